# Optimizing an MI355X kernel written in HIP

```python
import jax, jax.numpy as jnp
from jax import lax
import numpy as np

D_MODEL = 1024
BATCH = 2
SEQ = 16384
DEPTH = 2

N_A_LAYERS = max(1, DEPTH // 2)
N_B_LAYERS = DEPTH - N_A_LAYERS

D_RNN = D_MODEL
N_RG_BLOCKS = 8
RG_BW = D_RNN // N_RG_BLOCKS
CONV_WIDTH = 4
RG_C = 8.0

N_HEADS = 8
HEAD_DIM = 128
D_ATTN = N_HEADS * HEAD_DIM
MOBA_BLOCK = 256
MOBA_TOPK = 3
Q_CHUNK = 64
ROPE_THETA = 10000.0
EPS = 1e-6
NEG_INF = -1e30

kernel_name = "hawk_moba_yoco_hybrid"


def rms_norm(x, g):
    xf = x.astype(jnp.float32)
    y = xf * lax.rsqrt(jnp.mean(xf * xf, axis=-1, keepdims=True) + EPS)
    return (y * g.astype(jnp.float32)).astype(x.dtype)


def rope(x, pos):
    half = HEAD_DIM // 2
    inv = ROPE_THETA ** (-jnp.arange(half, dtype=jnp.float32) / half)
    ang = pos.astype(jnp.float32)[:, None] * inv[None, :]
    cos = jnp.cos(ang)[None, :, None, :]
    sin = jnp.sin(ang)[None, :, None, :]
    xf = x.astype(jnp.float32)
    x1, x2 = xf[..., :half], xf[..., half:]
    return jnp.concatenate([x1 * cos - x2 * sin, x2 * cos + x1 * sin], axis=-1).astype(x.dtype)


def causal_depthwise_conv(x, w, b):
    S = x.shape[1]
    xp = jnp.pad(x, ((0, 0), (CONV_WIDTH - 1, 0), (0, 0)))
    y = xp[:, 0:S] * w[0]
    for k in range(1, CONV_WIDTH):
        y = y + xp[:, k:k + S] * w[k]
    return y + b


def block_diag_linear(x, w, b):
    B, S, _ = x.shape
    xb = x.reshape(B, S, N_RG_BLOCKS, RG_BW)
    y = jnp.einsum('bsni,nij->bsnj', xb, w).reshape(B, S, D_RNN)
    return y + b


def rg_lru(x, r_w, r_b, i_w, i_b, lam):
    r = jax.nn.sigmoid(block_diag_linear(x, r_w, r_b).astype(jnp.float32))
    i = jax.nn.sigmoid(block_diag_linear(x, i_w, i_b).astype(jnp.float32))
    log_a = -RG_C * r * jax.nn.softplus(-lam.astype(jnp.float32))
    a = jnp.exp(log_a)
    mult = jnp.sqrt(-jnp.expm1(2.0 * log_a))
    bterm = mult * (i * x.astype(jnp.float32))

    def combine(left, right):
        a_l, b_l = left
        a_r, b_r = right
        return a_l * a_r, a_r * b_l + b_r

    _, h = lax.associative_scan(combine, (a, bterm), axis=1)
    return h.astype(x.dtype)


def hawk_layer(x, norm_g, in_w, conv_w, conv_b, r_w, r_b, i_w, i_b, lam, out_w):
    h = rms_norm(x, norm_g)
    u = h @ in_w
    xb, gate = u[..., :D_RNN], u[..., D_RNN:]
    xb = causal_depthwise_conv(xb, conv_w, conv_b)
    y = rg_lru(xb, r_w, r_b, i_w, i_b, lam) * jax.nn.silu(gate)
    return x + y @ out_w


def shared_kv(x, kv_norm_g, kv_w, k_norm_g, pos):
    B, S, _ = x.shape
    h = rms_norm(x, kv_norm_g)
    kv = (h @ kv_w).reshape(B, S, 2, N_HEADS, HEAD_DIM)
    k = rope(rms_norm(kv[:, :, 0], k_norm_g), pos)
    v = kv[:, :, 1]
    nb = -(-S // MOBA_BLOCK)
    pad = nb * MOBA_BLOCK - S
    k = jnp.pad(k, ((0, 0), (0, pad), (0, 0), (0, 0)))
    v = jnp.pad(v, ((0, 0), (0, pad), (0, 0), (0, 0)))
    kb = k.reshape(B, nb, MOBA_BLOCK, N_HEADS, HEAD_DIM).transpose(0, 3, 1, 2, 4)
    vb = v.reshape(B, nb, MOBA_BLOCK, N_HEADS, HEAD_DIM).transpose(0, 3, 1, 2, 4)
    kmean = jnp.mean(kb.astype(jnp.float32), axis=3)
    return kb, vb, kmean


def moba_attention(q, kb, vb, kmean):
    B, S, H, Dh = q.shape
    nb = kb.shape[2]
    topk = min(MOBA_TOPK, nb)
    qh = jnp.transpose(q, (0, 2, 1, 3))
    scale = HEAD_DIM ** -0.5
    blk_ids = jnp.arange(nb)
    gather_blocks = jax.vmap(jax.vmap(lambda t, idx: t[idx]))

    def chunk(c):
        q0 = c * Q_CHUNK
        qc = lax.dynamic_slice_in_dim(qh, q0, Q_CHUNK, axis=2)
        qpos = q0 + jnp.arange(Q_CHUNK)
        own = q0 // MOBA_BLOCK
        g = jnp.einsum('bhqd,bhnd->bhqn', qc.astype(jnp.float32), kmean)
        g = jnp.where(blk_ids < own, g, -jnp.inf)
        _, sel = lax.top_k(g, topk)
        valid = sel < own
        k_sel = gather_blocks(kb, sel)
        v_sel = gather_blocks(vb, sel)
        s_sel = jnp.einsum('bhqd,bhqkld->bhqkl', qc, k_sel).astype(jnp.float32) * scale
        s_sel = jnp.where(valid[..., None], s_sel, NEG_INF)
        k_own = lax.dynamic_index_in_dim(kb, own, axis=2, keepdims=False)
        v_own = lax.dynamic_index_in_dim(vb, own, axis=2, keepdims=False)
        s_own = jnp.einsum('bhqd,bhld->bhql', qc, k_own).astype(jnp.float32) * scale
        kpos = own * MOBA_BLOCK + jnp.arange(MOBA_BLOCK)
        s_own = jnp.where(kpos[None, :] <= qpos[:, None], s_own, NEG_INF)
        s = jnp.concatenate([s_sel.reshape(B, H, Q_CHUNK, topk * MOBA_BLOCK), s_own], axis=-1)
        p = jax.nn.softmax(s, axis=-1).astype(q.dtype)
        p_sel = p[..., :topk * MOBA_BLOCK].reshape(B, H, Q_CHUNK, topk, MOBA_BLOCK)
        p_own = p[..., topk * MOBA_BLOCK:]
        return (jnp.einsum('bhqkl,bhqkld->bhqd', p_sel, v_sel)
                + jnp.einsum('bhql,bhld->bhqd', p_own, v_own))

    o = lax.map(chunk, jnp.arange(S // Q_CHUNK))
    return jnp.transpose(o, (1, 0, 3, 2, 4)).reshape(B, S, H * Dh)


def moba_layer(x, norm_g, in_w, q_norm_g, out_w, kb, vb, kmean, pos):
    B, S, _ = x.shape
    h = rms_norm(x, norm_g)
    u = h @ in_w
    q = u[..., :D_ATTN].reshape(B, S, N_HEADS, HEAD_DIM)
    gate = u[..., D_ATTN:]
    q = rope(rms_norm(q, q_norm_g), pos)
    o = moba_attention(q, kb, vb, kmean) * jax.nn.silu(gate)
    return x + o @ out_w


def setup_inputs(seed: int = 0) -> dict:
    key = jax.random.key(seed)
    ks = jax.random.split(key, 24)
    f32 = jnp.float32
    nA, nB = N_A_LAYERS, N_B_LAYERS

    def nrm(k, shape, scale):
        return jax.random.normal(k, shape, f32) * scale

    x = jax.random.normal(ks[0], (BATCH, SEQ, D_MODEL), f32)
    a_norm = 1.0 + nrm(ks[1], (nA, D_MODEL), 0.02)
    a_in_w = nrm(ks[2], (nA, D_MODEL, 2 * D_RNN), D_MODEL ** -0.5)
    a_conv_w = nrm(ks[3], (nA, CONV_WIDTH, D_RNN), CONV_WIDTH ** -0.5)
    a_conv_b = nrm(ks[4], (nA, D_RNN), 0.02)
    a_r_w = nrm(ks[5], (nA, N_RG_BLOCKS, RG_BW, RG_BW), RG_BW ** -0.5)
    a_r_b = nrm(ks[6], (nA, D_RNN), 0.02)
    a_i_w = nrm(ks[7], (nA, N_RG_BLOCKS, RG_BW, RG_BW), RG_BW ** -0.5)
    a_i_b = nrm(ks[8], (nA, D_RNN), 0.02)
    a_c = jax.random.uniform(ks[9], (nA, D_RNN), f32, 0.9, 0.999)
    a_base = a_c ** (1.0 / RG_C)
    a_lambda = jnp.log(a_base) - jnp.log1p(-a_base)
    a_out_w = nrm(ks[10], (nA, D_RNN, D_MODEL), D_RNN ** -0.5)
    kv_norm = 1.0 + nrm(ks[11], (D_MODEL,), 0.02)
    kv_w = nrm(ks[12], (D_MODEL, 2 * D_ATTN), D_MODEL ** -0.5)
    k_norm = 1.0 + nrm(ks[13], (HEAD_DIM,), 0.02)
    b_norm = 1.0 + nrm(ks[14], (nB, D_MODEL), 0.02)
    b_in_w = nrm(ks[15], (nB, D_MODEL, 2 * D_ATTN), D_MODEL ** -0.5)
    q_norm = 1.0 + nrm(ks[16], (nB, HEAD_DIM), 0.02)
    b_out_w = nrm(ks[17], (nB, D_ATTN, D_MODEL), D_ATTN ** -0.5)
    return {"x": x, "a_norm": a_norm, "a_in_w": a_in_w, "a_conv_w": a_conv_w, "a_conv_b": a_conv_b,
            "a_r_w": a_r_w, "a_r_b": a_r_b, "a_i_w": a_i_w, "a_i_b": a_i_b, "a_lambda": a_lambda,
            "a_out_w": a_out_w, "kv_norm": kv_norm, "kv_w": kv_w, "k_norm": k_norm,
            "b_norm": b_norm, "b_in_w": b_in_w, "q_norm": q_norm, "b_out_w": b_out_w}


def reference(x, a_norm, a_in_w, a_conv_w, a_conv_b, a_r_w, a_r_b, a_i_w, a_i_b, a_lambda,
              a_out_w, kv_norm, kv_w, k_norm, b_norm, b_in_w, q_norm, b_out_w):
    S = x.shape[1]
    pos = jnp.arange(S, dtype=jnp.int32)
    for l in range(N_A_LAYERS):
        x = hawk_layer(x, a_norm[l], a_in_w[l], a_conv_w[l], a_conv_b[l], a_r_w[l], a_r_b[l],
                       a_i_w[l], a_i_b[l], a_lambda[l], a_out_w[l])
    kb, vb, kmean = shared_kv(x, kv_norm, kv_w, k_norm, pos)
    for j in range(N_B_LAYERS):
        x = moba_layer(x, b_norm[j], b_in_w[j], q_norm[j], b_out_w[j], kb, vb, kmean, pos)
    return x
```

```cpp
#include <hip/hip_runtime.h>
#include <cstdio>
#include <cstdint>

#ifndef MK_N_LAUNCHES
#define MK_N_LAUNCHES 0
#endif
#ifndef MK_PHMASK
#define MK_PHMASK 0x7ff
#endif
#ifndef MK_LAST_PHASE
#define MK_LAST_PHASE 10
#endif

namespace pg8 {
#define PG8_LAS __attribute__((address_space(3)))
typedef unsigned short bf16_t;
typedef short bf16x8 __attribute__((ext_vector_type(8)));
typedef float f32x4 __attribute__((ext_vector_type(4)));
typedef unsigned u32x4 __attribute__((ext_vector_type(4)));
typedef unsigned u32x2 __attribute__((ext_vector_type(2)));
constexpr int BM = 256, BK = 64, HALF = 128, HTB = HALF * BK * 2, STAGE_BYTES = 8 * HTB, NXCD = 8, WGM = 8;

__host__ __device__ __forceinline__ int lds_byte(int r, int c) { const int st = (r >> 4) * 2 + (c >> 5), rr = r & 15, cc = c & 31, ob = rr * 64 + cc * 2; return st * 1024 + (ob ^ (((ob >> 9) & 1) << 5)); }
__host__ __device__ __forceinline__ void stage_rc(int b, int& R, int& C) { const int st = b / 1024, sb = b % 1024, swz = sb ^ (((sb >> 9) & 1) << 5); R = (st >> 1) * 16 + swz / 64; C = (st & 1) * 32 + (swz % 64) / 2; }
__host__ __device__ __forceinline__ int perm32(int rho) { const int n = rho >> 4, i = rho & 15; return 8 * (i >> 2) + 4 * n + (i & 3); }

struct Unit { int pm, pn; };
struct Gemm { const bf16_t* A; const bf16_t* Bt; int M, N, K; };

struct StaticOrder {
    int nM, nN, nwg, G, c;
    __host__ __device__ void init(int M, int N, int G_, int c_) { nM = M / BM; nN = N / BM; nwg = nM * nN; G = G_; c = c_; }
    __host__ __device__ bool next(int i, Unit& u) const {
        const long L = (long)i * G + c; if (L >= nwg) return false;
        int wgid = (int)L; { const int q = nwg / NXCD, r = nwg % NXCD, xcd = wgid % NXCD, off = wgid / NXCD; wgid = (xcd < r ? xcd * (q + 1) : r * (q + 1) + (xcd - r) * q) + off; }
        const int nig = WGM * nN, gid = wgid / nig, fm = gid * WGM, gsz = (nM - fm) < WGM ? (nM - fm) : WGM;
        u.pm = fm + ((wgid % nig) % gsz); u.pn = (wgid % nig) / gsz; return true;
    }
    __device__ __forceinline__ void a_ready(const Unit&) const {}
    __device__ __forceinline__ void done(const Unit&) const {}
};

__device__ __forceinline__ unsigned cvt_pk_bf16(float lo, float hi) { unsigned r; asm volatile("v_cvt_pk_bf16_f32 %0, %1, %2" : "=v"(r) : "v"(lo), "v"(hi)); return r; }

template <class Epi, class Sched, bool ALIGN_EPI = false, bool SP2 = false>
__device__ __forceinline__ void gemm_phase(PG8_LAS unsigned char* lds, const Gemm g, const Sched& S, const Epi& E) {
    const int tid = threadIdx.x, wid = __builtin_amdgcn_readfirstlane(tid >> 6), lane = tid & 63, wr = wid >> 2, wc = wid & 3, fr = lane & 15, fq = lane >> 4;
    const int K = g.K, nt = K / BK;
    unsigned voffA[2], voffB[2];
#pragma unroll
    for (int i = 0; i < 2; ++i) { int R, C; stage_rc(tid * 16 + i * 8192, R, C); const int Rb = Epi::PERM ? ((R & ~31) + perm32(R & 31)) : R;
        voffA[i] = (unsigned)(R * K + C) * 2u; voffB[i] = (unsigned)(Rb * K + C) * 2u; }
    const size_t kstep = (size_t)(BK * 2);
    const size_t hstep = (size_t)HALF * K * 2;
    const size_t tstep = 2 * hstep;
    const unsigned ldsw = (unsigned)wid * 1024u;
    const int aoff = lds_byte(wr * 64 + fr, fq * 8), boff = lds_byte(wc * 32 + fr, fq * 8);
#define PG8_SA(b, h) (((b) * 2 + (h)) * HTB)
#define PG8_SB(b, h) ((4 + (b) * 2 + (h)) * HTB)
#define PG8_STAGE(bufoff, gbase, voff) do { _Pragma("unroll") for (int _i = 0; _i < 2; ++_i) \
        __builtin_amdgcn_global_load_lds((const unsigned*)((const char*)(gbase) + (voff)[_i]), (PG8_LAS unsigned*)(lds + (bufoff) + ldsw + _i * 8192), 16, 0, 0); } while (0)
#define PG8_LDA(dst, b, h) do { _Pragma("unroll") for (int m = 0; m < 4; ++m) _Pragma("unroll") for (int k = 0; k < 2; ++k) dst[m][k] = *(const PG8_LAS bf16x8*)(lds + PG8_SA(b, h) + aoff + m * 2048 + k * 1024); } while (0)
#define PG8_LDB(dst, b, h) do { _Pragma("unroll") for (int n = 0; n < 2; ++n) _Pragma("unroll") for (int k = 0; k < 2; ++k) dst[n][k] = *(const PG8_LAS bf16x8*)(lds + PG8_SB(b, h) + boff + n * 2048 + k * 1024); } while (0)
#define PG8_MMA(ai, bj, At, Bt) do { __builtin_amdgcn_s_setprio(1); _Pragma("unroll") for (int m = 0; m < 4; ++m) _Pragma("unroll") for (int n = 0; n < 2; ++n) _Pragma("unroll") for (int k = 0; k < 2; ++k) \
        acc[ai][bj][m][n] = __builtin_amdgcn_mfma_f32_16x16x32_bf16(Bt[n][k], At[m][k], acc[ai][bj][m][n], 0, 0, 0); __builtin_amdgcn_s_setprio(0); } while (0)
#define PG8_WAIT_V(n) asm volatile("s_waitcnt vmcnt(" #n ")" ::: "memory")
#define PG8_WAIT_L(n) asm volatile("s_waitcnt lgkmcnt(" #n ")" ::: "memory")
#define PG8_BAR __builtin_amdgcn_s_barrier()
#define PG8_SCHED __builtin_amdgcn_sched_barrier(0)
    Unit cur, nxt; int ui = 0;
    if (!S.next(0, cur)) return;
    f32x4 acc[2][2][4][2];
#pragma unroll
    for (int a = 0; a < 2; ++a)
#pragma unroll
        for (int b = 0; b < 2; ++b)
#pragma unroll
            for (int m = 0; m < 4; ++m)
#pragma unroll
                for (int n = 0; n < 2; ++n) acc[a][b][m][n] = (f32x4){0.f, 0.f, 0.f, 0.f};
    bf16x8 At[4][2], B0[2][2], B1[2][2];
    const char* cA = (const char*)g.A + (size_t)cur.pm * tstep; const char* cB = (const char*)g.Bt + (size_t)cur.pn * tstep;
    S.a_ready(cur);
    if constexpr (SP2) {
        PG8_STAGE(PG8_SB(0, 0), cB, voffB); PG8_STAGE(PG8_SB(0, 1), cB + hstep, voffB); PG8_STAGE(PG8_SA(0, 0), cA, voffA); PG8_STAGE(PG8_SA(0, 1), cA + hstep, voffA);
        if (wr == 1) PG8_BAR;
        PG8_WAIT_V(2); PG8_BAR;
        PG8_STAGE(PG8_SB(1, 0), cB + kstep, voffB); PG8_STAGE(PG8_SA(1, 0), cA + kstep, voffA); PG8_STAGE(PG8_SB(1, 1), cB + hstep + kstep, voffB);
        PG8_WAIT_V(6); PG8_BAR;
    } else {
        PG8_STAGE(PG8_SB(0, 0), cB, voffB); PG8_STAGE(PG8_SA(0, 0), cA, voffA); PG8_STAGE(PG8_SB(0, 1), cB + hstep, voffB); PG8_STAGE(PG8_SA(0, 1), cA + hstep, voffA);
        if (wr == 1) PG8_BAR;
        PG8_WAIT_V(4); PG8_BAR;
        PG8_STAGE(PG8_SB(1, 0), cB + kstep, voffB); PG8_STAGE(PG8_SA(1, 0), cA + kstep, voffA); PG8_STAGE(PG8_SB(1, 1), cB + hstep + kstep, voffB);
        PG8_WAIT_V(6); PG8_BAR;
    }
    for (;;) {
        const bool has_next = S.next(ui + 1, nxt);
        const char* nA = has_next ? (const char*)g.A + (size_t)nxt.pm * tstep : cA; const char* nB = has_next ? (const char*)g.Bt + (size_t)nxt.pn * tstep : cB;
        for (int t = 0; t < nt; t += 2) {
            const bool last = (t == nt - 2);
            const char* a1 = cA + (size_t)(t + 1) * kstep;
            const char* a2 = last ? nA : cA + (size_t)(t + 2) * kstep; const char* b2 = last ? nB : cB + (size_t)(t + 2) * kstep;
            const char* a3 = a2 + kstep; const char* b3 = b2 + kstep;
            if (last && has_next) S.a_ready(nxt);
            if constexpr (SP2) {
            PG8_LDB(B0, 0, 0); PG8_LDB(B1, 0, 1); PG8_SCHED; PG8_LDA(At, 0, 0); PG8_STAGE(PG8_SA(1, 1), a1 + hstep, voffA);
            PG8_WAIT_V(8); PG8_WAIT_L(0); PG8_BAR; PG8_MMA(0, 0, At, B0); PG8_MMA(0, 1, At, B1); PG8_BAR; PG8_SCHED;
            PG8_LDA(At, 0, 1); PG8_STAGE(PG8_SB(0, 0), b2, voffB); PG8_STAGE(PG8_SB(0, 1), b2 + hstep, voffB); PG8_STAGE(PG8_SA(0, 0), a2, voffA);
            PG8_WAIT_V(8); PG8_WAIT_L(0); PG8_BAR; PG8_MMA(1, 0, At, B0); PG8_MMA(1, 1, At, B1); PG8_BAR; PG8_SCHED;
            PG8_LDB(B0, 1, 0); PG8_LDB(B1, 1, 1); PG8_SCHED; PG8_LDA(At, 1, 0); PG8_STAGE(PG8_SA(0, 1), a2 + hstep, voffA);
            PG8_WAIT_V(8); PG8_WAIT_L(0); PG8_BAR; PG8_MMA(0, 0, At, B0); PG8_MMA(0, 1, At, B1); PG8_BAR; PG8_SCHED;
            PG8_LDA(At, 1, 1); PG8_STAGE(PG8_SB(1, 0), b3, voffB); PG8_STAGE(PG8_SB(1, 1), b3 + hstep, voffB); PG8_STAGE(PG8_SA(1, 0), a3, voffA);
            PG8_WAIT_V(8); PG8_WAIT_L(0); PG8_BAR; PG8_MMA(1, 0, At, B0); PG8_MMA(1, 1, At, B1); PG8_BAR; PG8_SCHED;
            } else {
            PG8_LDB(B0, 0, 0); PG8_SCHED; PG8_LDA(At, 0, 0); PG8_STAGE(PG8_SA(1, 1), a1 + hstep, voffA);
            PG8_WAIT_L(8); PG8_BAR; PG8_WAIT_L(0); PG8_MMA(0, 0, At, B0); PG8_BAR; PG8_SCHED;
            PG8_LDB(B1, 0, 1); PG8_STAGE(PG8_SB(0, 0), b2, voffB);
            PG8_BAR; PG8_WAIT_L(0); PG8_MMA(0, 1, At, B1); PG8_BAR;
            PG8_LDA(At, 0, 1); PG8_STAGE(PG8_SA(0, 0), a2, voffA);
            PG8_BAR; PG8_WAIT_L(0); PG8_MMA(1, 0, At, B0); PG8_BAR; PG8_SCHED;
            PG8_STAGE(PG8_SB(0, 1), b2 + hstep, voffB);
            PG8_WAIT_V(6); PG8_BAR; PG8_MMA(1, 1, At, B1); PG8_BAR;
            PG8_LDB(B0, 1, 0); PG8_SCHED; PG8_LDA(At, 1, 0); PG8_STAGE(PG8_SA(0, 1), a2 + hstep, voffA);
            PG8_WAIT_L(8); PG8_BAR; PG8_WAIT_L(0); PG8_MMA(0, 0, At, B0); PG8_BAR; PG8_SCHED;
            PG8_LDB(B1, 1, 1); PG8_STAGE(PG8_SB(1, 0), b3, voffB);
            PG8_BAR; PG8_WAIT_L(0); PG8_MMA(0, 1, At, B1); PG8_BAR;
            PG8_LDA(At, 1, 1); PG8_STAGE(PG8_SA(1, 0), a3, voffA);
            PG8_BAR; PG8_WAIT_L(0); PG8_MMA(1, 0, At, B0); PG8_BAR; PG8_SCHED;
            PG8_STAGE(PG8_SB(1, 1), b3 + hstep, voffB);
            PG8_WAIT_V(6); PG8_BAR; PG8_MMA(1, 1, At, B1); PG8_BAR;
            }
        }
        if constexpr (ALIGN_EPI) { if (wr == 0) PG8_BAR; }
        E(acc, cur, wr, wc, fr, fq); S.done(cur);
        if (!has_next) break;
#pragma unroll
        for (int a = 0; a < 2; ++a)
#pragma unroll
            for (int b = 0; b < 2; ++b)
#pragma unroll
                for (int m = 0; m < 4; ++m)
#pragma unroll
                    for (int n = 0; n < 2; ++n) acc[a][b][m][n] = (f32x4){0.f, 0.f, 0.f, 0.f};
        cur = nxt; cA = nA; cB = nB; ++ui;
        if constexpr (ALIGN_EPI) { if (wr == 1) PG8_BAR; }
    }
    PG8_WAIT_V(0);
    if constexpr (!ALIGN_EPI) { if (wr == 0) PG8_BAR; }
    PG8_BAR;
#undef PG8_SA
#undef PG8_SB
#undef PG8_STAGE
#undef PG8_LDA
#undef PG8_LDB
#undef PG8_MMA
#undef PG8_WAIT_V
#undef PG8_WAIT_L
#undef PG8_BAR
#undef PG8_SCHED
}
}

constexpr int NBATCH = 2, SEQ = 16384, T = NBATCH * SEQ, DM = 1024, NH = 8, HD = 128, NBLK = 64, BLK = 256;
constexpr float EPS = 1e-6f;
constexpr float QSCALE = 0.088388347648318440f * 1.4426950408889634f;

constexpr size_t MiB = 1u << 20;
constexpr size_t WS_CTL = 0, CTL_ZERO_BYTES = 1 * MiB;
constexpr size_t WS_WAIN = 2 * MiB, WS_WAOUT = 6 * MiB, WS_WB1 = 8 * MiB, WS_WBOUT = 16 * MiB, WS_WRG = 18 * MiB;
constexpr size_t WS_RS0 = 19 * MiB;
constexpr size_t WS_SSQ1 = 20 * MiB;
constexpr size_t WS_ROPE = 22 * MiB;
constexpr size_t WS_SUMA = 30 * MiB, WS_SUMB = 30 * MiB + 512 * 1024;
constexpr size_t WS_KMEAN = 31 * MiB;
constexpr size_t WS_ENT = 32 * MiB;
constexpr size_t WS_OFFS = 34 * MiB;
constexpr size_t WS_LSE = 36 * MiB;
constexpr size_t SLOT = 64 * MiB;
constexpr size_t WS_S0 = 1 * SLOT;
constexpr size_t WS_S1 = 2 * SLOT;
constexpr size_t WS_S2 = 3 * SLOT;
constexpr size_t WS_S3 = 4 * SLOT;
constexpr size_t WS_S6 = 7 * SLOT;
constexpr size_t WS_END = 8 * SLOT;
constexpr int OFFS_PITCH = 72;
constexpr int CW_BAR = 4096;
constexpr int CW_NTOT = 16384;

constexpr int LDS_BYTES = 163840;
constexpr int MISC_OFF = LDS_BYTES - 256;

#define GAS __attribute__((address_space(1)))
#define LAS __attribute__((address_space(3)))
typedef unsigned short bf16;
typedef unsigned v4u __attribute__((ext_vector_type(4)));
typedef unsigned v2u __attribute__((ext_vector_type(2)));
typedef float f32x4 __attribute__((ext_vector_type(4)));
typedef float f32x16 __attribute__((ext_vector_type(16)));
typedef short bf16x8 __attribute__((ext_vector_type(8)));
typedef short s16x4 __attribute__((ext_vector_type(4)));
#define LDS_WAIT() asm volatile("s_waitcnt lgkmcnt(0)" ::: "memory")
#define VM_WAIT() asm volatile("s_waitcnt vmcnt(0)" ::: "memory")
#define SBAR() __builtin_amdgcn_sched_barrier(0)

__device__ __forceinline__ unsigned f2bf(float f) { unsigned u = __builtin_bit_cast(unsigned, f); return (u + 0x7fffu + ((u >> 16) & 1u)) >> 16; }
__device__ __forceinline__ unsigned pk2(float lo, float hi) { return pg8::cvt_pk_bf16(lo, hi); }
__device__ __forceinline__ float bflo(unsigned w) { return __builtin_bit_cast(float, w << 16); }
__device__ __forceinline__ float bfhi(unsigned w) { return __builtin_bit_cast(float, w & 0xffff0000u); }
__device__ __forceinline__ float bf1(unsigned short h) { return __builtin_bit_cast(float, ((unsigned)h) << 16); }
__device__ __forceinline__ float fast_exp2(float x) { return __builtin_amdgcn_exp2f(x); }
__device__ __forceinline__ float sigmoidf_(float v) { return __builtin_amdgcn_rcpf(1.f + fast_exp2(-v * 1.4426950408889634f)); }
__device__ __forceinline__ float siluf_(float v) { return v * sigmoidf_(v); }

#define XB_TMO      128
#define XB_XCNT(j)  (256  + 64 * (j))
#define XB_XSUB(j)  (1280 + 64 * (j))
#define XB_XGEN(j)  (2304 + 64 * (j))
#define XB_TOP      3328
#define XB_TOPGEN   3392
#define XCD_BAR_WORDS 3456
#define XB_SPIN_CAP (1u << 20)
__device__ __forceinline__ unsigned xb_ld(unsigned* p)              { return __hip_atomic_load(p, __ATOMIC_RELAXED, __HIP_MEMORY_SCOPE_AGENT); }
__device__ __forceinline__ unsigned xb_add(unsigned* p, unsigned v) { return __hip_atomic_fetch_add(p, v, __ATOMIC_RELAXED, __HIP_MEMORY_SCOPE_AGENT); }
__device__ __forceinline__ unsigned xb_xcc_id() { return (unsigned)__builtin_amdgcn_s_getreg((3 << 11) | 20) & 0xFu; }
#define XB_SPIN(cond, bar) do { unsigned _sp = 0; while (cond) { __builtin_amdgcn_s_sleep(1); \
    if ((++_sp & 255u) == 0u) { if (xb_ld(&(bar)[XB_TMO])) break; if (_sp > XB_SPIN_CAP) { atomicAdd(&(bar)[XB_TMO], 1u); break; } } } } while (0)
struct XcdBarrier { unsigned* bar; unsigned x; volatile LAS unsigned* st; };
__device__ __forceinline__ XcdBarrier xcd_barrier_post(unsigned* bar, volatile LAS unsigned* st) {
    XcdBarrier b; b.bar = bar; b.x = xb_xcc_id(); b.st = st;
    if (threadIdx.x == 0) (void)xb_add(&bar[XB_XCNT(b.x)], 1u);
    return b;
}
__device__ __forceinline__ void xcd_barrier_complete(unsigned* bar, unsigned x, unsigned& nloc, unsigned& nx) {
    const unsigned G = gridDim.x * gridDim.y * gridDim.z;
    unsigned sum, cnt, mine, sp = 0u;
    for (;;) {
        sum = 0u; cnt = 0u; mine = 0u;
#pragma unroll
        for (unsigned j = 0; j < 16; ++j) { const unsigned c = xb_ld(&bar[XB_XCNT(j)]); sum += c; cnt += (c > 0u) ? 1u : 0u; mine = (j == x) ? c : mine; }
        if (sum == G) break;
        __builtin_amdgcn_s_sleep(1);
        if ((++sp & 255u) == 0u) { if (xb_ld(&bar[XB_TMO])) break; if (sp > XB_SPIN_CAP) { atomicAdd(&bar[XB_TMO], 1u); break; } }
    }
    nloc = mine > 0u ? mine : 1u; nx = cnt > 0u ? cnt : 1u;
}
__device__ __forceinline__ void xcd_barrier(const XcdBarrier& b) {
    asm volatile("s_waitcnt vmcnt(0)" ::: "memory");
    __syncthreads();
    if (threadIdx.x == 0) {
        unsigned* bar = b.bar;
        __builtin_amdgcn_s_waitcnt(0);
        unsigned nloc = b.st[0], nx = b.st[1];
        if (nloc == 0u) { xcd_barrier_complete(bar, b.x, nloc, nx); b.st[0] = nloc; b.st[1] = nx; }
        const unsigned old = xb_add(&bar[XB_XSUB(b.x)], 1u);
        const unsigned gen = old / nloc;
        if (old + 1u == (gen + 1u) * nloc) {
            __builtin_amdgcn_fence(__ATOMIC_RELEASE, "agent");
            asm volatile("s_waitcnt vmcnt(0)" ::: "memory");
            const unsigned og = xb_add(&bar[XB_TOP], 1u);
            const unsigned tg = og / nx;
            if (og + 1u == (tg + 1u) * nx) xb_add(&bar[XB_TOPGEN], 1u);
            else XB_SPIN(xb_ld(&bar[XB_TOPGEN]) == tg, bar);
            __builtin_amdgcn_fence(__ATOMIC_ACQUIRE, "agent");
            xb_add(&bar[XB_XGEN(b.x)], 1u);
            asm volatile("s_waitcnt vmcnt(0)" ::: "memory");
        } else {
            XB_SPIN(xb_ld(&bar[XB_XGEN(b.x)]) == gen, bar);
            __builtin_amdgcn_fence(__ATOMIC_ACQUIRE, "agent");
            asm volatile("s_waitcnt vmcnt(0)" ::: "memory");
        }
    }
    __syncthreads();
}

struct Args { const float* in[18]; float* out; unsigned char* ws; int ph_lo, ph_hi; };
__device__ __forceinline__ const float* inp(int k) {
    const __attribute__((address_space(4))) Args* ap = (const __attribute__((address_space(4))) Args*)__builtin_amdgcn_kernarg_segment_ptr();
    asm volatile("" : "+s"(ap));
    return ap->in[k];
}
struct Frame {
    LAS unsigned char* lds;
    int tid, lane, wave, vcu, G;
    float* out;
    unsigned char* ws;
};
__device__ __forceinline__ float wave_sum(float v) {
#pragma unroll
    for (int o = 1; o < 64; o <<= 1) v += __shfl_xor(v, o);
    return v;
}

namespace pg8 {
struct EpiAll {
    static constexpr bool PERM = true, AFTER_DRAIN = false;
    int mode;
    unsigned char* ws;
    float* xout;
    __device__ __forceinline__ void operator()(const f32x4 (&acc)[2][2][4][2], const Unit& u, int wr, int wc, int fr, int fq) const {
        const int row0 = u.pm * BM + wr * 64 + fr;
        bf16_t* const o0 = (bf16_t*)(ws + (mode == 1 ? WS_S3 : WS_S1)); bf16_t* const o1 = (bf16_t*)(ws + WS_S2); bf16_t* const o2 = (bf16_t*)(ws + WS_S0); bf16_t* const o3 = (bf16_t*)(ws + WS_S6);
        const float* const rs = (const float*)(ws + (mode == 0 ? WS_RS0 : WS_SSQ1)); float* const ssq = (float*)(ws + WS_SSQ1);
        if (mode == 0 || mode == 2) {
            const int tt = u.pn >> 2; const bool act = (mode == 0) ? (tt == 1) : (tt == 3);
            bf16_t* base = tt == 0 ? o0 : (tt == 1 ? o1 : (tt == 2 ? o2 : o3)); const int col0 = (u.pn & 3) * BM + wc * 32 + 8 * fq;
#pragma unroll
            for (int ai = 0; ai < 2; ++ai)
#pragma unroll
                for (int m = 0; m < 4; ++m) { const int row = row0 + ai * HALF + m * 16; float s;
                    if (mode == 0) s = rs[row];
                    else { const f32x4* sp = (const f32x4*)(rs + (size_t)row * 16); const f32x4 s0 = sp[0], s1 = sp[1], s2 = sp[2], s3 = sp[3];
                        const float tot = ((s0[0] + s0[1]) + (s0[2] + s0[3])) + ((s1[0] + s1[1]) + (s1[2] + s1[3])) + ((s2[0] + s2[1]) + (s2[2] + s2[3])) + ((s3[0] + s3[1]) + (s3[2] + s3[3]));
                        s = 1.0f / sqrtf(tot * (1.0f / DM) + EPS); }
                    bf16_t* rowp = base + (size_t)row * DM + col0;
#pragma unroll
                    for (int bj = 0; bj < 2; ++bj) { f32x4 v0 = acc[ai][bj][m][0] * s, v1 = acc[ai][bj][m][1] * s;
                        if (act) {
#pragma unroll
                            for (int j = 0; j < 4; ++j) { v0[j] = siluf_(v0[j]); v1[j] = siluf_(v1[j]); } }
                        u32x4 w; w.x = cvt_pk_bf16(v0[0], v0[1]); w.y = cvt_pk_bf16(v0[2], v0[3]); w.z = cvt_pk_bf16(v1[0], v1[1]); w.w = cvt_pk_bf16(v1[2], v1[3]);
                        *(u32x4*)(rowp + bj * HALF) = w; } }
        } else if (mode == 1) {
            const float* const xin = inp(0);
            const int col0 = u.pn * BM + wc * 32 + 8 * fq;
#pragma unroll
            for (int ai = 0; ai < 2; ++ai)
#pragma unroll
                for (int m = 0; m < 4; ++m) { const int row = row0 + ai * HALF + m * 16; const size_t off = (size_t)row * DM + col0; float ss = 0.f;
#pragma unroll
                    for (int bj = 0; bj < 2; ++bj) { const f32x4 xa = *(const f32x4*)(xin + off + bj * HALF), xb = *(const f32x4*)(xin + off + bj * HALF + 4);
                        const f32x4 v0 = acc[ai][bj][m][0] + xa, v1 = acc[ai][bj][m][1] + xb;
                        *(f32x4*)(xout + off + bj * HALF) = v0; *(f32x4*)(xout + off + bj * HALF + 4) = v1;
                        ss += ((v0[0] * v0[0] + v0[1] * v0[1]) + (v0[2] * v0[2] + v0[3] * v0[3])) + ((v1[0] * v1[0] + v1[1] * v1[1]) + (v1[2] * v1[2] + v1[3] * v1[3]));
                        u32x4 w; w.x = cvt_pk_bf16(v0[0], v0[1]); w.y = cvt_pk_bf16(v0[2], v0[3]); w.z = cvt_pk_bf16(v1[0], v1[1]); w.w = cvt_pk_bf16(v1[2], v1[3]);
                        *(u32x4*)(o0 + off + bj * HALF) = w; }
                    ss += __shfl_xor(ss, 16); ss += __shfl_xor(ss, 32);
                    if (fq == 0) ssq[(size_t)row * 16 + u.pn * 4 + wc] = ss;
                    asm volatile("" ::: "memory"); }
        } else {
            const int col0 = u.pn * BM + wc * 32 + 8 * fq;
#pragma unroll
            for (int ai = 0; ai < 2; ++ai)
#pragma unroll
                for (int m = 0; m < 4; ++m) { const size_t off = (size_t)(row0 + ai * HALF + m * 16) * DM + col0;
#pragma unroll
                    for (int bj = 0; bj < 2; ++bj) { float* p = xout + off + bj * HALF; const f32x4 xa = *(const f32x4*)p, xb = *(const f32x4*)(p + 4);
                        *(f32x4*)p = acc[ai][bj][m][0] + xa; *(f32x4*)(p + 4) = acc[ai][bj][m][1] + xb; }
                    asm volatile("" ::: "memory"); }
        }
    }
};
}

__device__ __forceinline__ int fperm(int p) { return ((p >> 2) & 1) * 64 + (p >> 5) * 16 + ((p >> 3) & 3) * 4 + (p & 3); }
template <int MODE  >
__device__ __forceinline__ void p0_transpose_item(const float* W, int ldw, int Kd, bf16* WT, int drow0, const float* gain, LAS float* scr, int k0, int n0, int lane) {
    const int nn = n0 + (lane & 31);
    const int sc = (MODE == 1 && nn < 1024) ? ((nn & ~127) + fperm(nn & 127)) : nn;
#pragma unroll 8
    for (int i = 0; i < 32; ++i) { const int kk = 2 * i + (lane >> 5); float v = W[(size_t)(k0 + kk) * ldw + sc]; if (gain) v *= gain[k0 + kk]; scr[kk * 33 + (lane & 31)] = v; }
    LDS_WAIT(); asm volatile("" ::: "memory");
    const int c = lane & 7;
#pragma unroll
    for (int j = 0; j < 4; ++j) { const int n = (lane >> 3) + 8 * j; const LAS float* s = scr + (8 * c) * 33 + n;
        v4u o; o.x = pk2(s[0 * 33], s[1 * 33]); o.y = pk2(s[2 * 33], s[3 * 33]); o.z = pk2(s[4 * 33], s[5 * 33]); o.w = pk2(s[6 * 33], s[7 * 33]);
        *(v4u*)(WT + (size_t)(drow0 + n0 + n) * Kd + k0 + 8 * c) = o; }
    LDS_WAIT(); asm volatile("" ::: "memory");
}
__device__ __forceinline__ void sincos_acc(float angf, float& s, float& c) {
    const double a = (double)angf;
    const double k = __builtin_rint(a * 0.63661977236758134308);
    const double y = __builtin_fma(-k, 1.57079632679489661923, a) - k * 6.123233995736766e-17;
    const double y2 = y * y;
    double sp = -1.0 / 1307674368000.0; sp = sp * y2 + 1.0 / 6227020800.0; sp = sp * y2 - 1.0 / 39916800.0; sp = sp * y2 + 1.0 / 362880.0; sp = sp * y2 - 1.0 / 5040.0; sp = sp * y2 + 1.0 / 120.0; sp = sp * y2 - 1.0 / 6.0; sp = sp * y2 + 1.0;
    const double sy = sp * y;
    double cp = 1.0 / 20922789888000.0; cp = cp * y2 - 1.0 / 87178291200.0; cp = cp * y2 + 1.0 / 479001600.0; cp = cp * y2 - 1.0 / 3628800.0; cp = cp * y2 + 1.0 / 40320.0; cp = cp * y2 - 1.0 / 720.0; cp = cp * y2 + 1.0 / 24.0; cp = cp * y2 - 0.5; cp = cp * y2 + 1.0;
    const int q = ((int)k) & 3;
    const double ss = (q == 0) ? sy : (q == 1) ? cp : (q == 2) ? -sy : -cp;
    const double cc = (q == 0) ? cp : (q == 1) ? -sy : (q == 2) ? -cp : sy;
    s = (float)ss; c = (float)cc;
}
__device__ __forceinline__ void p0_prologue(Frame& F) {
    static constexpr float ROPE_INV[64] = {
        1.000000000e+00f, 8.659643531e-01f, 7.498942018e-01f, 6.493816376e-01f, 5.623413324e-01f, 4.869675338e-01f, 4.216965139e-01f, 3.651741147e-01f, 3.162277639e-01f, 2.738419771e-01f, 2.371373773e-01f, 2.053525001e-01f, 1.778279394e-01f, 1.539926529e-01f, 1.333521456e-01f, 1.154781953e-01f,
        1.000000015e-01f, 8.659642935e-02f, 7.498942316e-02f, 6.493816525e-02f, 5.623413250e-02f, 4.869675264e-02f, 4.216964915e-02f, 3.651741147e-02f, 3.162277490e-02f, 2.738419548e-02f, 2.371373773e-02f, 2.053525113e-02f, 1.778279431e-02f, 1.539926510e-02f, 1.333521400e-02f, 1.154781971e-02f,
        9.999999776e-03f, 8.659643121e-03f, 7.498942316e-03f, 6.493816152e-03f, 5.623413250e-03f, 4.869675264e-03f, 4.216964822e-03f, 3.651741194e-03f, 3.162277630e-03f, 2.738419687e-03f, 2.371373819e-03f, 2.053525066e-03f, 1.778279431e-03f, 1.539926510e-03f, 1.333521446e-03f, 1.154782018e-03f,
        1.000000047e-03f, 8.659643354e-04f, 7.498941850e-04f, 6.493816036e-04f, 5.623413017e-04f, 4.869675322e-04f, 4.216965172e-04f, 3.651741135e-04f, 3.162277571e-04f, 2.738419571e-04f, 2.371373703e-04f, 2.053525095e-04f, 1.778279402e-04f, 1.539926598e-04f, 1.333521504e-04f, 1.154782003e-04f};
    LAS float* scr = (LAS float*)(F.lds + F.wave * 16384);
    const int gw = F.vcu * 8 + F.wave, NGW = F.G * 8;
    bf16* WAIN = (bf16*)(F.ws + WS_WAIN); bf16* WAOUT = (bf16*)(F.ws + WS_WAOUT); bf16* WB1 = (bf16*)(F.ws + WS_WB1); bf16* WBOUT = (bf16*)(F.ws + WS_WBOUT); bf16* WRG = (bf16*)(F.ws + WS_WRG);
    constexpr int I0 = 16 * 64, I1 = 16 * 32, I2 = 16 * 64, I3 = 16 * 64, I4 = 16 * 32, I5 = 16 * 8;
    constexpr int NITEMS = I0 + I1 + I2 + I3 + I4 + I5;
    for (int it = gw; it < NITEMS; it += NGW) {
        int r = it;
        if (r < I0) { p0_transpose_item<0>(inp(2), 2048, DM, WAIN, 0, inp(1), scr, (r / 64) * 64, (r % 64) * 32, F.lane); continue; } r -= I0;
        if (r < I1) { p0_transpose_item<0>(inp(10), 1024, DM, WAOUT, 0, nullptr, scr, (r / 32) * 64, (r % 32) * 32, F.lane); continue; } r -= I1;
        if (r < I2) { p0_transpose_item<1>(inp(12), 2048, DM, WB1, 0, inp(11), scr, (r / 64) * 64, (r % 64) * 32, F.lane); continue; } r -= I2;
        if (r < I3) { p0_transpose_item<1>(inp(15), 2048, DM, WB1, 2048, inp(14), scr, (r / 64) * 64, (r % 64) * 32, F.lane); continue; } r -= I3;
        if (r < I4) { p0_transpose_item<0>(inp(17), 1024, DM, WBOUT, 0, nullptr, scr, (r / 32) * 64, (r % 32) * 32, F.lane); continue; } r -= I4;
        { const int mat = r >> 3, sub = r & 7, n = mat >> 1, which = mat & 1;
          const float* W = (which ? inp(7) : inp(5)) + (size_t)n * 128 * 128;
          p0_transpose_item<0>(W, 128, 128, WRG, n * 256 + which * 128, nullptr, scr, (sub >> 2) * 64, (sub & 3) * 32, F.lane); }
    }
    bf16* XB = (bf16*)(F.ws + WS_S0); float* RS0 = (float*)(F.ws + WS_RS0);
    for (int m = gw; m < T; m += NGW) {
        const f32x4* xr = (const f32x4*)(inp(0) + (size_t)m * DM) + F.lane;
        f32x4 v[4]; float s = 0.f;
#pragma unroll
        for (int j = 0; j < 4; ++j) { v[j] = xr[64 * j]; s += (v[j][0] * v[j][0] + v[j][1] * v[j][1]) + (v[j][2] * v[j][2] + v[j][3] * v[j][3]); }
        s = wave_sum(s);
        if (F.lane == 0) RS0[m] = 1.0f / sqrtf(s * (1.0f / DM) + EPS);
        v2u* o8 = (v2u*)(XB + (size_t)m * DM) + F.lane;
#pragma unroll
        for (int j = 0; j < 4; ++j) { v2u w; w.x = pk2(v[j][0], v[j][1]); w.y = pk2(v[j][2], v[j][3]); o8[64 * j] = w; }
    }
    float* RC = (float*)(F.ws + WS_ROPE); float* RSn = RC + (size_t)SEQ * 64;
    for (int idx = gw * 64 + F.lane; idx < SEQ * 64; idx += NGW * 64) {
        const int pos = idx >> 6, i = idx & 63;
        const float inv = ROPE_INV[i];
        const float ang = (float)pos * inv; float s, c; sincos_acc(ang, s, c);
        RC[idx] = c; RSn[idx] = s;
    }
}

constexpr int XB_PITCH = 272;
constexpr int XB_TILE = 256 * XB_PITCH;
__device__ __forceinline__ void scan_unit(Frame& F, const bool PASS2, int b, int c, int n) {
    LAS unsigned char* XBt = F.lds; LAS unsigned char* SGt = F.lds + XB_TILE;
    const bf16* UX = (const bf16*)(F.ws + WS_S1); const bf16* SG = (const bf16*)(F.ws + WS_S2); bf16* Y = (bf16*)(F.ws + WS_S0);
    float* SUMA = (float*)(F.ws + WS_SUMA); float* SUMB = (float*)(F.ws + WS_SUMB);
    const int t0 = c * BLK; const size_t rowbase = (size_t)b * SEQ + t0;
    {
        const int cg = F.tid & 15, tr = F.tid >> 4, chb = n * 128 + cg * 8;
        float w[4][8], bia[8];
#pragma unroll
        for (int k = 0; k < 4; ++k) { const f32x4 a = *(const f32x4*)(inp(3) + k * DM + chb), bb = *(const f32x4*)(inp(3) + k * DM + chb + 4);
            w[k][0] = a[0]; w[k][1] = a[1]; w[k][2] = a[2]; w[k][3] = a[3]; w[k][4] = bb[0]; w[k][5] = bb[1]; w[k][6] = bb[2]; w[k][7] = bb[3]; }
        { const f32x4 a = *(const f32x4*)(inp(4) + chb), bb = *(const f32x4*)(inp(4) + chb + 4); bia[0] = a[0]; bia[1] = a[1]; bia[2] = a[2]; bia[3] = a[3]; bia[4] = bb[0]; bia[5] = bb[1]; bia[6] = bb[2]; bia[7] = bb[3]; }
        v4u raw[11];
#pragma unroll
        for (int i = 0; i < 11; ++i) { const int t = 8 * tr + i - 3; const bool ok = (c > 0) || (t >= 0);
            raw[i] = ok ? *(const v4u*)(UX + (size_t)((long)rowbase + t) * DM + chb) : (v4u){0u, 0u, 0u, 0u}; }
#pragma unroll
        for (int i = 0; i < 8; ++i) { float o[8];
#pragma unroll
            for (int e = 0; e < 8; ++e) o[e] = bia[e];
#pragma unroll
            for (int k = 0; k < 4; ++k) { const v4u r = raw[i + k];
                o[0] += w[k][0] * bflo(r.x); o[1] += w[k][1] * bfhi(r.x); o[2] += w[k][2] * bflo(r.y); o[3] += w[k][3] * bfhi(r.y);
                o[4] += w[k][4] * bflo(r.z); o[5] += w[k][5] * bfhi(r.z); o[6] += w[k][6] * bflo(r.w); o[7] += w[k][7] * bfhi(r.w); }
            v4u pk; pk.x = pk2(o[0], o[1]); pk.y = pk2(o[2], o[3]); pk.z = pk2(o[4], o[5]); pk.w = pk2(o[6], o[7]);
            *(LAS v4u*)(XBt + (8 * tr + i) * XB_PITCH + cg * 16) = pk; }
    }
    if (PASS2) {
#pragma unroll
        for (int it = 0; it < 8; ++it) { const int id = F.tid + 512 * it, row = id >> 4, ch = id & 15;
            const v4u v = *(const v4u*)(SG + (rowbase + row) * DM + n * 128 + ch * 8);
            *(LAS v4u*)(SGt + row * XB_PITCH + ch * 16) = v; }
    }
    __syncthreads();
    {
        const int w = F.wave, cl = F.lane & 15, q = F.lane >> 4;
        const bf16* WRG = (const bf16*)(F.ws + WS_WRG);
        bf16x8 Br[4], Bi[4];
#pragma unroll
        for (int ks = 0; ks < 4; ++ks) { Br[ks] = *(const bf16x8*)(WRG + (size_t)(n * 256 + 16 * w + cl) * 128 + 32 * ks + 8 * q);
                                         Bi[ks] = *(const bf16x8*)(WRG + (size_t)(n * 256 + 128 + 16 * w + cl) * 128 + 32 * ks + 8 * q); }
        const int ch = n * 128 + 16 * w + cl;
        const float rb = inp(6)[ch], ib = inp(8)[ch], lam = inp(9)[ch];
        const float z = -lam; const float sp = fmaxf(z, 0.f) + log1pf(expf(-fabsf(z)));
        const float c8 = -8.0f * sp;
        float Arun = 1.f, Brun = 0.f, h = 0.f;
        if (PASS2) {
            for (int cc = 0; cc < c; ++cc) { const float A = SUMA[(size_t)(b * 64 + cc) * DM + ch], Bv = SUMB[(size_t)(b * 64 + cc) * DM + ch]; h = A * h + Bv; }
        }
        for (int mt = 0; mt < 16; ++mt) {
            pg8::f32x4 accR = {0.f, 0.f, 0.f, 0.f}, accI = {0.f, 0.f, 0.f, 0.f};
#pragma unroll
            for (int ks = 0; ks < 4; ++ks) { const bf16x8 a = *(const LAS bf16x8*)(XBt + (16 * mt + cl) * XB_PITCH + (32 * ks + 8 * q) * 2);
                accR = __builtin_amdgcn_mfma_f32_16x16x32_bf16(a, Br[ks], accR, 0, 0, 0);
                accI = __builtin_amdgcn_mfma_f32_16x16x32_bf16(a, Bi[ks], accI, 0, 0, 0); }
            float av[4], bv[4]; float Ac = 1.f, Bc = 0.f;
#pragma unroll
            for (int r = 0; r < 4; ++r) { const int tok = 16 * mt + 4 * q + r;
                const float xv = bf1(*(const LAS unsigned short*)(XBt + tok * XB_PITCH + (16 * w + cl) * 2));
                const float rg = sigmoidf_(accR[r] + rb), ig = sigmoidf_(accI[r] + ib);
                const float la = c8 * rg; const float a = fast_exp2(la * 1.4426950408889634f);
                const float x2 = 2.f * la;
                float em1;
                if (x2 > -0.3f) { float pz = 1.0f / 720.0f; pz = pz * x2 + 1.0f / 120.0f; pz = pz * x2 + 1.0f / 24.0f; pz = pz * x2 + 1.0f / 6.0f; pz = pz * x2 + 0.5f; pz = pz * x2 + 1.0f; em1 = -x2 * pz; }
                else em1 = 1.0f - a * a;
                const float mult = sqrtf(em1);
                av[r] = a; bv[r] = mult * ig * xv;
                Bc = a * Bc + bv[r]; Ac *= a; }
            float Ak[4], Bk[4];
#pragma unroll
            for (int k = 0; k < 4; ++k) { Ak[k] = __shfl(Ac, cl + 16 * k); Bk[k] = __shfl(Bc, cl + 16 * k); }
            if (!PASS2) {
#pragma unroll
                for (int k = 0; k < 4; ++k) { Brun = Ak[k] * Brun + Bk[k]; Arun *= Ak[k]; }
            } else {
                float hq = h;
#pragma unroll
                for (int k = 0; k < 3; ++k) if (k < q) hq = Ak[k] * hq + Bk[k];
#pragma unroll
                for (int r = 0; r < 4; ++r) { const int tok = 16 * mt + 4 * q + r; hq = av[r] * hq + bv[r];
                    LAS unsigned short* sp2 = (LAS unsigned short*)(SGt + tok * XB_PITCH + (16 * w + cl) * 2);
                    const float g = bf1(*sp2); *sp2 = (unsigned short)f2bf(hq * g); }
#pragma unroll
                for (int k = 0; k < 4; ++k) h = Ak[k] * h + Bk[k];
            }
        }
        if (!PASS2) { if (q == 0) { SUMA[(size_t)(b * 64 + c) * DM + ch] = Arun; SUMB[(size_t)(b * 64 + c) * DM + ch] = Brun; } }
    }
    __syncthreads();
    if (PASS2) {
#pragma unroll
        for (int it = 0; it < 8; ++it) { const int id = F.tid + 512 * it, row = id >> 4, ch = id & 15;
            const v4u v = *(const LAS v4u*)(SGt + row * XB_PITCH + ch * 16);
            *(v4u*)(Y + (rowbase + row) * DM + n * 128 + ch * 8) = v; }
        __syncthreads();
    }
}

__device__ __forceinline__ void fix_unit(Frame& F, int b, int blk, int h, int which  ) {
    bf16* BUF = (bf16*)(F.ws + (which ? WS_S0 : WS_S1));
    const float* G = which ? inp(16) : inp(13);
    const float* RC = (const float*)(F.ws + WS_ROPE); const float* RSn = RC + (size_t)SEQ * 64;
    LAS float* red = (LAS float*)F.lds;
    const int k16 = F.tid & 15, ts = F.tid >> 4;
    float g[8];
    { const f32x4 a = *(const f32x4*)(G + 4 * k16), bb = *(const f32x4*)(G + 64 + 4 * k16); g[0] = a[0]; g[1] = a[1]; g[2] = a[2]; g[3] = a[3]; g[4] = bb[0]; g[5] = bb[1]; g[6] = bb[2]; g[7] = bb[3]; }
    const float osc = which ? QSCALE : 1.0f;
    float km[8] = {0.f, 0.f, 0.f, 0.f, 0.f, 0.f, 0.f, 0.f};
#pragma unroll 2
    for (int it = 0; it < 8; ++it) {
        const int tl = ts + 32 * it, pos = blk * BLK + tl; const size_t row = (size_t)b * SEQ + pos;
        bf16* p = BUF + row * DM + h * 128 + 8 * k16;
        const v4u raw = *(const v4u*)p;
        float v[8] = {bflo(raw.x), bfhi(raw.x), bflo(raw.y), bfhi(raw.y), bflo(raw.z), bfhi(raw.z), bflo(raw.w), bfhi(raw.w)};
        float ss = 0.f;
#pragma unroll
        for (int e = 0; e < 8; ++e) ss += v[e] * v[e];
        ss += __shfl_xor(ss, 1); ss += __shfl_xor(ss, 2); ss += __shfl_xor(ss, 4); ss += __shfl_xor(ss, 8);
        const float rinv = 1.0f / sqrtf(ss * (1.0f / HD) + EPS);
        const f32x4 cs = *(const f32x4*)(RC + (size_t)pos * 64 + 4 * k16), sn = *(const f32x4*)(RSn + (size_t)pos * 64 + 4 * k16);
        float o[8];
#pragma unroll
        for (int e = 0; e < 4; ++e) { const float x1 = v[e] * rinv * g[e], x2 = v[4 + e] * rinv * g[4 + e];
            o[e] = (x1 * cs[e] - x2 * sn[e]) * osc; o[4 + e] = (x2 * cs[e] + x1 * sn[e]) * osc; }
#pragma unroll
        for (int e = 0; e < 8; ++e) km[e] += o[e];
        v4u w; w.x = pk2(o[0], o[1]); w.y = pk2(o[2], o[3]); w.z = pk2(o[4], o[5]); w.w = pk2(o[6], o[7]);
        *(v4u*)p = w;
    }
    if (which == 0) {
#pragma unroll
        for (int e = 0; e < 8; ++e) red[ts * 128 + 8 * k16 + e] = km[e];
        __syncthreads();
        if (F.tid < 128) { float s = 0.f;
#pragma unroll 8
            for (int j = 0; j < 32; ++j) s += red[j * 128 + F.tid];
            ((float*)(F.ws + WS_KMEAN))[((size_t)(b * NH + h) * NBLK + blk) * HD + F.tid] = s * (1.0f / BLK); }
        __syncthreads();
    }
}

#define KSWZ(row, colB) ((row) * 256 + ((colB) ^ (((row) & 7) << 4)))
__device__ __forceinline__ int crow(int r, int hi) { return (r & 3) + 8 * (r >> 2) + 4 * hi; }
__device__ __forceinline__ int v_st(int k, int c) { const int kk = (k & ~0xC) | ((k & 4) << 1) | ((k & 8) >> 1); return ((kk >> 3) * 4 + (c >> 5)) * 512 + ((kk & 7) * 32 + (c & 31)) * 2; }
__device__ __forceinline__ int v_rd_base(int lane) { return ((lane & 3) << 3) | (((lane >> 2) & 3) << 6) | (((lane >> 4) & 1) << 5) | (((lane >> 5) & 1) << 8); }
constexpr int v_rd_off(int d0, int ks, int half) { return d0 * 512 + ks * 4096 + half * 2048; }
template <int OFF> __device__ __forceinline__ s16x4 tr_read(int vb) {
    s16x4 r; asm volatile("ds_read_b64_tr_b16 %0, %1 offset:%2" : "=&v"(r) : "v"(vb), "i"(OFF) : "memory"); return r;
}
__device__ __forceinline__ void qkt_acc(f32x16& p0, f32x16& p1, const LAS unsigned char* Ks, const bf16x8 (&qr)[8], int r32, int hi) {
#pragma unroll
    for (int d0 = 0; d0 < 8; ++d0) { const int cb = (d0 * 16 + hi * 8) * 2;
        const bf16x8 b0 = *(const LAS bf16x8*)(Ks + KSWZ(r32, cb));
        const bf16x8 b1 = *(const LAS bf16x8*)(Ks + KSWZ(32 + r32, cb));
        p0 = __builtin_amdgcn_mfma_f32_32x32x16_bf16(b0, qr[d0], p0, 0, 0, 0);
        p1 = __builtin_amdgcn_mfma_f32_32x32x16_bf16(b1, qr[d0], p1, 0, 0, 0); }
}
template <int D0> __device__ __forceinline__ void pv_one(f32x16& od, int vb, bf16x8 pa0, bf16x8 pa1, bf16x8 pa2, bf16x8 pa3) {
    const s16x4 l0 = tr_read<v_rd_off(D0, 0, 0)>(vb), h0 = tr_read<v_rd_off(D0, 0, 1)>(vb), l1 = tr_read<v_rd_off(D0, 1, 0)>(vb), h1 = tr_read<v_rd_off(D0, 1, 1)>(vb);
    const s16x4 l2 = tr_read<v_rd_off(D0, 2, 0)>(vb), h2 = tr_read<v_rd_off(D0, 2, 1)>(vb), l3 = tr_read<v_rd_off(D0, 3, 0)>(vb), h3 = tr_read<v_rd_off(D0, 3, 1)>(vb);
    asm volatile("s_waitcnt lgkmcnt(0)" ::: "memory"); SBAR();
#define PKV(L, H) (bf16x8){L[0], L[1], L[2], L[3], H[0], H[1], H[2], H[3]}
    od = __builtin_amdgcn_mfma_f32_32x32x16_bf16(PKV(l0, h0), pa0, od, 0, 0, 0);
    od = __builtin_amdgcn_mfma_f32_32x32x16_bf16(PKV(l1, h1), pa1, od, 0, 0, 0);
    od = __builtin_amdgcn_mfma_f32_32x32x16_bf16(PKV(l2, h2), pa2, od, 0, 0, 0);
    od = __builtin_amdgcn_mfma_f32_32x32x16_bf16(PKV(l3, h3), pa3, od, 0, 0, 0);
#undef PKV
}
__device__ __forceinline__ void attn_subtile(f32x16 (&o)[4], float& m, float& l, const LAS unsigned char* Ks, int vb, const bf16x8 (&qr)[8], int r32, int hi, bool diag, int kb0, int qidx) {
    f32x16 p0 = {}, p1 = {};
    qkt_acc(p0, p1, Ks, qr, r32, hi);
    if (diag) {
#pragma unroll
        for (int r = 0; r < 16; ++r) { const int kk = kb0 + crow(r, hi); if (kk > qidx) p0[r] = -1e30f; if (kk + 32 > qidx) p1[r] = -1e30f; }
    }
    float pmax = p0[0];
#pragma unroll
    for (int r = 1; r < 16; ++r) pmax = fmaxf(pmax, p0[r]);
#pragma unroll
    for (int r = 0; r < 16; ++r) pmax = fmaxf(pmax, p1[r]);
    { auto rr = __builtin_amdgcn_permlane32_swap(__float_as_uint(pmax), __float_as_uint(pmax), false, false);
      pmax = fmaxf(__uint_as_float(rr[0]), __uint_as_float(rr[1])); }
    const float mn = fmaxf(m, pmax); const float alpha = fast_exp2(m - mn); m = mn;
    float ps = 0.f;
#pragma unroll
    for (int r = 0; r < 16; ++r) { p0[r] = fast_exp2(p0[r] - mn); ps += p0[r]; }
#pragma unroll
    for (int r = 0; r < 16; ++r) { p1[r] = fast_exp2(p1[r] - mn); ps += p1[r]; }
    { auto rr = __builtin_amdgcn_permlane32_swap(__float_as_uint(ps), __float_as_uint(ps), false, false);
      ps = __uint_as_float(rr[0]) + __uint_as_float(rr[1]); }
    l = l * alpha + ps;
    if (!__all(alpha == 1.0f)) {
#pragma unroll
        for (int d = 0; d < 4; ++d)
#pragma unroll
            for (int r = 0; r < 16; ++r) o[d][r] *= alpha;
    }
    bf16x8 pa0, pa1, pa2, pa3;
#define PK4(P, BASE, OUT) do { unsigned a0 = pk2(P[BASE + 0], P[BASE + 1]), a1 = pk2(P[BASE + 2], P[BASE + 3]);   \
    unsigned b0 = pk2(P[BASE + 4], P[BASE + 5]), b1 = pk2(P[BASE + 6], P[BASE + 7]);                              \
    auto r0 = __builtin_amdgcn_permlane32_swap(a0, b0, false, false); auto r1 = __builtin_amdgcn_permlane32_swap(a1, b1, false, false); \
    v4u w = {r0[0], r1[0], r0[1], r1[1]}; OUT = __builtin_bit_cast(bf16x8, w); } while (0)
    PK4(p0, 0, pa0); PK4(p0, 8, pa1); PK4(p1, 0, pa2); PK4(p1, 8, pa3);
#undef PK4
    pv_one<0>(o[0], vb, pa0, pa1, pa2, pa3); pv_one<1>(o[1], vb, pa0, pa1, pa2, pa3); pv_one<2>(o[2], vb, pa0, pa1, pa2, pa3); pv_one<3>(o[3], vb, pa0, pa1, pa2, pa3);
}
__device__ __forceinline__ void row_store_T(unsigned char* rowp, const f32x16 (&o)[4], float sc, int hi, bool pred) {
#pragma unroll
    for (int j = 0; j < 8; ++j) { const int d0 = j >> 1, g0 = (j & 1) * 2;
        unsigned ax = pk2(o[d0][4 * g0 + 0] * sc, o[d0][4 * g0 + 1] * sc), ay = pk2(o[d0][4 * g0 + 2] * sc, o[d0][4 * g0 + 3] * sc);
        unsigned bx = pk2(o[d0][4 * g0 + 4] * sc, o[d0][4 * g0 + 5] * sc), by = pk2(o[d0][4 * g0 + 6] * sc, o[d0][4 * g0 + 7] * sc);
        auto r0 = __builtin_amdgcn_permlane32_swap(ax, bx, false, false); auto r1 = __builtin_amdgcn_permlane32_swap(ay, by, false, false);
        const v4u w = {r0[0], r1[0], r0[1], r1[1]};
        if (pred) *(v4u*)(rowp + 32 * j + 16 * hi) = w; }
}
__device__ __forceinline__ void row_load_T(const unsigned char* rowp, f32x16 (&v)[4], int hi) {
    v4u w[8];
#pragma unroll
    for (int j = 0; j < 8; ++j) w[j] = *(const v4u*)(rowp + 32 * j + 16 * hi);
#pragma unroll
    for (int j = 0; j < 8; ++j) { const int d0 = j >> 1, g0 = (j & 1) * 2;
        auto r0 = __builtin_amdgcn_permlane32_swap(w[j].x, w[j].z, false, false); auto r1 = __builtin_amdgcn_permlane32_swap(w[j].y, w[j].w, false, false);
        const unsigned ax = r0[0], bx = r0[1], ay = r1[0], by = r1[1];
        v[d0][4 * g0 + 0] = bflo(ax); v[d0][4 * g0 + 1] = bfhi(ax); v[d0][4 * g0 + 2] = bflo(ay); v[d0][4 * g0 + 3] = bfhi(ay);
        v[d0][4 * g0 + 4] = bflo(bx); v[d0][4 * g0 + 5] = bfhi(bx); v[d0][4 * g0 + 6] = bflo(by); v[d0][4 * g0 + 7] = bfhi(by); }
}
constexpr int KIMG = 0, VIMG = 65536, ATT_AUX = 131072;
__device__ __forceinline__ void load_kv_block(Frame& F, int b, int h, int j) {
    const bf16* KB = (const bf16*)(F.ws + WS_S1); const bf16* VB = (const bf16*)(F.ws + WS_S2);
    const size_t base = ((size_t)b * SEQ + (size_t)j * BLK) * DM + h * 128;
    v4u kr[8], vr[8];
#pragma unroll
    for (int it = 0; it < 8; ++it) { const int id = F.tid + 512 * it, row = id >> 4, c = id & 15;
        kr[it] = *(const v4u*)(KB + base + (size_t)row * DM + c * 8); vr[it] = *(const v4u*)(VB + base + (size_t)row * DM + c * 8); }
#pragma unroll
    for (int it = 0; it < 8; ++it) { const int id = F.tid + 512 * it, row = id >> 4, c = id & 15;
        *(LAS v4u*)(F.lds + KIMG + (row >> 6) * 16384 + KSWZ(row & 63, c * 16)) = kr[it];
        *(LAS v4u*)(F.lds + VIMG + (row >> 6) * 16384 + v_st(row & 63, c * 8)) = vr[it]; }
}

__device__ __forceinline__ void select_unit(Frame& F, int b, int h, int qb) {
    LAS unsigned char* KH = F.lds; LAS unsigned char* KL = F.lds + 16384;
    LAS int* cnt = (LAS int*)(F.lds + 32768); LAS int* cursor = cnt + 64; LAS int* offs = cnt + 128; LAS unsigned short* ent = (LAS unsigned short*)(F.lds + 32768 + 1024);
    const float* KM = (const float*)(F.ws + WS_KMEAN) + (size_t)(b * NH + h) * NBLK * HD;
    const bf16* QB = (const bf16*)(F.ws + WS_S0);
    unsigned short* ENT = (unsigned short*)(F.ws + WS_ENT) + (size_t)((b * NH + h) * NBLK + qb) * 768;
    unsigned short* OFFS = (unsigned short*)(F.ws + WS_OFFS) + (size_t)((b * NH + h) * NBLK + qb) * OFFS_PITCH;
    unsigned* NTOT = (unsigned*)(F.ws + WS_CTL) + CW_NTOT + (b * NH + h) * NBLK;
#pragma unroll
    for (int it = 0; it < 2; ++it) { const int id = F.tid + 512 * it, row = id >> 4, c = id & 15;
        const f32x4 a = *(const f32x4*)(KM + row * HD + c * 8), bb = *(const f32x4*)(KM + row * HD + c * 8 + 4);
        float v[8] = {a[0], a[1], a[2], a[3], bb[0], bb[1], bb[2], bb[3]}; unsigned hw[8]; float lo[8];
#pragma unroll
        for (int e = 0; e < 8; ++e) { if (row >= qb) v[e] = 0.f; hw[e] = f2bf(v[e]); lo[e] = v[e] - __builtin_bit_cast(float, hw[e] << 16); }
        v4u wh = {hw[0] | (hw[1] << 16), hw[2] | (hw[3] << 16), hw[4] | (hw[5] << 16), hw[6] | (hw[7] << 16)};
        v4u wl = {pk2(lo[0], lo[1]), pk2(lo[2], lo[3]), pk2(lo[4], lo[5]), pk2(lo[6], lo[7])};
        *(LAS v4u*)(KH + KSWZ(row, c * 16)) = wh; *(LAS v4u*)(KL + KSWZ(row, c * 16)) = wl; }
    if (F.tid < 64) cnt[F.tid] = 0;
    __syncthreads();
    const int r32 = F.lane & 31, hi = F.lane >> 5, ql = 32 * F.wave + r32;
    const size_t tok = (size_t)b * SEQ + qb * BLK + ql;
    bf16x8 qr[8];
#pragma unroll
    for (int d0 = 0; d0 < 8; ++d0) qr[d0] = *(const bf16x8*)(QB + tok * DM + h * 128 + d0 * 16 + hi * 8);
    f32x16 p0 = {}, p1 = {};
    qkt_acc(p0, p1, KH, qr, r32, hi); qkt_acc(p0, p1, KL, qr, r32, hi);
    float cv[32]; int ci[32];
#pragma unroll
    for (int r = 0; r < 16; ++r) { const int j0 = crow(r, hi), j1 = 32 + crow(r, hi);
        cv[r] = j0 < qb ? p0[r] : -INFINITY; ci[r] = j0; cv[16 + r] = j1 < qb ? p1[r] : -INFINITY; ci[16 + r] = j1; }
    float tv[3]; int ti[3];
#pragma unroll
    for (int pass = 0; pass < 3; ++pass) { float bv = -INFINITY; int bi = 1000;
#pragma unroll
        for (int r = 0; r < 32; ++r) { const bool excl = (pass > 0 && ci[r] == ti[0]) || (pass > 1 && ci[r] == ti[1]);
            const bool take = !excl && ((cv[r] > bv) || (cv[r] == bv && ci[r] < bi)); bv = take ? cv[r] : bv; bi = take ? ci[r] : bi; }
        tv[pass] = bv; ti[pass] = bi; }
    float mv[6]; int mi[6];
#pragma unroll
    for (int k = 0; k < 3; ++k) { mv[k] = tv[k]; mi[k] = ti[k]; mv[3 + k] = __shfl_xor(tv[k], 32); mi[3 + k] = __shfl_xor(ti[k], 32); }
    int fi[3];
#pragma unroll
    for (int pass = 0; pass < 3; ++pass) { float bv = -INFINITY; int bi = 1000;
#pragma unroll
        for (int r = 0; r < 6; ++r) { const bool excl = (pass > 0 && mi[r] == fi[0]) || (pass > 1 && mi[r] == fi[1]);
            const bool take = !excl && ((mv[r] > bv) || (mv[r] == bv && mi[r] < bi)); bv = take ? mv[r] : bv; bi = take ? mi[r] : bi; }
        fi[pass] = bi; }
    const int i1 = fi[0], i2 = fi[1], i3 = fi[2];
    const int nv = qb < 3 ? qb : 3;
    const int js[3] = {i1, i2, i3};
    if (hi == 0) {
#pragma unroll
        for (int s = 0; s < 3; ++s) if (s < nv) __hip_atomic_fetch_add(&cnt[js[s]], 1, __ATOMIC_RELAXED, __HIP_MEMORY_SCOPE_WORKGROUP);
    }
    __syncthreads();
    if (F.wave == 0) {
        const int c = cnt[F.lane]; int incl = c;
#pragma unroll
        for (int o = 1; o < 64; o <<= 1) { const int t = __shfl_up(incl, o); if (F.lane >= o) incl += t; }
        offs[F.lane + 1] = incl; cursor[F.lane] = incl - c; if (F.lane == 0) offs[0] = 0;
        OFFS[F.lane + 1] = (unsigned short)incl; if (F.lane == 0) OFFS[0] = 0;
        if (F.lane < qb && c > 0) atomicAdd(&NTOT[F.lane], (unsigned)c);
    }
    __syncthreads();
    if (hi == 0) {
#pragma unroll
        for (int s = 0; s < 3; ++s) if (s < nv) { const int idx = __hip_atomic_fetch_add(&cursor[js[s]], 1, __ATOMIC_RELAXED, __HIP_MEMORY_SCOPE_WORKGROUP); ent[idx] = (unsigned short)(ql | (s << 8)); }
    }
    __syncthreads();
    const int tot = offs[64];
    for (int i = F.tid; i < tot; i += 512) ENT[i] = ent[i];
    __syncthreads();
}

__device__ __forceinline__ void gathered_attention(Frame& F) {
    LAS int* PFX = (LAS int*)(F.lds + ATT_AUX); LAS int* NT = PFX + 1024; LAS int* TMP = NT + 1024;
    LAS int* cumI = TMP + 1024; LAS int* segoff = cumI + 64; LAS int* qinfo = segoff + 64;
    const unsigned* NTOT = (const unsigned*)(F.ws + WS_CTL) + CW_NTOT;
    const bf16* QB = (const bf16*)(F.ws + WS_S0);
    unsigned char* PART = F.ws + WS_S3; float* LSE = (float*)(F.ws + WS_LSE);
    for (int i = F.tid; i < 1024; i += 512) { const int n = (int)NTOT[i]; NT[i] = n; PFX[i] = (n + 255) >> 8; }
    __syncthreads();
    for (int d = 1; d < 1024; d <<= 1) {
        for (int i = F.tid; i < 1024; i += 512) TMP[i] = PFX[i] + (i >= d ? PFX[i - d] : 0);
        __syncthreads();
        for (int i = F.tid; i < 1024; i += 512) PFX[i] = TMP[i];
        __syncthreads();
    }
    const int S_tot = PFX[1023];
    const int s_lo = (int)(((long)F.vcu * S_tot) / F.G), s_hi = (int)(((long)(F.vcu + 1) * S_tot) / F.G);
    const int r32 = F.lane & 31, hi = F.lane >> 5;
    const int vbase = (int)(uintptr_t)(F.lds + VIMG) + v_rd_base(F.lane);
    int cur_u = -1, ub = 0, uh = 0, uj = 0;
    for (int s = s_lo; s < s_hi; ++s) {
        int lo = 0, hi_ = 1023;
        while (lo < hi_) { const int mid = (lo + hi_) >> 1; if (PFX[mid] > s) hi_ = mid; else lo = mid + 1; }
        const int u = lo; const int k = s - (u ? PFX[u - 1] : 0); const int n = NT[u];
        __syncthreads();
        if (u != cur_u) {
            cur_u = u; ub = u >> 9; uh = (u >> 6) & 7; uj = u & 63;
            load_kv_block(F, ub, uh, uj);
            if (F.wave == 0) {
                const int qb = F.lane; int o0 = 0, o1 = 0;
                if (qb > uj) { const unsigned short* OF = (const unsigned short*)(F.ws + WS_OFFS) + (size_t)((ub * NH + uh) * NBLK + qb) * OFFS_PITCH; o0 = OF[uj]; o1 = OF[uj + 1]; }
                int incl = o1 - o0;
#pragma unroll
                for (int o = 1; o < 64; o <<= 1) { const int t = __shfl_up(incl, o); if (F.lane >= o) incl += t; }
                cumI[qb] = incl; segoff[qb] = o0;
            }
        }
        __syncthreads();
        if (F.tid < 256) {
            const int e = k * 256 + F.tid; int info = -1;
            if (e < n) {
                int a = 0, c = 63;
                while (a < c) { const int mid = (a + c) >> 1; if (cumI[mid] > e) c = mid; else a = mid + 1; }
                const int qb = a; const int idx = e - (qb ? cumI[qb - 1] : 0);
                const unsigned short en = ((const unsigned short*)(F.ws + WS_ENT))[(size_t)((ub * NH + uh) * NBLK + qb) * 768 + segoff[qb] + idx];
                info = (qb * BLK + (en & 255)) | ((en >> 8) << 16);
            }
            qinfo[F.tid] = info;
        }
        __syncthreads();
        const int info = qinfo[32 * F.wave + r32]; const bool valid = info >= 0;
        if (__any(valid)) {
            const int pos = valid ? (info & 0xffff) : 0, slot = valid ? (info >> 16) : 0;
            const size_t tok = (size_t)ub * SEQ + pos;
            bf16x8 qr[8];
#pragma unroll
            for (int d0 = 0; d0 < 8; ++d0) qr[d0] = *(const bf16x8*)(QB + tok * DM + uh * 128 + d0 * 16 + hi * 8);
            f32x16 o[4] = {}; float m = -1e30f, l = 0.f;
#pragma unroll 1
            for (int t = 0; t < 4; ++t) attn_subtile(o, m, l, F.lds + KIMG + t * 16384, vbase + t * 16384, qr, r32, hi, false, 0, 0);
            const float il = __builtin_amdgcn_rcpf(l);
            const size_t prow = (tok * NH + uh) * 3 + slot;
            row_store_T(PART + prow * 256, o, il, hi, valid);
            if (valid && hi == 0) LSE[(tok * NH + uh) * 4 + slot] = m + __builtin_amdgcn_logf(l);
        }
    }
    __syncthreads();
}

__device__ __forceinline__ void own_unit(Frame& F, int b, int h, int qb) {
    bf16* QB = (bf16*)(F.ws + WS_S0); const bf16* SG2 = (const bf16*)(F.ws + WS_S6);
    const unsigned char* PART = F.ws + WS_S3; const float* LSE = (const float*)(F.ws + WS_LSE);
    load_kv_block(F, b, h, qb);
    __syncthreads();
    const int r32 = F.lane & 31, hi = F.lane >> 5, w = F.wave, ql = 32 * w + r32;
    const int vbase = (int)(uintptr_t)(F.lds + VIMG) + v_rd_base(F.lane);
    const size_t tok = (size_t)b * SEQ + qb * BLK + ql;
    bf16x8 qr[8];
#pragma unroll
    for (int d0 = 0; d0 < 8; ++d0) qr[d0] = *(const bf16x8*)(QB + tok * DM + h * 128 + d0 * 16 + hi * 8);
    f32x16 o[4] = {}; float m = -1e30f, l = 0.f;
    const int tdiag = w >> 1;
#pragma unroll 1
    for (int t = 0; t <= tdiag; ++t) attn_subtile(o, m, l, F.lds + KIMG + t * 16384, vbase + t * 16384, qr, r32, hi, t == tdiag, 64 * t, ql);
    const int nv = qb < 3 ? qb : 3;
    float L[3]; float Mx = m;
#pragma unroll
    for (int s = 0; s < 3; ++s) { L[s] = (s < nv) ? LSE[(tok * NH + h) * 4 + s] : -1e30f; Mx = fmaxf(Mx, L[s]); }
    const float wo = fast_exp2(m - Mx); float den = l * wo;
#pragma unroll
    for (int d = 0; d < 4; ++d)
#pragma unroll
        for (int r = 0; r < 16; ++r) o[d][r] *= wo;
#pragma unroll 1
    for (int s = 0; s < nv; ++s) {
        const float ws_ = fast_exp2(L[s] - Mx); den += ws_;
        f32x16 pv[4]; row_load_T(PART + ((tok * NH + h) * 3 + s) * 256, pv, hi);
#pragma unroll
        for (int d = 0; d < 4; ++d)
#pragma unroll
            for (int r = 0; r < 16; ++r) o[d][r] += ws_ * pv[d][r];
    }
    const float iden = __builtin_amdgcn_rcpf(den);
    { f32x16 gv[4]; row_load_T((const unsigned char*)(SG2 + tok * DM + h * 128), gv, hi);
#pragma unroll
      for (int d = 0; d < 4; ++d)
#pragma unroll
          for (int r = 0; r < 16; ++r) o[d][r] *= gv[d][r]; }
    row_store_T((unsigned char*)(QB + tok * DM + h * 128), o, iden, hi, true);
    __syncthreads();
}

constexpr int N_PHASES = 11;
__global__ void __launch_bounds__(512, 2) hawk_moba_fwd(Args args) {
    extern __shared__ __attribute__((aligned(16))) unsigned char lds_raw[];
    Frame F;
    F.lds = (LAS unsigned char*)lds_raw;
    F.tid = threadIdx.x; F.lane = F.tid & 63; F.wave = __builtin_amdgcn_readfirstlane(F.tid >> 6);
    F.G = gridDim.x; { const int bx = blockIdx.x; F.vcu = (F.G % 8 == 0) ? (bx % 8) * (F.G / 8) + bx / 8 : bx; }
    F.out = args.out; F.ws = args.ws;
    volatile LAS unsigned* MISC = (volatile LAS unsigned*)(F.lds + MISC_OFF);
    if (F.tid < 64) MISC[F.tid] = 0u;
    __syncthreads();
    unsigned* ctl = (unsigned*)(F.ws + WS_CTL);
    XcdBarrier bar; bar.bar = ctl + CW_BAR; bar.x = 0; bar.st = nullptr;
    const int lo = args.ph_lo, hi = args.ph_hi;
    if (hi - lo > 1) bar = xcd_barrier_post(ctl + CW_BAR, MISC + 8);
#define IN(k) (lo <= (k) && (k) < hi)
#define SEAM(k) do { if (IN(k) && IN((k) + 1)) xcd_barrier(bar); } while (0)

#define RUN_GEMM(MODE, AOFF, BOFF, NN) do { \
        pg8::Gemm g{(const pg8::bf16_t*)(F.ws + (AOFF)), (const pg8::bf16_t*)(F.ws + (BOFF)), T, (NN), DM}; \
        pg8::EpiAll E{(MODE), F.ws, F.out}; pg8::StaticOrder S; S.init(T, (NN), F.G, (int)blockIdx.x); \
        pg8::gemm_phase<pg8::EpiAll, pg8::StaticOrder, true, true>(F.lds, g, S, E); } while (0)
    if (IN(0)) { p0_prologue(F); } SEAM(0);
    if (IN(1)) { RUN_GEMM(0, WS_S0, WS_WAIN, 2048); } SEAM(1);
    if (IN(2)) { for (int u = F.vcu; u < 1024; u += F.G) scan_unit(F, false, u >> 9, (u >> 3) & 63, u & 7); } SEAM(2);
    if (IN(3)) { for (int u = F.vcu; u < 1024; u += F.G) scan_unit(F, true, u >> 9, (u >> 3) & 63, u & 7); } SEAM(3);
    if (IN(4)) { RUN_GEMM(1, WS_S0, WS_WAOUT, DM); } SEAM(4);
    if (IN(5)) { RUN_GEMM(2, WS_S3, WS_WB1, 4096); } SEAM(5);
    if (IN(6)) { for (int u = F.vcu; u < 2048; u += F.G) fix_unit(F, (u >> 10) & 1, (u >> 4) & 63, (u >> 1) & 7, u & 1); } SEAM(6);
    if (IN(7)) { for (int u = F.vcu; u < 1024; u += F.G) { const int qb = u & 63; if (qb > 0) select_unit(F, u >> 9, (u >> 6) & 7, qb); } } SEAM(7);
    if (IN(8)) { gathered_attention(F); } SEAM(8);
    if (IN(9)) { for (int u = F.vcu; u < 1024; u += F.G) own_unit(F, u >> 9, (u >> 6) & 7, u & 63); } SEAM(9);
    if (IN(10)) { RUN_GEMM(3, WS_S0, WS_WBOUT, DM); }
#undef RUN_GEMM
#undef IN
#undef SEAM
}

extern "C" void kernel_launch(void* const* d_in, const int* in_sizes, int n_in, void* d_out, int out_size, void* d_ws, size_t ws_size, hipStream_t stream) {
    static int grid = 0;
    if (grid == 0) {
        if (n_in != 18 || in_sizes[0] != T * DM || out_size != T * DM || ws_size < WS_END) { fprintf(stderr, "kernel_launch: unexpected shapes (n_in %d, in0 %d, out %d, ws %zu < %zu)\n", n_in, n_in > 0 ? in_sizes[0] : -1, out_size, ws_size, (size_t)WS_END); grid = -1; return; }
        int dev = 0, cus = 0, per_cu = 0;
        if (hipGetDevice(&dev) != hipSuccess || hipDeviceGetAttribute(&cus, hipDeviceAttributeMultiprocessorCount, dev) != hipSuccess) { grid = -1; return; }
        if (hipFuncSetAttribute((const void*)hawk_moba_fwd, hipFuncAttributeMaxDynamicSharedMemorySize, LDS_BYTES) != hipSuccess) { fprintf(stderr, "kernel_launch: hipFuncSetAttribute failed\n"); grid = -1; return; }
        if (hipOccupancyMaxActiveBlocksPerMultiprocessor(&per_cu, (const void*)hawk_moba_fwd, 512, LDS_BYTES) != hipSuccess || per_cu < 1) { fprintf(stderr, "kernel_launch: occupancy query says %d blocks per CU\n", per_cu); (void)hipGetLastError(); grid = -1; return; }
        grid = cus;
    }
    if (grid < 0) return;
    (void)hipMemsetAsync((char*)d_ws + WS_CTL, 0, CTL_ZERO_BYTES, stream);
    Args a{};
    for (int i = 0; i < 18; ++i) a.in[i] = (const float*)d_in[i];
    a.out = (float*)d_out; a.ws = (unsigned char*)d_ws;
#if MK_N_LAUNCHES == 1
    a.ph_lo = 0; a.ph_hi = N_PHASES;
    hipLaunchKernelGGL(hawk_moba_fwd, dim3(grid), dim3(512), LDS_BYTES, stream, a);
#else
    for (int p = 0; p <= MK_LAST_PHASE; ++p) { a.ph_lo = p; a.ph_hi = p + 1; hipLaunchKernelGGL(hawk_moba_fwd, dim3(grid), dim3(512), LDS_BYTES, stream, a); }
#endif
}
```

```cpp
#include <hip/hip_runtime.h>
#include <cstdio>
#include <cstdint>

#ifndef MK_N_LAUNCHES
#define MK_N_LAUNCHES 1
#endif
#ifndef MK_PHMASK
#define MK_PHMASK 0x7ff
#endif
#ifndef MK_LAST_PHASE
#define MK_LAST_PHASE 10
#endif

namespace pg8 {
#define PG8_LAS __attribute__((address_space(3)))
typedef unsigned short bf16_t;
typedef short bf16x8 __attribute__((ext_vector_type(8)));
typedef float f32x4 __attribute__((ext_vector_type(4)));
typedef unsigned u32x4 __attribute__((ext_vector_type(4)));
typedef unsigned u32x2 __attribute__((ext_vector_type(2)));
constexpr int BM = 256, BK = 64, HALF = 128, HTB = HALF * BK * 2, STAGE_BYTES = 8 * HTB, NXCD = 8, WGM = 8;

__host__ __device__ __forceinline__ int lds_byte(int r, int c) { const int st = (r >> 4) * 2 + (c >> 5), rr = r & 15, cc = c & 31, ob = rr * 64 + cc * 2; return st * 1024 + (ob ^ (((ob >> 9) & 1) << 5)); }
__host__ __device__ __forceinline__ void stage_rc(int b, int& R, int& C) { const int st = b / 1024, sb = b % 1024, swz = sb ^ (((sb >> 9) & 1) << 5); R = (st >> 1) * 16 + swz / 64; C = (st & 1) * 32 + (swz % 64) / 2; }
__host__ __device__ __forceinline__ int perm32(int rho) { const int n = rho >> 4, i = rho & 15; return 8 * (i >> 2) + 4 * n + (i & 3); }

struct Unit { int pm, pn; };
struct Gemm { const bf16_t* A; const bf16_t* Bt; int M, N, K; };

struct StaticOrder {
    int nM, nN, nwg, G, c;
    __host__ __device__ void init(int M, int N, int G_, int c_) { nM = M / BM; nN = N / BM; nwg = nM * nN; G = G_; c = c_; }
    __host__ __device__ bool next(int i, Unit& u) const {
        const long L = (long)i * G + c; if (L >= nwg) return false;
        int wgid = (int)L; { const int q = nwg / NXCD, r = nwg % NXCD, xcd = wgid % NXCD, off = wgid / NXCD; wgid = (xcd < r ? xcd * (q + 1) : r * (q + 1) + (xcd - r) * q) + off; }
        const int nig = WGM * nN, gid = wgid / nig, fm = gid * WGM, gsz = (nM - fm) < WGM ? (nM - fm) : WGM;
        u.pm = fm + ((wgid % nig) % gsz); u.pn = (wgid % nig) / gsz; return true;
    }
    __device__ __forceinline__ void a_ready(const Unit&) const {}
    __device__ __forceinline__ void done(const Unit&) const {}
};

__device__ __forceinline__ unsigned cvt_pk_bf16(float lo, float hi) { unsigned r; asm volatile("v_cvt_pk_bf16_f32 %0, %1, %2" : "=v"(r) : "v"(lo), "v"(hi)); return r; }

template <class Epi, class Sched, bool ALIGN_EPI = false, bool SP2 = false>
__device__ __forceinline__ void gemm_phase(PG8_LAS unsigned char* lds, const Gemm g, const Sched& S, const Epi& E) {
    const int tid = threadIdx.x, wid = __builtin_amdgcn_readfirstlane(tid >> 6), lane = tid & 63, wr = wid >> 2, wc = wid & 3, fr = lane & 15, fq = lane >> 4;
    const int K = g.K, nt = K / BK;
    unsigned voffA[2], voffB[2];
#pragma unroll
    for (int i = 0; i < 2; ++i) { int R, C; stage_rc(tid * 16 + i * 8192, R, C); const int Rb = Epi::PERM ? ((R & ~31) + perm32(R & 31)) : R;
        voffA[i] = (unsigned)(R * K + C) * 2u; voffB[i] = (unsigned)(Rb * K + C) * 2u; }
    const size_t kstep = (size_t)(BK * 2);
    const size_t hstep = (size_t)HALF * K * 2;
    const size_t tstep = 2 * hstep;
    const unsigned ldsw = (unsigned)wid * 1024u;
    const int aoff = lds_byte(wr * 64 + fr, fq * 8), boff = lds_byte(wc * 32 + fr, fq * 8);
#define PG8_SA(b, h) (((b) * 2 + (h)) * HTB)
#define PG8_SB(b, h) ((4 + (b) * 2 + (h)) * HTB)
#define PG8_STAGE(bufoff, gbase, voff) do { _Pragma("unroll") for (int _i = 0; _i < 2; ++_i) \
        __builtin_amdgcn_global_load_lds((const unsigned*)((const char*)(gbase) + (voff)[_i]), (PG8_LAS unsigned*)(lds + (bufoff) + ldsw + _i * 8192), 16, 0, 0); } while (0)
#define PG8_LDA(dst, b, h) do { _Pragma("unroll") for (int m = 0; m < 4; ++m) _Pragma("unroll") for (int k = 0; k < 2; ++k) dst[m][k] = *(const PG8_LAS bf16x8*)(lds + PG8_SA(b, h) + aoff + m * 2048 + k * 1024); } while (0)
#define PG8_LDB(dst, b, h) do { _Pragma("unroll") for (int n = 0; n < 2; ++n) _Pragma("unroll") for (int k = 0; k < 2; ++k) dst[n][k] = *(const PG8_LAS bf16x8*)(lds + PG8_SB(b, h) + boff + n * 2048 + k * 1024); } while (0)
#define PG8_MMA(ai, bj, At, Bt) do { __builtin_amdgcn_s_setprio(1); _Pragma("unroll") for (int m = 0; m < 4; ++m) _Pragma("unroll") for (int n = 0; n < 2; ++n) _Pragma("unroll") for (int k = 0; k < 2; ++k) \
        acc[ai][bj][m][n] = __builtin_amdgcn_mfma_f32_16x16x32_bf16(Bt[n][k], At[m][k], acc[ai][bj][m][n], 0, 0, 0); __builtin_amdgcn_s_setprio(0); } while (0)
#define PG8_WAIT_V(n) asm volatile("s_waitcnt vmcnt(" #n ")" ::: "memory")
#define PG8_WAIT_L(n) asm volatile("s_waitcnt lgkmcnt(" #n ")" ::: "memory")
#define PG8_BAR __builtin_amdgcn_s_barrier()
#define PG8_SCHED __builtin_amdgcn_sched_barrier(0)
    Unit cur, nxt; int ui = 0;
    if (!S.next(0, cur)) return;
    f32x4 acc[2][2][4][2];
#pragma unroll
    for (int a = 0; a < 2; ++a)
#pragma unroll
        for (int b = 0; b < 2; ++b)
#pragma unroll
            for (int m = 0; m < 4; ++m)
#pragma unroll
                for (int n = 0; n < 2; ++n) acc[a][b][m][n] = (f32x4){0.f, 0.f, 0.f, 0.f};
    bf16x8 At[4][2], B0[2][2], B1[2][2];
    const char* cA = (const char*)g.A + (size_t)cur.pm * tstep; const char* cB = (const char*)g.Bt + (size_t)cur.pn * tstep;
    S.a_ready(cur);
    if constexpr (SP2) {
        PG8_STAGE(PG8_SB(0, 0), cB, voffB); PG8_STAGE(PG8_SB(0, 1), cB + hstep, voffB); PG8_STAGE(PG8_SA(0, 0), cA, voffA); PG8_STAGE(PG8_SA(0, 1), cA + hstep, voffA);
        if (wr == 1) PG8_BAR;
        PG8_WAIT_V(2); PG8_BAR;
        PG8_STAGE(PG8_SB(1, 0), cB + kstep, voffB); PG8_STAGE(PG8_SA(1, 0), cA + kstep, voffA); PG8_STAGE(PG8_SB(1, 1), cB + hstep + kstep, voffB);
        PG8_WAIT_V(6); PG8_BAR;
    } else {
        PG8_STAGE(PG8_SB(0, 0), cB, voffB); PG8_STAGE(PG8_SA(0, 0), cA, voffA); PG8_STAGE(PG8_SB(0, 1), cB + hstep, voffB); PG8_STAGE(PG8_SA(0, 1), cA + hstep, voffA);
        if (wr == 1) PG8_BAR;
        PG8_WAIT_V(4); PG8_BAR;
        PG8_STAGE(PG8_SB(1, 0), cB + kstep, voffB); PG8_STAGE(PG8_SA(1, 0), cA + kstep, voffA); PG8_STAGE(PG8_SB(1, 1), cB + hstep + kstep, voffB);
        PG8_WAIT_V(6); PG8_BAR;
    }
    for (;;) {
        const bool has_next = S.next(ui + 1, nxt);
        const char* nA = has_next ? (const char*)g.A + (size_t)nxt.pm * tstep : cA; const char* nB = has_next ? (const char*)g.Bt + (size_t)nxt.pn * tstep : cB;
        for (int t = 0; t < nt; t += 2) {
            const bool last = (t == nt - 2);
            const char* a1 = cA + (size_t)(t + 1) * kstep;
            const char* a2 = last ? nA : cA + (size_t)(t + 2) * kstep; const char* b2 = last ? nB : cB + (size_t)(t + 2) * kstep;
            const char* a3 = a2 + kstep; const char* b3 = b2 + kstep;
            if (last && has_next) S.a_ready(nxt);
            if constexpr (SP2) {
            PG8_LDB(B0, 0, 0); PG8_LDB(B1, 0, 1); PG8_SCHED; PG8_LDA(At, 0, 0); PG8_STAGE(PG8_SA(1, 1), a1 + hstep, voffA);
            PG8_WAIT_V(8); PG8_WAIT_L(0); PG8_BAR; PG8_MMA(0, 0, At, B0); PG8_MMA(0, 1, At, B1); PG8_BAR; PG8_SCHED;
            PG8_LDA(At, 0, 1); PG8_STAGE(PG8_SB(0, 0), b2, voffB); PG8_STAGE(PG8_SB(0, 1), b2 + hstep, voffB); PG8_STAGE(PG8_SA(0, 0), a2, voffA);
            PG8_WAIT_V(8); PG8_WAIT_L(0); PG8_BAR; PG8_MMA(1, 0, At, B0); PG8_MMA(1, 1, At, B1); PG8_BAR; PG8_SCHED;
            PG8_LDB(B0, 1, 0); PG8_LDB(B1, 1, 1); PG8_SCHED; PG8_LDA(At, 1, 0); PG8_STAGE(PG8_SA(0, 1), a2 + hstep, voffA);
            PG8_WAIT_V(8); PG8_WAIT_L(0); PG8_BAR; PG8_MMA(0, 0, At, B0); PG8_MMA(0, 1, At, B1); PG8_BAR; PG8_SCHED;
            PG8_LDA(At, 1, 1); PG8_STAGE(PG8_SB(1, 0), b3, voffB); PG8_STAGE(PG8_SB(1, 1), b3 + hstep, voffB); PG8_STAGE(PG8_SA(1, 0), a3, voffA);
            PG8_WAIT_V(8); PG8_WAIT_L(0); PG8_BAR; PG8_MMA(1, 0, At, B0); PG8_MMA(1, 1, At, B1); PG8_BAR; PG8_SCHED;
            } else {
            PG8_LDB(B0, 0, 0); PG8_SCHED; PG8_LDA(At, 0, 0); PG8_STAGE(PG8_SA(1, 1), a1 + hstep, voffA);
            PG8_WAIT_L(8); PG8_BAR; PG8_WAIT_L(0); PG8_MMA(0, 0, At, B0); PG8_BAR; PG8_SCHED;
            PG8_LDB(B1, 0, 1); PG8_STAGE(PG8_SB(0, 0), b2, voffB);
            PG8_BAR; PG8_WAIT_L(0); PG8_MMA(0, 1, At, B1); PG8_BAR;
            PG8_LDA(At, 0, 1); PG8_STAGE(PG8_SA(0, 0), a2, voffA);
            PG8_BAR; PG8_WAIT_L(0); PG8_MMA(1, 0, At, B0); PG8_BAR; PG8_SCHED;
            PG8_STAGE(PG8_SB(0, 1), b2 + hstep, voffB);
            PG8_WAIT_V(6); PG8_BAR; PG8_MMA(1, 1, At, B1); PG8_BAR;
            PG8_LDB(B0, 1, 0); PG8_SCHED; PG8_LDA(At, 1, 0); PG8_STAGE(PG8_SA(0, 1), a2 + hstep, voffA);
            PG8_WAIT_L(8); PG8_BAR; PG8_WAIT_L(0); PG8_MMA(0, 0, At, B0); PG8_BAR; PG8_SCHED;
            PG8_LDB(B1, 1, 1); PG8_STAGE(PG8_SB(1, 0), b3, voffB);
            PG8_BAR; PG8_WAIT_L(0); PG8_MMA(0, 1, At, B1); PG8_BAR;
            PG8_LDA(At, 1, 1); PG8_STAGE(PG8_SA(1, 0), a3, voffA);
            PG8_BAR; PG8_WAIT_L(0); PG8_MMA(1, 0, At, B0); PG8_BAR; PG8_SCHED;
            PG8_STAGE(PG8_SB(1, 1), b3 + hstep, voffB);
            PG8_WAIT_V(6); PG8_BAR; PG8_MMA(1, 1, At, B1); PG8_BAR;
            }
        }
        if constexpr (ALIGN_EPI) { if (wr == 0) PG8_BAR; }
        E(acc, cur, wr, wc, fr, fq); S.done(cur);
        if (!has_next) break;
#pragma unroll
        for (int a = 0; a < 2; ++a)
#pragma unroll
            for (int b = 0; b < 2; ++b)
#pragma unroll
                for (int m = 0; m < 4; ++m)
#pragma unroll
                    for (int n = 0; n < 2; ++n) acc[a][b][m][n] = (f32x4){0.f, 0.f, 0.f, 0.f};
        cur = nxt; cA = nA; cB = nB; ++ui;
        if constexpr (ALIGN_EPI) { if (wr == 1) PG8_BAR; }
    }
    PG8_WAIT_V(0);
    if constexpr (!ALIGN_EPI) { if (wr == 0) PG8_BAR; }
    PG8_BAR;
#undef PG8_SA
#undef PG8_SB
#undef PG8_STAGE
#undef PG8_LDA
#undef PG8_LDB
#undef PG8_MMA
#undef PG8_WAIT_V
#undef PG8_WAIT_L
#undef PG8_BAR
#undef PG8_SCHED
}
}

constexpr int NBATCH = 2, SEQ = 16384, T = NBATCH * SEQ, DM = 1024, NH = 8, HD = 128, NBLK = 64, BLK = 256;
constexpr float EPS = 1e-6f;
constexpr float QSCALE = 0.088388347648318440f * 1.4426950408889634f;

constexpr size_t MiB = 1u << 20;
constexpr size_t WS_CTL = 0, CTL_ZERO_BYTES = 1 * MiB;
constexpr size_t WS_WAIN = 2 * MiB, WS_WAOUT = 6 * MiB, WS_WB1 = 8 * MiB, WS_WBOUT = 16 * MiB, WS_WRG = 18 * MiB;
constexpr size_t WS_RS0 = 19 * MiB;
constexpr size_t WS_SSQ1 = 20 * MiB;
constexpr size_t WS_ROPE = 22 * MiB;
constexpr size_t WS_SUMA = 30 * MiB, WS_SUMB = 30 * MiB + 512 * 1024;
constexpr size_t WS_KMEAN = 31 * MiB;
constexpr size_t WS_ENT = 32 * MiB;
constexpr size_t WS_OFFS = 34 * MiB;
constexpr size_t WS_LSE = 36 * MiB;
constexpr size_t SLOT = 64 * MiB;
constexpr size_t WS_S0 = 1 * SLOT;
constexpr size_t WS_S1 = 2 * SLOT;
constexpr size_t WS_S2 = 3 * SLOT;
constexpr size_t WS_S3 = 4 * SLOT;
constexpr size_t WS_S6 = 7 * SLOT;
constexpr size_t WS_END = 8 * SLOT;
constexpr int OFFS_PITCH = 72;
constexpr int CW_BAR = 4096;
constexpr int CW_NTOT = 16384;

constexpr int LDS_BYTES = 163840;
constexpr int MISC_OFF = LDS_BYTES - 256;

#define GAS __attribute__((address_space(1)))
#define LAS __attribute__((address_space(3)))
typedef unsigned short bf16;
typedef unsigned v4u __attribute__((ext_vector_type(4)));
typedef unsigned v2u __attribute__((ext_vector_type(2)));
typedef float f32x4 __attribute__((ext_vector_type(4)));
typedef float f32x16 __attribute__((ext_vector_type(16)));
typedef short bf16x8 __attribute__((ext_vector_type(8)));
typedef short s16x4 __attribute__((ext_vector_type(4)));
#define LDS_WAIT() asm volatile("s_waitcnt lgkmcnt(0)" ::: "memory")
#define VM_WAIT() asm volatile("s_waitcnt vmcnt(0)" ::: "memory")
#define SBAR() __builtin_amdgcn_sched_barrier(0)

__device__ __forceinline__ unsigned f2bf(float f) { unsigned u = __builtin_bit_cast(unsigned, f); return (u + 0x7fffu + ((u >> 16) & 1u)) >> 16; }
__device__ __forceinline__ unsigned pk2(float lo, float hi) { return pg8::cvt_pk_bf16(lo, hi); }
__device__ __forceinline__ float bflo(unsigned w) { return __builtin_bit_cast(float, w << 16); }
__device__ __forceinline__ float bfhi(unsigned w) { return __builtin_bit_cast(float, w & 0xffff0000u); }
__device__ __forceinline__ float bf1(unsigned short h) { return __builtin_bit_cast(float, ((unsigned)h) << 16); }
__device__ __forceinline__ float fast_exp2(float x) { return __builtin_amdgcn_exp2f(x); }
__device__ __forceinline__ float sigmoidf_(float v) { return __builtin_amdgcn_rcpf(1.f + fast_exp2(-v * 1.4426950408889634f)); }
__device__ __forceinline__ float siluf_(float v) { return v * sigmoidf_(v); }

#define XB_TMO      128
#define XB_XCNT(j)  (256  + 64 * (j))
#define XB_XSUB(j)  (1280 + 64 * (j))
#define XB_XGEN(j)  (2304 + 64 * (j))
#define XB_TOP      3328
#define XB_TOPGEN   3392
#define XCD_BAR_WORDS 3456
#define XB_SPIN_CAP (1u << 20)
__device__ __forceinline__ unsigned xb_ld(unsigned* p)              { return __hip_atomic_load(p, __ATOMIC_RELAXED, __HIP_MEMORY_SCOPE_AGENT); }
__device__ __forceinline__ unsigned xb_add(unsigned* p, unsigned v) { return __hip_atomic_fetch_add(p, v, __ATOMIC_RELAXED, __HIP_MEMORY_SCOPE_AGENT); }
__device__ __forceinline__ unsigned xb_xcc_id() { return (unsigned)__builtin_amdgcn_s_getreg((3 << 11) | 20) & 0xFu; }
#define XB_SPIN(cond, bar) do { unsigned _sp = 0; while (cond) { __builtin_amdgcn_s_sleep(1); \
    if ((++_sp & 255u) == 0u) { if (xb_ld(&(bar)[XB_TMO])) break; if (_sp > XB_SPIN_CAP) { atomicAdd(&(bar)[XB_TMO], 1u); break; } } } } while (0)
struct XcdBarrier { unsigned* bar; unsigned x; volatile LAS unsigned* st; };
__device__ __forceinline__ XcdBarrier xcd_barrier_post(unsigned* bar, volatile LAS unsigned* st) {
    XcdBarrier b; b.bar = bar; b.x = xb_xcc_id(); b.st = st;
    if (threadIdx.x == 0) (void)xb_add(&bar[XB_XCNT(b.x)], 1u);
    return b;
}
__device__ __forceinline__ void xcd_barrier_complete(unsigned* bar, unsigned x, unsigned& nloc, unsigned& nx) {
    const unsigned G = gridDim.x * gridDim.y * gridDim.z;
    unsigned sum, cnt, mine, sp = 0u;
    for (;;) {
        sum = 0u; cnt = 0u; mine = 0u;
#pragma unroll
        for (unsigned j = 0; j < 16; ++j) { const unsigned c = xb_ld(&bar[XB_XCNT(j)]); sum += c; cnt += (c > 0u) ? 1u : 0u; mine = (j == x) ? c : mine; }
        if (sum == G) break;
        __builtin_amdgcn_s_sleep(1);
        if ((++sp & 255u) == 0u) { if (xb_ld(&bar[XB_TMO])) break; if (sp > XB_SPIN_CAP) { atomicAdd(&bar[XB_TMO], 1u); break; } }
    }
    nloc = mine > 0u ? mine : 1u; nx = cnt > 0u ? cnt : 1u;
}
__device__ __forceinline__ void xcd_barrier(const XcdBarrier& b) {
    asm volatile("s_waitcnt vmcnt(0)" ::: "memory");
    __syncthreads();
    if (threadIdx.x == 0) {
        unsigned* bar = b.bar;
        __builtin_amdgcn_s_waitcnt(0);
        unsigned nloc = b.st[0], nx = b.st[1];
        if (nloc == 0u) { xcd_barrier_complete(bar, b.x, nloc, nx); b.st[0] = nloc; b.st[1] = nx; }
        const unsigned old = xb_add(&bar[XB_XSUB(b.x)], 1u);
        const unsigned gen = old / nloc;
        if (old + 1u == (gen + 1u) * nloc) {
            __builtin_amdgcn_fence(__ATOMIC_RELEASE, "agent");
            asm volatile("s_waitcnt vmcnt(0)" ::: "memory");
            const unsigned og = xb_add(&bar[XB_TOP], 1u);
            const unsigned tg = og / nx;
            if (og + 1u == (tg + 1u) * nx) xb_add(&bar[XB_TOPGEN], 1u);
            else XB_SPIN(xb_ld(&bar[XB_TOPGEN]) == tg, bar);
            __builtin_amdgcn_fence(__ATOMIC_ACQUIRE, "agent");
            xb_add(&bar[XB_XGEN(b.x)], 1u);
            asm volatile("s_waitcnt vmcnt(0)" ::: "memory");
        } else {
            XB_SPIN(xb_ld(&bar[XB_XGEN(b.x)]) == gen, bar);
            __builtin_amdgcn_fence(__ATOMIC_ACQUIRE, "agent");
            asm volatile("s_waitcnt vmcnt(0)" ::: "memory");
        }
    }
    __syncthreads();
}

struct Args { const float* in[18]; float* out; unsigned char* ws; int ph_lo, ph_hi; };
__device__ __forceinline__ const float* inp(int k) {
    const __attribute__((address_space(4))) Args* ap = (const __attribute__((address_space(4))) Args*)__builtin_amdgcn_kernarg_segment_ptr();
    asm volatile("" : "+s"(ap));
    return ap->in[k];
}
struct Frame {
    LAS unsigned char* lds;
    int tid, lane, wave, vcu, G;
    float* out;
    unsigned char* ws;
};
__device__ __forceinline__ float wave_sum(float v) {
#pragma unroll
    for (int o = 1; o < 64; o <<= 1) v += __shfl_xor(v, o);
    return v;
}

namespace pg8 {
struct EpiAll {
    static constexpr bool PERM = true, AFTER_DRAIN = false;
    int mode;
    unsigned char* ws;
    float* xout;
    __device__ __forceinline__ void operator()(const f32x4 (&acc)[2][2][4][2], const Unit& u, int wr, int wc, int fr, int fq) const {
        const int row0 = u.pm * BM + wr * 64 + fr;
        bf16_t* const o0 = (bf16_t*)(ws + (mode == 1 ? WS_S3 : WS_S1)); bf16_t* const o1 = (bf16_t*)(ws + WS_S2); bf16_t* const o2 = (bf16_t*)(ws + WS_S0); bf16_t* const o3 = (bf16_t*)(ws + WS_S6);
        const float* const rs = (const float*)(ws + (mode == 0 ? WS_RS0 : WS_SSQ1)); float* const ssq = (float*)(ws + WS_SSQ1);
        if (mode == 0 || mode == 2) {
            const int tt = u.pn >> 2; const bool act = (mode == 0) ? (tt == 1) : (tt == 3);
            bf16_t* base = tt == 0 ? o0 : (tt == 1 ? o1 : (tt == 2 ? o2 : o3)); const int col0 = (u.pn & 3) * BM + wc * 32 + 8 * fq;
#pragma unroll
            for (int ai = 0; ai < 2; ++ai)
#pragma unroll
                for (int m = 0; m < 4; ++m) { const int row = row0 + ai * HALF + m * 16; float s;
                    if (mode == 0) s = rs[row];
                    else { const f32x4* sp = (const f32x4*)(rs + (size_t)row * 16); const f32x4 s0 = sp[0], s1 = sp[1], s2 = sp[2], s3 = sp[3];
                        const float tot = ((s0[0] + s0[1]) + (s0[2] + s0[3])) + ((s1[0] + s1[1]) + (s1[2] + s1[3])) + ((s2[0] + s2[1]) + (s2[2] + s2[3])) + ((s3[0] + s3[1]) + (s3[2] + s3[3]));
                        s = 1.0f / sqrtf(tot * (1.0f / DM) + EPS); }
                    bf16_t* rowp = base + (size_t)row * DM + col0;
#pragma unroll
                    for (int bj = 0; bj < 2; ++bj) { f32x4 v0 = acc[ai][bj][m][0] * s, v1 = acc[ai][bj][m][1] * s;
                        if (act) {
#pragma unroll
                            for (int j = 0; j < 4; ++j) { v0[j] = siluf_(v0[j]); v1[j] = siluf_(v1[j]); } }
                        u32x4 w; w.x = cvt_pk_bf16(v0[0], v0[1]); w.y = cvt_pk_bf16(v0[2], v0[3]); w.z = cvt_pk_bf16(v1[0], v1[1]); w.w = cvt_pk_bf16(v1[2], v1[3]);
                        *(u32x4*)(rowp + bj * HALF) = w; } }
        } else if (mode == 1) {
            const float* const xin = inp(0);
            const int col0 = u.pn * BM + wc * 32 + 8 * fq;
#pragma unroll
            for (int ai = 0; ai < 2; ++ai)
#pragma unroll
                for (int m = 0; m < 4; ++m) { const int row = row0 + ai * HALF + m * 16; const size_t off = (size_t)row * DM + col0; float ss = 0.f;
#pragma unroll
                    for (int bj = 0; bj < 2; ++bj) { const f32x4 xa = *(const f32x4*)(xin + off + bj * HALF), xb = *(const f32x4*)(xin + off + bj * HALF + 4);
                        const f32x4 v0 = acc[ai][bj][m][0] + xa, v1 = acc[ai][bj][m][1] + xb;
                        *(f32x4*)(xout + off + bj * HALF) = v0; *(f32x4*)(xout + off + bj * HALF + 4) = v1;
                        ss += ((v0[0] * v0[0] + v0[1] * v0[1]) + (v0[2] * v0[2] + v0[3] * v0[3])) + ((v1[0] * v1[0] + v1[1] * v1[1]) + (v1[2] * v1[2] + v1[3] * v1[3]));
                        u32x4 w; w.x = cvt_pk_bf16(v0[0], v0[1]); w.y = cvt_pk_bf16(v0[2], v0[3]); w.z = cvt_pk_bf16(v1[0], v1[1]); w.w = cvt_pk_bf16(v1[2], v1[3]);
                        *(u32x4*)(o0 + off + bj * HALF) = w; }
                    ss += __shfl_xor(ss, 16); ss += __shfl_xor(ss, 32);
                    if (fq == 0) ssq[(size_t)row * 16 + u.pn * 4 + wc] = ss;
                    asm volatile("" ::: "memory"); }
        } else {
            const int col0 = u.pn * BM + wc * 32 + 8 * fq;
#pragma unroll
            for (int ai = 0; ai < 2; ++ai)
#pragma unroll
                for (int m = 0; m < 4; ++m) { const size_t off = (size_t)(row0 + ai * HALF + m * 16) * DM + col0;
#pragma unroll
                    for (int bj = 0; bj < 2; ++bj) { float* p = xout + off + bj * HALF; const f32x4 xa = *(const f32x4*)p, xb = *(const f32x4*)(p + 4);
                        *(f32x4*)p = acc[ai][bj][m][0] + xa; *(f32x4*)(p + 4) = acc[ai][bj][m][1] + xb; }
                    asm volatile("" ::: "memory"); }
        }
    }
};
}

__device__ __forceinline__ int fperm(int p) { return ((p >> 2) & 1) * 64 + (p >> 5) * 16 + ((p >> 3) & 3) * 4 + (p & 3); }
template <int MODE  >
__device__ __forceinline__ void p0_transpose_item(const float* W, int ldw, int Kd, bf16* WT, int drow0, const float* gain, LAS float* scr, int k0, int n0, int lane) {
    const int nn = n0 + (lane & 31);
    const int sc = (MODE == 1 && nn < 1024) ? ((nn & ~127) + fperm(nn & 127)) : nn;
#pragma unroll 8
    for (int i = 0; i < 32; ++i) { const int kk = 2 * i + (lane >> 5); float v = W[(size_t)(k0 + kk) * ldw + sc]; if (gain) v *= gain[k0 + kk]; scr[kk * 33 + (lane & 31)] = v; }
    LDS_WAIT(); asm volatile("" ::: "memory");
    const int c = lane & 7;
#pragma unroll
    for (int j = 0; j < 4; ++j) { const int n = (lane >> 3) + 8 * j; const LAS float* s = scr + (8 * c) * 33 + n;
        v4u o; o.x = pk2(s[0 * 33], s[1 * 33]); o.y = pk2(s[2 * 33], s[3 * 33]); o.z = pk2(s[4 * 33], s[5 * 33]); o.w = pk2(s[6 * 33], s[7 * 33]);
        *(v4u*)(WT + (size_t)(drow0 + n0 + n) * Kd + k0 + 8 * c) = o; }
    LDS_WAIT(); asm volatile("" ::: "memory");
}
__device__ __forceinline__ void sincos_acc(float angf, float& s, float& c) {
    const double a = (double)angf;
    const double k = __builtin_rint(a * 0.63661977236758134308);
    const double y = __builtin_fma(-k, 1.57079632679489661923, a) - k * 6.123233995736766e-17;
    const double y2 = y * y;
    double sp = -1.0 / 1307674368000.0; sp = sp * y2 + 1.0 / 6227020800.0; sp = sp * y2 - 1.0 / 39916800.0; sp = sp * y2 + 1.0 / 362880.0; sp = sp * y2 - 1.0 / 5040.0; sp = sp * y2 + 1.0 / 120.0; sp = sp * y2 - 1.0 / 6.0; sp = sp * y2 + 1.0;
    const double sy = sp * y;
    double cp = 1.0 / 20922789888000.0; cp = cp * y2 - 1.0 / 87178291200.0; cp = cp * y2 + 1.0 / 479001600.0; cp = cp * y2 - 1.0 / 3628800.0; cp = cp * y2 + 1.0 / 40320.0; cp = cp * y2 - 1.0 / 720.0; cp = cp * y2 + 1.0 / 24.0; cp = cp * y2 - 0.5; cp = cp * y2 + 1.0;
    const int q = ((int)k) & 3;
    const double ss = (q == 0) ? sy : (q == 1) ? cp : (q == 2) ? -sy : -cp;
    const double cc = (q == 0) ? cp : (q == 1) ? -sy : (q == 2) ? -cp : sy;
    s = (float)ss; c = (float)cc;
}
__device__ __forceinline__ void p0_prologue(Frame& F) {
    static constexpr float ROPE_INV[64] = {
        1.000000000e+00f, 8.659643531e-01f, 7.498942018e-01f, 6.493816376e-01f, 5.623413324e-01f, 4.869675338e-01f, 4.216965139e-01f, 3.651741147e-01f, 3.162277639e-01f, 2.738419771e-01f, 2.371373773e-01f, 2.053525001e-01f, 1.778279394e-01f, 1.539926529e-01f, 1.333521456e-01f, 1.154781953e-01f,
        1.000000015e-01f, 8.659642935e-02f, 7.498942316e-02f, 6.493816525e-02f, 5.623413250e-02f, 4.869675264e-02f, 4.216964915e-02f, 3.651741147e-02f, 3.162277490e-02f, 2.738419548e-02f, 2.371373773e-02f, 2.053525113e-02f, 1.778279431e-02f, 1.539926510e-02f, 1.333521400e-02f, 1.154781971e-02f,
        9.999999776e-03f, 8.659643121e-03f, 7.498942316e-03f, 6.493816152e-03f, 5.623413250e-03f, 4.869675264e-03f, 4.216964822e-03f, 3.651741194e-03f, 3.162277630e-03f, 2.738419687e-03f, 2.371373819e-03f, 2.053525066e-03f, 1.778279431e-03f, 1.539926510e-03f, 1.333521446e-03f, 1.154782018e-03f,
        1.000000047e-03f, 8.659643354e-04f, 7.498941850e-04f, 6.493816036e-04f, 5.623413017e-04f, 4.869675322e-04f, 4.216965172e-04f, 3.651741135e-04f, 3.162277571e-04f, 2.738419571e-04f, 2.371373703e-04f, 2.053525095e-04f, 1.778279402e-04f, 1.539926598e-04f, 1.333521504e-04f, 1.154782003e-04f};
    LAS float* scr = (LAS float*)(F.lds + F.wave * 16384);
    const int gw = F.vcu * 8 + F.wave, NGW = F.G * 8;
    bf16* WAIN = (bf16*)(F.ws + WS_WAIN); bf16* WAOUT = (bf16*)(F.ws + WS_WAOUT); bf16* WB1 = (bf16*)(F.ws + WS_WB1); bf16* WBOUT = (bf16*)(F.ws + WS_WBOUT); bf16* WRG = (bf16*)(F.ws + WS_WRG);
    constexpr int I0 = 16 * 64, I1 = 16 * 32, I2 = 16 * 64, I3 = 16 * 64, I4 = 16 * 32, I5 = 16 * 8;
    constexpr int NITEMS = I0 + I1 + I2 + I3 + I4 + I5;
    for (int it = gw; it < NITEMS; it += NGW) {
        int r = it;
        if (r < I0) { p0_transpose_item<0>(inp(2), 2048, DM, WAIN, 0, inp(1), scr, (r / 64) * 64, (r % 64) * 32, F.lane); continue; } r -= I0;
        if (r < I1) { p0_transpose_item<0>(inp(10), 1024, DM, WAOUT, 0, nullptr, scr, (r / 32) * 64, (r % 32) * 32, F.lane); continue; } r -= I1;
        if (r < I2) { p0_transpose_item<1>(inp(12), 2048, DM, WB1, 0, inp(11), scr, (r / 64) * 64, (r % 64) * 32, F.lane); continue; } r -= I2;
        if (r < I3) { p0_transpose_item<1>(inp(15), 2048, DM, WB1, 2048, inp(14), scr, (r / 64) * 64, (r % 64) * 32, F.lane); continue; } r -= I3;
        if (r < I4) { p0_transpose_item<0>(inp(17), 1024, DM, WBOUT, 0, nullptr, scr, (r / 32) * 64, (r % 32) * 32, F.lane); continue; } r -= I4;
        { const int mat = r >> 3, sub = r & 7, n = mat >> 1, which = mat & 1;
          const float* W = (which ? inp(7) : inp(5)) + (size_t)n * 128 * 128;
          p0_transpose_item<0>(W, 128, 128, WRG, n * 256 + which * 128, nullptr, scr, (sub >> 2) * 64, (sub & 3) * 32, F.lane); }
    }
    bf16* XB = (bf16*)(F.ws + WS_S0); float* RS0 = (float*)(F.ws + WS_RS0);
    for (int m = gw; m < T; m += NGW) {
        const f32x4* xr = (const f32x4*)(inp(0) + (size_t)m * DM) + F.lane;
        f32x4 v[4]; float s = 0.f;
#pragma unroll
        for (int j = 0; j < 4; ++j) { v[j] = xr[64 * j]; s += (v[j][0] * v[j][0] + v[j][1] * v[j][1]) + (v[j][2] * v[j][2] + v[j][3] * v[j][3]); }
        s = wave_sum(s);
        if (F.lane == 0) RS0[m] = 1.0f / sqrtf(s * (1.0f / DM) + EPS);
        v2u* o8 = (v2u*)(XB + (size_t)m * DM) + F.lane;
#pragma unroll
        for (int j = 0; j < 4; ++j) { v2u w; w.x = pk2(v[j][0], v[j][1]); w.y = pk2(v[j][2], v[j][3]); o8[64 * j] = w; }
    }
    float* RC = (float*)(F.ws + WS_ROPE); float* RSn = RC + (size_t)SEQ * 64;
    for (int idx = gw * 64 + F.lane; idx < SEQ * 64; idx += NGW * 64) {
        const int pos = idx >> 6, i = idx & 63;
        const float inv = ROPE_INV[i];
        const float ang = (float)pos * inv; float s, c; sincos_acc(ang, s, c);
        RC[idx] = c; RSn[idx] = s;
    }
}

constexpr int XB_PITCH = 272;
constexpr int XB_TILE = 256 * XB_PITCH;
__device__ __forceinline__ void scan_unit(Frame& F, const bool PASS2, int b, int c, int n) {
    LAS unsigned char* XBt = F.lds; LAS unsigned char* SGt = F.lds + XB_TILE;
    const bf16* UX = (const bf16*)(F.ws + WS_S1); const bf16* SG = (const bf16*)(F.ws + WS_S2); bf16* Y = (bf16*)(F.ws + WS_S0);
    float* SUMA = (float*)(F.ws + WS_SUMA); float* SUMB = (float*)(F.ws + WS_SUMB);
    const int t0 = c * BLK; const size_t rowbase = (size_t)b * SEQ + t0;
    {
        const int cg = F.tid & 15, tr = F.tid >> 4, chb = n * 128 + cg * 8;
        float w[4][8], bia[8];
#pragma unroll
        for (int k = 0; k < 4; ++k) { const f32x4 a = *(const f32x4*)(inp(3) + k * DM + chb), bb = *(const f32x4*)(inp(3) + k * DM + chb + 4);
            w[k][0] = a[0]; w[k][1] = a[1]; w[k][2] = a[2]; w[k][3] = a[3]; w[k][4] = bb[0]; w[k][5] = bb[1]; w[k][6] = bb[2]; w[k][7] = bb[3]; }
        { const f32x4 a = *(const f32x4*)(inp(4) + chb), bb = *(const f32x4*)(inp(4) + chb + 4); bia[0] = a[0]; bia[1] = a[1]; bia[2] = a[2]; bia[3] = a[3]; bia[4] = bb[0]; bia[5] = bb[1]; bia[6] = bb[2]; bia[7] = bb[3]; }
        v4u raw[11];
#pragma unroll
        for (int i = 0; i < 11; ++i) { const int t = 8 * tr + i - 3; const bool ok = (c > 0) || (t >= 0);
            raw[i] = ok ? *(const v4u*)(UX + (size_t)((long)rowbase + t) * DM + chb) : (v4u){0u, 0u, 0u, 0u}; }
#pragma unroll
        for (int i = 0; i < 8; ++i) { float o[8];
#pragma unroll
            for (int e = 0; e < 8; ++e) o[e] = bia[e];
#pragma unroll
            for (int k = 0; k < 4; ++k) { const v4u r = raw[i + k];
                o[0] += w[k][0] * bflo(r.x); o[1] += w[k][1] * bfhi(r.x); o[2] += w[k][2] * bflo(r.y); o[3] += w[k][3] * bfhi(r.y);
                o[4] += w[k][4] * bflo(r.z); o[5] += w[k][5] * bfhi(r.z); o[6] += w[k][6] * bflo(r.w); o[7] += w[k][7] * bfhi(r.w); }
            v4u pk; pk.x = pk2(o[0], o[1]); pk.y = pk2(o[2], o[3]); pk.z = pk2(o[4], o[5]); pk.w = pk2(o[6], o[7]);
            *(LAS v4u*)(XBt + (8 * tr + i) * XB_PITCH + cg * 16) = pk; }
    }
    if (PASS2) {
#pragma unroll
        for (int it = 0; it < 8; ++it) { const int id = F.tid + 512 * it, row = id >> 4, ch = id & 15;
            const v4u v = *(const v4u*)(SG + (rowbase + row) * DM + n * 128 + ch * 8);
            *(LAS v4u*)(SGt + row * XB_PITCH + ch * 16) = v; }
    }
    __syncthreads();
    {
        const int w = F.wave, cl = F.lane & 15, q = F.lane >> 4;
        const bf16* WRG = (const bf16*)(F.ws + WS_WRG);
        bf16x8 Br[4], Bi[4];
#pragma unroll
        for (int ks = 0; ks < 4; ++ks) { Br[ks] = *(const bf16x8*)(WRG + (size_t)(n * 256 + 16 * w + cl) * 128 + 32 * ks + 8 * q);
                                         Bi[ks] = *(const bf16x8*)(WRG + (size_t)(n * 256 + 128 + 16 * w + cl) * 128 + 32 * ks + 8 * q); }
        const int ch = n * 128 + 16 * w + cl;
        const float rb = inp(6)[ch], ib = inp(8)[ch], lam = inp(9)[ch];
        const float z = -lam; const float sp = fmaxf(z, 0.f) + log1pf(expf(-fabsf(z)));
        const float c8 = -8.0f * sp;
        float Arun = 1.f, Brun = 0.f, h = 0.f;
        if (PASS2) {
            for (int cc = 0; cc < c; ++cc) { const float A = SUMA[(size_t)(b * 64 + cc) * DM + ch], Bv = SUMB[(size_t)(b * 64 + cc) * DM + ch]; h = A * h + Bv; }
        }
        for (int mt = 0; mt < 16; ++mt) {
            pg8::f32x4 accR = {0.f, 0.f, 0.f, 0.f}, accI = {0.f, 0.f, 0.f, 0.f};
#pragma unroll
            for (int ks = 0; ks < 4; ++ks) { const bf16x8 a = *(const LAS bf16x8*)(XBt + (16 * mt + cl) * XB_PITCH + (32 * ks + 8 * q) * 2);
                accR = __builtin_amdgcn_mfma_f32_16x16x32_bf16(a, Br[ks], accR, 0, 0, 0);
                accI = __builtin_amdgcn_mfma_f32_16x16x32_bf16(a, Bi[ks], accI, 0, 0, 0); }
            float av[4], bv[4]; float Ac = 1.f, Bc = 0.f;
#pragma unroll
            for (int r = 0; r < 4; ++r) { const int tok = 16 * mt + 4 * q + r;
                const float xv = bf1(*(const LAS unsigned short*)(XBt + tok * XB_PITCH + (16 * w + cl) * 2));
                const float rg = sigmoidf_(accR[r] + rb), ig = sigmoidf_(accI[r] + ib);
                const float la = c8 * rg; const float a = fast_exp2(la * 1.4426950408889634f);
                const float x2 = 2.f * la;
                float em1;
                if (x2 > -0.3f) { float pz = 1.0f / 720.0f; pz = pz * x2 + 1.0f / 120.0f; pz = pz * x2 + 1.0f / 24.0f; pz = pz * x2 + 1.0f / 6.0f; pz = pz * x2 + 0.5f; pz = pz * x2 + 1.0f; em1 = -x2 * pz; }
                else em1 = 1.0f - a * a;
                const float mult = sqrtf(em1);
                av[r] = a; bv[r] = mult * ig * xv;
                Bc = a * Bc + bv[r]; Ac *= a; }
            float Ak[4], Bk[4];
#pragma unroll
            for (int k = 0; k < 4; ++k) { Ak[k] = __shfl(Ac, cl + 16 * k); Bk[k] = __shfl(Bc, cl + 16 * k); }
            if (!PASS2) {
#pragma unroll
                for (int k = 0; k < 4; ++k) { Brun = Ak[k] * Brun + Bk[k]; Arun *= Ak[k]; }
            } else {
                float hq = h;
#pragma unroll
                for (int k = 0; k < 3; ++k) if (k < q) hq = Ak[k] * hq + Bk[k];
#pragma unroll
                for (int r = 0; r < 4; ++r) { const int tok = 16 * mt + 4 * q + r; hq = av[r] * hq + bv[r];
                    LAS unsigned short* sp2 = (LAS unsigned short*)(SGt + tok * XB_PITCH + (16 * w + cl) * 2);
                    const float g = bf1(*sp2); *sp2 = (unsigned short)f2bf(hq * g); }
#pragma unroll
                for (int k = 0; k < 4; ++k) h = Ak[k] * h + Bk[k];
            }
        }
        if (!PASS2) { if (q == 0) { SUMA[(size_t)(b * 64 + c) * DM + ch] = Arun; SUMB[(size_t)(b * 64 + c) * DM + ch] = Brun; } }
    }
    __syncthreads();
    if (PASS2) {
#pragma unroll
        for (int it = 0; it < 8; ++it) { const int id = F.tid + 512 * it, row = id >> 4, ch = id & 15;
            const v4u v = *(const LAS v4u*)(SGt + row * XB_PITCH + ch * 16);
            *(v4u*)(Y + (rowbase + row) * DM + n * 128 + ch * 8) = v; }
        __syncthreads();
    }
}

__device__ __forceinline__ void fix_unit(Frame& F, int b, int blk, int h, int which  ) {
    bf16* BUF = (bf16*)(F.ws + (which ? WS_S0 : WS_S1));
    const float* G = which ? inp(16) : inp(13);
    const float* RC = (const float*)(F.ws + WS_ROPE); const float* RSn = RC + (size_t)SEQ * 64;
    LAS float* red = (LAS float*)F.lds;
    const int k16 = F.tid & 15, ts = F.tid >> 4;
    float g[8];
    { const f32x4 a = *(const f32x4*)(G + 4 * k16), bb = *(const f32x4*)(G + 64 + 4 * k16); g[0] = a[0]; g[1] = a[1]; g[2] = a[2]; g[3] = a[3]; g[4] = bb[0]; g[5] = bb[1]; g[6] = bb[2]; g[7] = bb[3]; }
    const float osc = which ? QSCALE : 1.0f;
    float km[8] = {0.f, 0.f, 0.f, 0.f, 0.f, 0.f, 0.f, 0.f};
#pragma unroll 2
    for (int it = 0; it < 8; ++it) {
        const int tl = ts + 32 * it, pos = blk * BLK + tl; const size_t row = (size_t)b * SEQ + pos;
        bf16* p = BUF + row * DM + h * 128 + 8 * k16;
        const v4u raw = *(const v4u*)p;
        float v[8] = {bflo(raw.x), bfhi(raw.x), bflo(raw.y), bfhi(raw.y), bflo(raw.z), bfhi(raw.z), bflo(raw.w), bfhi(raw.w)};
        float ss = 0.f;
#pragma unroll
        for (int e = 0; e < 8; ++e) ss += v[e] * v[e];
        ss += __shfl_xor(ss, 1); ss += __shfl_xor(ss, 2); ss += __shfl_xor(ss, 4); ss += __shfl_xor(ss, 8);
        const float rinv = 1.0f / sqrtf(ss * (1.0f / HD) + EPS);
        const f32x4 cs = *(const f32x4*)(RC + (size_t)pos * 64 + 4 * k16), sn = *(const f32x4*)(RSn + (size_t)pos * 64 + 4 * k16);
        float o[8];
#pragma unroll
        for (int e = 0; e < 4; ++e) { const float x1 = v[e] * rinv * g[e], x2 = v[4 + e] * rinv * g[4 + e];
            o[e] = (x1 * cs[e] - x2 * sn[e]) * osc; o[4 + e] = (x2 * cs[e] + x1 * sn[e]) * osc; }
#pragma unroll
        for (int e = 0; e < 8; ++e) km[e] += o[e];
        v4u w; w.x = pk2(o[0], o[1]); w.y = pk2(o[2], o[3]); w.z = pk2(o[4], o[5]); w.w = pk2(o[6], o[7]);
        *(v4u*)p = w;
    }
    if (which == 0) {
#pragma unroll
        for (int e = 0; e < 8; ++e) red[ts * 128 + 8 * k16 + e] = km[e];
        __syncthreads();
        if (F.tid < 128) { float s = 0.f;
#pragma unroll 8
            for (int j = 0; j < 32; ++j) s += red[j * 128 + F.tid];
            ((float*)(F.ws + WS_KMEAN))[((size_t)(b * NH + h) * NBLK + blk) * HD + F.tid] = s * (1.0f / BLK); }
        __syncthreads();
    }
}

#define KSWZ(row, colB) ((row) * 256 + ((colB) ^ (((row) & 7) << 4)))
__device__ __forceinline__ int crow(int r, int hi) { return (r & 3) + 8 * (r >> 2) + 4 * hi; }
__device__ __forceinline__ int v_st(int k, int c) { const int kk = (k & ~0xC) | ((k & 4) << 1) | ((k & 8) >> 1); return ((kk >> 3) * 4 + (c >> 5)) * 512 + ((kk & 7) * 32 + (c & 31)) * 2; }
__device__ __forceinline__ int v_rd_base(int lane) { return ((lane & 3) << 3) | (((lane >> 2) & 3) << 6) | (((lane >> 4) & 1) << 5) | (((lane >> 5) & 1) << 8); }
constexpr int v_rd_off(int d0, int ks, int half) { return d0 * 512 + ks * 4096 + half * 2048; }
template <int OFF> __device__ __forceinline__ s16x4 tr_read(int vb) {
    s16x4 r; asm volatile("ds_read_b64_tr_b16 %0, %1 offset:%2" : "=&v"(r) : "v"(vb), "i"(OFF) : "memory"); return r;
}
__device__ __forceinline__ void qkt_acc(f32x16& p0, f32x16& p1, const LAS unsigned char* Ks, const bf16x8 (&qr)[8], int r32, int hi) {
#pragma unroll
    for (int d0 = 0; d0 < 8; ++d0) { const int cb = (d0 * 16 + hi * 8) * 2;
        const bf16x8 b0 = *(const LAS bf16x8*)(Ks + KSWZ(r32, cb));
        const bf16x8 b1 = *(const LAS bf16x8*)(Ks + KSWZ(32 + r32, cb));
        p0 = __builtin_amdgcn_mfma_f32_32x32x16_bf16(b0, qr[d0], p0, 0, 0, 0);
        p1 = __builtin_amdgcn_mfma_f32_32x32x16_bf16(b1, qr[d0], p1, 0, 0, 0); }
}
template <int D0> __device__ __forceinline__ void pv_one(f32x16& od, int vb, bf16x8 pa0, bf16x8 pa1, bf16x8 pa2, bf16x8 pa3) {
    const s16x4 l0 = tr_read<v_rd_off(D0, 0, 0)>(vb), h0 = tr_read<v_rd_off(D0, 0, 1)>(vb), l1 = tr_read<v_rd_off(D0, 1, 0)>(vb), h1 = tr_read<v_rd_off(D0, 1, 1)>(vb);
    const s16x4 l2 = tr_read<v_rd_off(D0, 2, 0)>(vb), h2 = tr_read<v_rd_off(D0, 2, 1)>(vb), l3 = tr_read<v_rd_off(D0, 3, 0)>(vb), h3 = tr_read<v_rd_off(D0, 3, 1)>(vb);
    asm volatile("s_waitcnt lgkmcnt(0)" ::: "memory"); SBAR();
#define PKV(L, H) (bf16x8){L[0], L[1], L[2], L[3], H[0], H[1], H[2], H[3]}
    od = __builtin_amdgcn_mfma_f32_32x32x16_bf16(PKV(l0, h0), pa0, od, 0, 0, 0);
    od = __builtin_amdgcn_mfma_f32_32x32x16_bf16(PKV(l1, h1), pa1, od, 0, 0, 0);
    od = __builtin_amdgcn_mfma_f32_32x32x16_bf16(PKV(l2, h2), pa2, od, 0, 0, 0);
    od = __builtin_amdgcn_mfma_f32_32x32x16_bf16(PKV(l3, h3), pa3, od, 0, 0, 0);
#undef PKV
}
__device__ __forceinline__ void attn_subtile(f32x16 (&o)[4], float& m, float& l, const LAS unsigned char* Ks, int vb, const bf16x8 (&qr)[8], int r32, int hi, bool diag, int kb0, int qidx) {
    f32x16 p0 = {}, p1 = {};
    qkt_acc(p0, p1, Ks, qr, r32, hi);
    if (diag) {
#pragma unroll
        for (int r = 0; r < 16; ++r) { const int kk = kb0 + crow(r, hi); if (kk > qidx) p0[r] = -1e30f; if (kk + 32 > qidx) p1[r] = -1e30f; }
    }
    float pmax = p0[0];
#pragma unroll
    for (int r = 1; r < 16; ++r) pmax = fmaxf(pmax, p0[r]);
#pragma unroll
    for (int r = 0; r < 16; ++r) pmax = fmaxf(pmax, p1[r]);
    { auto rr = __builtin_amdgcn_permlane32_swap(__float_as_uint(pmax), __float_as_uint(pmax), false, false);
      pmax = fmaxf(__uint_as_float(rr[0]), __uint_as_float(rr[1])); }
    const float mn = fmaxf(m, pmax); const float alpha = fast_exp2(m - mn); m = mn;
    float ps = 0.f;
#pragma unroll
    for (int r = 0; r < 16; ++r) { p0[r] = fast_exp2(p0[r] - mn); ps += p0[r]; }
#pragma unroll
    for (int r = 0; r < 16; ++r) { p1[r] = fast_exp2(p1[r] - mn); ps += p1[r]; }
    { auto rr = __builtin_amdgcn_permlane32_swap(__float_as_uint(ps), __float_as_uint(ps), false, false);
      ps = __uint_as_float(rr[0]) + __uint_as_float(rr[1]); }
    l = l * alpha + ps;
    if (!__all(alpha == 1.0f)) {
#pragma unroll
        for (int d = 0; d < 4; ++d)
#pragma unroll
            for (int r = 0; r < 16; ++r) o[d][r] *= alpha;
    }
    bf16x8 pa0, pa1, pa2, pa3;
#define PK4(P, BASE, OUT) do { unsigned a0 = pk2(P[BASE + 0], P[BASE + 1]), a1 = pk2(P[BASE + 2], P[BASE + 3]);   \
    unsigned b0 = pk2(P[BASE + 4], P[BASE + 5]), b1 = pk2(P[BASE + 6], P[BASE + 7]);                              \
    auto r0 = __builtin_amdgcn_permlane32_swap(a0, b0, false, false); auto r1 = __builtin_amdgcn_permlane32_swap(a1, b1, false, false); \
    v4u w = {r0[0], r1[0], r0[1], r1[1]}; OUT = __builtin_bit_cast(bf16x8, w); } while (0)
    PK4(p0, 0, pa0); PK4(p0, 8, pa1); PK4(p1, 0, pa2); PK4(p1, 8, pa3);
#undef PK4
    pv_one<0>(o[0], vb, pa0, pa1, pa2, pa3); pv_one<1>(o[1], vb, pa0, pa1, pa2, pa3); pv_one<2>(o[2], vb, pa0, pa1, pa2, pa3); pv_one<3>(o[3], vb, pa0, pa1, pa2, pa3);
}
__device__ __forceinline__ void row_store_T(unsigned char* rowp, const f32x16 (&o)[4], float sc, int hi, bool pred) {
#pragma unroll
    for (int j = 0; j < 8; ++j) { const int d0 = j >> 1, g0 = (j & 1) * 2;
        unsigned ax = pk2(o[d0][4 * g0 + 0] * sc, o[d0][4 * g0 + 1] * sc), ay = pk2(o[d0][4 * g0 + 2] * sc, o[d0][4 * g0 + 3] * sc);
        unsigned bx = pk2(o[d0][4 * g0 + 4] * sc, o[d0][4 * g0 + 5] * sc), by = pk2(o[d0][4 * g0 + 6] * sc, o[d0][4 * g0 + 7] * sc);
        auto r0 = __builtin_amdgcn_permlane32_swap(ax, bx, false, false); auto r1 = __builtin_amdgcn_permlane32_swap(ay, by, false, false);
        const v4u w = {r0[0], r1[0], r0[1], r1[1]};
        if (pred) *(v4u*)(rowp + 32 * j + 16 * hi) = w; }
}
__device__ __forceinline__ void row_load_T(const unsigned char* rowp, f32x16 (&v)[4], int hi) {
    v4u w[8];
#pragma unroll
    for (int j = 0; j < 8; ++j) w[j] = *(const v4u*)(rowp + 32 * j + 16 * hi);
#pragma unroll
    for (int j = 0; j < 8; ++j) { const int d0 = j >> 1, g0 = (j & 1) * 2;
        auto r0 = __builtin_amdgcn_permlane32_swap(w[j].x, w[j].z, false, false); auto r1 = __builtin_amdgcn_permlane32_swap(w[j].y, w[j].w, false, false);
        const unsigned ax = r0[0], bx = r0[1], ay = r1[0], by = r1[1];
        v[d0][4 * g0 + 0] = bflo(ax); v[d0][4 * g0 + 1] = bfhi(ax); v[d0][4 * g0 + 2] = bflo(ay); v[d0][4 * g0 + 3] = bfhi(ay);
        v[d0][4 * g0 + 4] = bflo(bx); v[d0][4 * g0 + 5] = bfhi(bx); v[d0][4 * g0 + 6] = bflo(by); v[d0][4 * g0 + 7] = bfhi(by); }
}
constexpr int KIMG = 0, VIMG = 65536, ATT_AUX = 131072;
__device__ __forceinline__ void load_kv_block(Frame& F, int b, int h, int j) {
    const bf16* KB = (const bf16*)(F.ws + WS_S1); const bf16* VB = (const bf16*)(F.ws + WS_S2);
    const size_t base = ((size_t)b * SEQ + (size_t)j * BLK) * DM + h * 128;
    v4u kr[8], vr[8];
#pragma unroll
    for (int it = 0; it < 8; ++it) { const int id = F.tid + 512 * it, row = id >> 4, c = id & 15;
        kr[it] = *(const v4u*)(KB + base + (size_t)row * DM + c * 8); vr[it] = *(const v4u*)(VB + base + (size_t)row * DM + c * 8); }
#pragma unroll
    for (int it = 0; it < 8; ++it) { const int id = F.tid + 512 * it, row = id >> 4, c = id & 15;
        *(LAS v4u*)(F.lds + KIMG + (row >> 6) * 16384 + KSWZ(row & 63, c * 16)) = kr[it];
        *(LAS v4u*)(F.lds + VIMG + (row >> 6) * 16384 + v_st(row & 63, c * 8)) = vr[it]; }
}

__device__ __forceinline__ void select_unit(Frame& F, int b, int h, int qb) {
    LAS unsigned char* KH = F.lds; LAS unsigned char* KL = F.lds + 16384;
    LAS int* cnt = (LAS int*)(F.lds + 32768); LAS int* cursor = cnt + 64; LAS int* offs = cnt + 128; LAS unsigned short* ent = (LAS unsigned short*)(F.lds + 32768 + 1024);
    const float* KM = (const float*)(F.ws + WS_KMEAN) + (size_t)(b * NH + h) * NBLK * HD;
    const bf16* QB = (const bf16*)(F.ws + WS_S0);
    unsigned short* ENT = (unsigned short*)(F.ws + WS_ENT) + (size_t)((b * NH + h) * NBLK + qb) * 768;
    unsigned short* OFFS = (unsigned short*)(F.ws + WS_OFFS) + (size_t)((b * NH + h) * NBLK + qb) * OFFS_PITCH;
    unsigned* NTOT = (unsigned*)(F.ws + WS_CTL) + CW_NTOT + (b * NH + h) * NBLK;
#pragma unroll
    for (int it = 0; it < 2; ++it) { const int id = F.tid + 512 * it, row = id >> 4, c = id & 15;
        const f32x4 a = *(const f32x4*)(KM + row * HD + c * 8), bb = *(const f32x4*)(KM + row * HD + c * 8 + 4);
        float v[8] = {a[0], a[1], a[2], a[3], bb[0], bb[1], bb[2], bb[3]}; unsigned hw[8]; float lo[8];
#pragma unroll
        for (int e = 0; e < 8; ++e) { if (row >= qb) v[e] = 0.f; hw[e] = f2bf(v[e]); lo[e] = v[e] - __builtin_bit_cast(float, hw[e] << 16); }
        v4u wh = {hw[0] | (hw[1] << 16), hw[2] | (hw[3] << 16), hw[4] | (hw[5] << 16), hw[6] | (hw[7] << 16)};
        v4u wl = {pk2(lo[0], lo[1]), pk2(lo[2], lo[3]), pk2(lo[4], lo[5]), pk2(lo[6], lo[7])};
        *(LAS v4u*)(KH + KSWZ(row, c * 16)) = wh; *(LAS v4u*)(KL + KSWZ(row, c * 16)) = wl; }
    if (F.tid < 64) cnt[F.tid] = 0;
    __syncthreads();
    const int r32 = F.lane & 31, hi = F.lane >> 5, ql = 32 * F.wave + r32;
    const size_t tok = (size_t)b * SEQ + qb * BLK + ql;
    bf16x8 qr[8];
#pragma unroll
    for (int d0 = 0; d0 < 8; ++d0) qr[d0] = *(const bf16x8*)(QB + tok * DM + h * 128 + d0 * 16 + hi * 8);
    f32x16 p0 = {}, p1 = {};
    qkt_acc(p0, p1, KH, qr, r32, hi); qkt_acc(p0, p1, KL, qr, r32, hi);
    float cv[32]; int ci[32];
#pragma unroll
    for (int r = 0; r < 16; ++r) { const int j0 = crow(r, hi), j1 = 32 + crow(r, hi);
        cv[r] = j0 < qb ? p0[r] : -INFINITY; ci[r] = j0; cv[16 + r] = j1 < qb ? p1[r] : -INFINITY; ci[16 + r] = j1; }
    float tv[3]; int ti[3];
#pragma unroll
    for (int pass = 0; pass < 3; ++pass) { float bv = -INFINITY; int bi = 1000;
#pragma unroll
        for (int r = 0; r < 32; ++r) { const bool excl = (pass > 0 && ci[r] == ti[0]) || (pass > 1 && ci[r] == ti[1]);
            const bool take = !excl && ((cv[r] > bv) || (cv[r] == bv && ci[r] < bi)); bv = take ? cv[r] : bv; bi = take ? ci[r] : bi; }
        tv[pass] = bv; ti[pass] = bi; }
    float mv[6]; int mi[6];
#pragma unroll
    for (int k = 0; k < 3; ++k) { mv[k] = tv[k]; mi[k] = ti[k]; mv[3 + k] = __shfl_xor(tv[k], 32); mi[3 + k] = __shfl_xor(ti[k], 32); }
    int fi[3];
#pragma unroll
    for (int pass = 0; pass < 3; ++pass) { float bv = -INFINITY; int bi = 1000;
#pragma unroll
        for (int r = 0; r < 6; ++r) { const bool excl = (pass > 0 && mi[r] == fi[0]) || (pass > 1 && mi[r] == fi[1]);
            const bool take = !excl && ((mv[r] > bv) || (mv[r] == bv && mi[r] < bi)); bv = take ? mv[r] : bv; bi = take ? mi[r] : bi; }
        fi[pass] = bi; }
    const int i1 = fi[0], i2 = fi[1], i3 = fi[2];
    const int nv = qb < 3 ? qb : 3;
    const int js[3] = {i1, i2, i3};
    if (hi == 0) {
#pragma unroll
        for (int s = 0; s < 3; ++s) if (s < nv) __hip_atomic_fetch_add(&cnt[js[s]], 1, __ATOMIC_RELAXED, __HIP_MEMORY_SCOPE_WORKGROUP);
    }
    __syncthreads();
    if (F.wave == 0) {
        const int c = cnt[F.lane]; int incl = c;
#pragma unroll
        for (int o = 1; o < 64; o <<= 1) { const int t = __shfl_up(incl, o); if (F.lane >= o) incl += t; }
        offs[F.lane + 1] = incl; cursor[F.lane] = incl - c; if (F.lane == 0) offs[0] = 0;
        OFFS[F.lane + 1] = (unsigned short)incl; if (F.lane == 0) OFFS[0] = 0;
        if (F.lane < qb && c > 0) atomicAdd(&NTOT[F.lane], (unsigned)c);
    }
    __syncthreads();
    if (hi == 0) {
#pragma unroll
        for (int s = 0; s < 3; ++s) if (s < nv) { const int idx = __hip_atomic_fetch_add(&cursor[js[s]], 1, __ATOMIC_RELAXED, __HIP_MEMORY_SCOPE_WORKGROUP); ent[idx] = (unsigned short)(ql | (s << 8)); }
    }
    __syncthreads();
    const int tot = offs[64];
    for (int i = F.tid; i < tot; i += 512) ENT[i] = ent[i];
    __syncthreads();
}

__device__ __forceinline__ void gathered_attention(Frame& F) {
    LAS int* PFX = (LAS int*)(F.lds + ATT_AUX); LAS int* NT = PFX + 1024; LAS int* TMP = NT + 1024;
    LAS int* cumI = TMP + 1024; LAS int* segoff = cumI + 64; LAS int* qinfo = segoff + 64;
    const unsigned* NTOT = (const unsigned*)(F.ws + WS_CTL) + CW_NTOT;
    const bf16* QB = (const bf16*)(F.ws + WS_S0);
    unsigned char* PART = F.ws + WS_S3; float* LSE = (float*)(F.ws + WS_LSE);
    for (int i = F.tid; i < 1024; i += 512) { const int n = (int)NTOT[i]; NT[i] = n; PFX[i] = (n + 255) >> 8; }
    __syncthreads();
    for (int d = 1; d < 1024; d <<= 1) {
        for (int i = F.tid; i < 1024; i += 512) TMP[i] = PFX[i] + (i >= d ? PFX[i - d] : 0);
        __syncthreads();
        for (int i = F.tid; i < 1024; i += 512) PFX[i] = TMP[i];
        __syncthreads();
    }
    const int S_tot = PFX[1023];
    const int s_lo = (int)(((long)F.vcu * S_tot) / F.G), s_hi = (int)(((long)(F.vcu + 1) * S_tot) / F.G);
    const int r32 = F.lane & 31, hi = F.lane >> 5;
    const int vbase = (int)(uintptr_t)(F.lds + VIMG) + v_rd_base(F.lane);
    int cur_u = -1, ub = 0, uh = 0, uj = 0;
    for (int s = s_lo; s < s_hi; ++s) {
        int lo = 0, hi_ = 1023;
        while (lo < hi_) { const int mid = (lo + hi_) >> 1; if (PFX[mid] > s) hi_ = mid; else lo = mid + 1; }
        const int u = lo; const int k = s - (u ? PFX[u - 1] : 0); const int n = NT[u];
        __syncthreads();
        if (u != cur_u) {
            cur_u = u; ub = u >> 9; uh = (u >> 6) & 7; uj = u & 63;
            load_kv_block(F, ub, uh, uj);
            if (F.wave == 0) {
                const int qb = F.lane; int o0 = 0, o1 = 0;
                if (qb > uj) { const unsigned short* OF = (const unsigned short*)(F.ws + WS_OFFS) + (size_t)((ub * NH + uh) * NBLK + qb) * OFFS_PITCH; o0 = OF[uj]; o1 = OF[uj + 1]; }
                int incl = o1 - o0;
#pragma unroll
                for (int o = 1; o < 64; o <<= 1) { const int t = __shfl_up(incl, o); if (F.lane >= o) incl += t; }
                cumI[qb] = incl; segoff[qb] = o0;
            }
        }
        __syncthreads();
        if (F.tid < 256) {
            const int e = k * 256 + F.tid; int info = -1;
            if (e < n) {
                int a = 0, c = 63;
                while (a < c) { const int mid = (a + c) >> 1; if (cumI[mid] > e) c = mid; else a = mid + 1; }
                const int qb = a; const int idx = e - (qb ? cumI[qb - 1] : 0);
                const unsigned short en = ((const unsigned short*)(F.ws + WS_ENT))[(size_t)((ub * NH + uh) * NBLK + qb) * 768 + segoff[qb] + idx];
                info = (qb * BLK + (en & 255)) | ((en >> 8) << 16);
            }
            qinfo[F.tid] = info;
        }
        __syncthreads();
        const int info = qinfo[32 * F.wave + r32]; const bool valid = info >= 0;
        if (__any(valid)) {
            const int pos = valid ? (info & 0xffff) : 0, slot = valid ? (info >> 16) : 0;
            const size_t tok = (size_t)ub * SEQ + pos;
            bf16x8 qr[8];
#pragma unroll
            for (int d0 = 0; d0 < 8; ++d0) qr[d0] = *(const bf16x8*)(QB + tok * DM + uh * 128 + d0 * 16 + hi * 8);
            f32x16 o[4] = {}; float m = -1e30f, l = 0.f;
#pragma unroll 1
            for (int t = 0; t < 4; ++t) attn_subtile(o, m, l, F.lds + KIMG + t * 16384, vbase + t * 16384, qr, r32, hi, false, 0, 0);
            const float il = __builtin_amdgcn_rcpf(l);
            const size_t prow = (tok * NH + uh) * 3 + slot;
            row_store_T(PART + prow * 256, o, il, hi, valid);
            if (valid && hi == 0) LSE[(tok * NH + uh) * 4 + slot] = m + __builtin_amdgcn_logf(l);
        }
    }
    __syncthreads();
}

__device__ __forceinline__ void own_unit(Frame& F, int b, int h, int qb) {
    bf16* QB = (bf16*)(F.ws + WS_S0); const bf16* SG2 = (const bf16*)(F.ws + WS_S6);
    const unsigned char* PART = F.ws + WS_S3; const float* LSE = (const float*)(F.ws + WS_LSE);
    load_kv_block(F, b, h, qb);
    __syncthreads();
    const int r32 = F.lane & 31, hi = F.lane >> 5, w = F.wave, ql = 32 * w + r32;
    const int vbase = (int)(uintptr_t)(F.lds + VIMG) + v_rd_base(F.lane);
    const size_t tok = (size_t)b * SEQ + qb * BLK + ql;
    bf16x8 qr[8];
#pragma unroll
    for (int d0 = 0; d0 < 8; ++d0) qr[d0] = *(const bf16x8*)(QB + tok * DM + h * 128 + d0 * 16 + hi * 8);
    f32x16 o[4] = {}; float m = -1e30f, l = 0.f;
    const int tdiag = w >> 1;
#pragma unroll 1
    for (int t = 0; t <= tdiag; ++t) attn_subtile(o, m, l, F.lds + KIMG + t * 16384, vbase + t * 16384, qr, r32, hi, t == tdiag, 64 * t, ql);
    const int nv = qb < 3 ? qb : 3;
    float L[3]; float Mx = m;
#pragma unroll
    for (int s = 0; s < 3; ++s) { L[s] = (s < nv) ? LSE[(tok * NH + h) * 4 + s] : -1e30f; Mx = fmaxf(Mx, L[s]); }
    const float wo = fast_exp2(m - Mx); float den = l * wo;
#pragma unroll
    for (int d = 0; d < 4; ++d)
#pragma unroll
        for (int r = 0; r < 16; ++r) o[d][r] *= wo;
#pragma unroll 1
    for (int s = 0; s < nv; ++s) {
        const float ws_ = fast_exp2(L[s] - Mx); den += ws_;
        f32x16 pv[4]; row_load_T(PART + ((tok * NH + h) * 3 + s) * 256, pv, hi);
#pragma unroll
        for (int d = 0; d < 4; ++d)
#pragma unroll
            for (int r = 0; r < 16; ++r) o[d][r] += ws_ * pv[d][r];
    }
    const float iden = __builtin_amdgcn_rcpf(den);
    { f32x16 gv[4]; row_load_T((const unsigned char*)(SG2 + tok * DM + h * 128), gv, hi);
#pragma unroll
      for (int d = 0; d < 4; ++d)
#pragma unroll
          for (int r = 0; r < 16; ++r) o[d][r] *= gv[d][r]; }
    row_store_T((unsigned char*)(QB + tok * DM + h * 128), o, iden, hi, true);
    __syncthreads();
}

constexpr int N_PHASES = 11;
__global__ void __launch_bounds__(512, 2) hawk_moba_fwd(Args args) {
    extern __shared__ __attribute__((aligned(16))) unsigned char lds_raw[];
    Frame F;
    F.lds = (LAS unsigned char*)lds_raw;
    F.tid = threadIdx.x; F.lane = F.tid & 63; F.wave = __builtin_amdgcn_readfirstlane(F.tid >> 6);
    F.G = gridDim.x; { const int bx = blockIdx.x; F.vcu = (F.G % 8 == 0) ? (bx % 8) * (F.G / 8) + bx / 8 : bx; }
    F.out = args.out; F.ws = args.ws;
    volatile LAS unsigned* MISC = (volatile LAS unsigned*)(F.lds + MISC_OFF);
    if (F.tid < 64) MISC[F.tid] = 0u;
    __syncthreads();
    unsigned* ctl = (unsigned*)(F.ws + WS_CTL);
    XcdBarrier bar; bar.bar = ctl + CW_BAR; bar.x = 0; bar.st = nullptr;
    const int lo = args.ph_lo, hi = args.ph_hi;
    if (hi - lo > 1) bar = xcd_barrier_post(ctl + CW_BAR, MISC + 8);
#define IN(k) (lo <= (k) && (k) < hi)
#define SEAM(k) do { if (IN(k) && IN((k) + 1)) xcd_barrier(bar); } while (0)

#define RUN_GEMM(MODE, AOFF, BOFF, NN) do { \
        pg8::Gemm g{(const pg8::bf16_t*)(F.ws + (AOFF)), (const pg8::bf16_t*)(F.ws + (BOFF)), T, (NN), DM}; \
        pg8::EpiAll E{(MODE), F.ws, F.out}; pg8::StaticOrder S; S.init(T, (NN), F.G, (int)blockIdx.x); \
        pg8::gemm_phase<pg8::EpiAll, pg8::StaticOrder, true, true>(F.lds, g, S, E); } while (0)
    if (IN(0)) { p0_prologue(F); } SEAM(0);
    if (IN(1)) { RUN_GEMM(0, WS_S0, WS_WAIN, 2048); } SEAM(1);
    if (IN(2)) { for (int u = F.vcu; u < 1024; u += F.G) scan_unit(F, false, u >> 9, (u >> 3) & 63, u & 7); } SEAM(2);
    if (IN(3)) { for (int u = F.vcu; u < 1024; u += F.G) scan_unit(F, true, u >> 9, (u >> 3) & 63, u & 7); } SEAM(3);
    if (IN(4)) { RUN_GEMM(1, WS_S0, WS_WAOUT, DM); } SEAM(4);
    if (IN(5)) { RUN_GEMM(2, WS_S3, WS_WB1, 4096); } SEAM(5);
    if (IN(6)) { for (int u = F.vcu; u < 2048; u += F.G) fix_unit(F, (u >> 10) & 1, (u >> 4) & 63, (u >> 1) & 7, u & 1); } SEAM(6);
    if (IN(7)) { for (int u = F.vcu; u < 1024; u += F.G) { const int qb = u & 63; if (qb > 0) select_unit(F, u >> 9, (u >> 6) & 7, qb); } } SEAM(7);
    if (IN(8)) { gathered_attention(F); } SEAM(8);
    if (IN(9)) { for (int u = F.vcu; u < 1024; u += F.G) own_unit(F, u >> 9, (u >> 6) & 7, u & 63); } SEAM(9);
    if (IN(10)) { RUN_GEMM(3, WS_S0, WS_WBOUT, DM); }
#undef RUN_GEMM
#undef IN
#undef SEAM
}

extern "C" void kernel_launch(void* const* d_in, const int* in_sizes, int n_in, void* d_out, int out_size, void* d_ws, size_t ws_size, hipStream_t stream) {
    static int grid = 0;
    if (grid == 0) {
        if (n_in != 18 || in_sizes[0] != T * DM || out_size != T * DM || ws_size < WS_END) { fprintf(stderr, "kernel_launch: unexpected shapes (n_in %d, in0 %d, out %d, ws %zu < %zu)\n", n_in, n_in > 0 ? in_sizes[0] : -1, out_size, ws_size, (size_t)WS_END); grid = -1; return; }
        int dev = 0, cus = 0, per_cu = 0;
        if (hipGetDevice(&dev) != hipSuccess || hipDeviceGetAttribute(&cus, hipDeviceAttributeMultiprocessorCount, dev) != hipSuccess) { grid = -1; return; }
        if (hipFuncSetAttribute((const void*)hawk_moba_fwd, hipFuncAttributeMaxDynamicSharedMemorySize, LDS_BYTES) != hipSuccess) { fprintf(stderr, "kernel_launch: hipFuncSetAttribute failed\n"); grid = -1; return; }
        if (hipOccupancyMaxActiveBlocksPerMultiprocessor(&per_cu, (const void*)hawk_moba_fwd, 512, LDS_BYTES) != hipSuccess || per_cu < 1) { fprintf(stderr, "kernel_launch: occupancy query says %d blocks per CU\n", per_cu); (void)hipGetLastError(); grid = -1; return; }
        grid = cus;
    }
    if (grid < 0) return;
    (void)hipMemsetAsync((char*)d_ws + WS_CTL, 0, CTL_ZERO_BYTES, stream);
    Args a{};
    for (int i = 0; i < 18; ++i) a.in[i] = (const float*)d_in[i];
    a.out = (float*)d_out; a.ws = (unsigned char*)d_ws;
#if MK_N_LAUNCHES == 1
    a.ph_lo = 0; a.ph_hi = N_PHASES;
    hipLaunchKernelGGL(hawk_moba_fwd, dim3(grid), dim3(512), LDS_BYTES, stream, a);
#else
    for (int p = 0; p <= MK_LAST_PHASE; ++p) { a.ph_lo = p; a.ph_hi = p + 1; hipLaunchKernelGGL(hawk_moba_fwd, dim3(grid), dim3(512), LDS_BYTES, stream, a); }
#endif
}
```

```cpp
#include <hip/hip_runtime.h>
#include <cstdio>
#include <cstdint>

#ifndef MK_N_LAUNCHES
#define MK_N_LAUNCHES 1
#endif
#ifndef MK_PHMASK
#define MK_PHMASK 0x7ff
#endif
#ifndef MK_REPEAT
#define MK_REPEAT (-1)
#endif
#ifndef MK_LAST_PHASE
#define MK_LAST_PHASE 10
#endif

namespace pg8 {
#define PG8_LAS __attribute__((address_space(3)))
typedef unsigned short bf16_t;
typedef short bf16x8 __attribute__((ext_vector_type(8)));
typedef float f32x4 __attribute__((ext_vector_type(4)));
typedef unsigned u32x4 __attribute__((ext_vector_type(4)));
typedef unsigned u32x2 __attribute__((ext_vector_type(2)));
constexpr int BM = 256, BK = 64, HALF = 128, HTB = HALF * BK * 2, STAGE_BYTES = 8 * HTB, NXCD = 8, WGM = 8;

__host__ __device__ __forceinline__ int lds_byte(int r, int c) { const int st = (r >> 4) * 2 + (c >> 5), rr = r & 15, cc = c & 31, ob = rr * 64 + cc * 2; return st * 1024 + (ob ^ (((ob >> 9) & 1) << 5)); }
__host__ __device__ __forceinline__ void stage_rc(int b, int& R, int& C) { const int st = b / 1024, sb = b % 1024, swz = sb ^ (((sb >> 9) & 1) << 5); R = (st >> 1) * 16 + swz / 64; C = (st & 1) * 32 + (swz % 64) / 2; }
__host__ __device__ __forceinline__ int perm32(int rho) { const int n = rho >> 4, i = rho & 15; return 8 * (i >> 2) + 4 * n + (i & 3); }

struct Unit { int pm, pn; };
struct Gemm { const bf16_t* A; const bf16_t* Bt; int M, N, K; };

struct StaticOrder {
    int nM, nN, nwg, G, c;
    __host__ __device__ void init(int M, int N, int G_, int c_) { nM = M / BM; nN = N / BM; nwg = nM * nN; G = G_; c = c_; }
    __host__ __device__ bool next(int i, Unit& u) const {
        const long L = (long)i * G + c; if (L >= nwg) return false;
        int wgid = (int)L; { const int q = nwg / NXCD, r = nwg % NXCD, xcd = wgid % NXCD, off = wgid / NXCD; wgid = (xcd < r ? xcd * (q + 1) : r * (q + 1) + (xcd - r) * q) + off; }
        const int nig = WGM * nN, gid = wgid / nig, fm = gid * WGM, gsz = (nM - fm) < WGM ? (nM - fm) : WGM;
        u.pm = fm + ((wgid % nig) % gsz); u.pn = (wgid % nig) / gsz; return true;
    }
    __device__ __forceinline__ void a_ready(const Unit&) const {}
    __device__ __forceinline__ void done(const Unit&) const {}
};

__device__ __forceinline__ unsigned cvt_pk_bf16(float lo, float hi) { unsigned r; asm volatile("v_cvt_pk_bf16_f32 %0, %1, %2" : "=v"(r) : "v"(lo), "v"(hi)); return r; }

template <class Epi, class Sched, bool ALIGN_EPI = false, bool SP2 = false>
__device__ __forceinline__ void gemm_phase(PG8_LAS unsigned char* lds, const Gemm g, const Sched& S, const Epi& E) {
    const int tid = threadIdx.x, wid = __builtin_amdgcn_readfirstlane(tid >> 6), lane = tid & 63, wr = wid >> 2, wc = wid & 3, fr = lane & 15, fq = lane >> 4;
    const int K = g.K, nt = K / BK;
    unsigned voffA[2], voffB[2];
#pragma unroll
    for (int i = 0; i < 2; ++i) { int R, C; stage_rc(tid * 16 + i * 8192, R, C); const int Rb = Epi::PERM ? ((R & ~31) + perm32(R & 31)) : R;
        voffA[i] = (unsigned)(R * K + C) * 2u; voffB[i] = (unsigned)(Rb * K + C) * 2u; }
    const size_t kstep = (size_t)(BK * 2);
    const size_t hstep = (size_t)HALF * K * 2;
    const size_t tstep = 2 * hstep;
    const unsigned ldsw = (unsigned)wid * 1024u;
    const int aoff = lds_byte(wr * 64 + fr, fq * 8), boff = lds_byte(wc * 32 + fr, fq * 8);
#define PG8_SA(b, h) (((b) * 2 + (h)) * HTB)
#define PG8_SB(b, h) ((4 + (b) * 2 + (h)) * HTB)
#define PG8_STAGE(bufoff, gbase, voff) do { _Pragma("unroll") for (int _i = 0; _i < 2; ++_i) \
        __builtin_amdgcn_global_load_lds((const unsigned*)((const char*)(gbase) + (voff)[_i]), (PG8_LAS unsigned*)(lds + (bufoff) + ldsw + _i * 8192), 16, 0, 0); } while (0)
#define PG8_LDA(dst, b, h) do { _Pragma("unroll") for (int m = 0; m < 4; ++m) _Pragma("unroll") for (int k = 0; k < 2; ++k) dst[m][k] = *(const PG8_LAS bf16x8*)(lds + PG8_SA(b, h) + aoff + m * 2048 + k * 1024); } while (0)
#define PG8_LDB(dst, b, h) do { _Pragma("unroll") for (int n = 0; n < 2; ++n) _Pragma("unroll") for (int k = 0; k < 2; ++k) dst[n][k] = *(const PG8_LAS bf16x8*)(lds + PG8_SB(b, h) + boff + n * 2048 + k * 1024); } while (0)
#define PG8_MMA(ai, bj, At, Bt) do { __builtin_amdgcn_s_setprio(1); _Pragma("unroll") for (int m = 0; m < 4; ++m) _Pragma("unroll") for (int n = 0; n < 2; ++n) _Pragma("unroll") for (int k = 0; k < 2; ++k) \
        acc[ai][bj][m][n] = __builtin_amdgcn_mfma_f32_16x16x32_bf16(Bt[n][k], At[m][k], acc[ai][bj][m][n], 0, 0, 0); __builtin_amdgcn_s_setprio(0); } while (0)
#define PG8_WAIT_V(n) asm volatile("s_waitcnt vmcnt(" #n ")" ::: "memory")
#define PG8_WAIT_L(n) asm volatile("s_waitcnt lgkmcnt(" #n ")" ::: "memory")
#define PG8_BAR __builtin_amdgcn_s_barrier()
#define PG8_SCHED __builtin_amdgcn_sched_barrier(0)
    Unit cur, nxt; int ui = 0;
    if (!S.next(0, cur)) return;
    f32x4 acc[2][2][4][2];
#pragma unroll
    for (int a = 0; a < 2; ++a)
#pragma unroll
        for (int b = 0; b < 2; ++b)
#pragma unroll
            for (int m = 0; m < 4; ++m)
#pragma unroll
                for (int n = 0; n < 2; ++n) acc[a][b][m][n] = (f32x4){0.f, 0.f, 0.f, 0.f};
    bf16x8 At[4][2], B0[2][2], B1[2][2];
    const char* cA = (const char*)g.A + (size_t)cur.pm * tstep; const char* cB = (const char*)g.Bt + (size_t)cur.pn * tstep;
    S.a_ready(cur);
    if constexpr (SP2) {
        PG8_STAGE(PG8_SB(0, 0), cB, voffB); PG8_STAGE(PG8_SB(0, 1), cB + hstep, voffB); PG8_STAGE(PG8_SA(0, 0), cA, voffA); PG8_STAGE(PG8_SA(0, 1), cA + hstep, voffA);
        if (wr == 1) PG8_BAR;
        PG8_WAIT_V(2); PG8_BAR;
        PG8_STAGE(PG8_SB(1, 0), cB + kstep, voffB); PG8_STAGE(PG8_SA(1, 0), cA + kstep, voffA); PG8_STAGE(PG8_SB(1, 1), cB + hstep + kstep, voffB);
        PG8_WAIT_V(6); PG8_BAR;
    } else {
        PG8_STAGE(PG8_SB(0, 0), cB, voffB); PG8_STAGE(PG8_SA(0, 0), cA, voffA); PG8_STAGE(PG8_SB(0, 1), cB + hstep, voffB); PG8_STAGE(PG8_SA(0, 1), cA + hstep, voffA);
        if (wr == 1) PG8_BAR;
        PG8_WAIT_V(4); PG8_BAR;
        PG8_STAGE(PG8_SB(1, 0), cB + kstep, voffB); PG8_STAGE(PG8_SA(1, 0), cA + kstep, voffA); PG8_STAGE(PG8_SB(1, 1), cB + hstep + kstep, voffB);
        PG8_WAIT_V(6); PG8_BAR;
    }
    for (;;) {
        const bool has_next = S.next(ui + 1, nxt);
        const char* nA = has_next ? (const char*)g.A + (size_t)nxt.pm * tstep : cA; const char* nB = has_next ? (const char*)g.Bt + (size_t)nxt.pn * tstep : cB;
        for (int t = 0; t < nt; t += 2) {
            const bool last = (t == nt - 2);
            const char* a1 = cA + (size_t)(t + 1) * kstep;
            const char* a2 = last ? nA : cA + (size_t)(t + 2) * kstep; const char* b2 = last ? nB : cB + (size_t)(t + 2) * kstep;
            const char* a3 = a2 + kstep; const char* b3 = b2 + kstep;
            if (last && has_next) S.a_ready(nxt);
            if constexpr (SP2) {
            PG8_LDB(B0, 0, 0); PG8_LDB(B1, 0, 1); PG8_SCHED; PG8_LDA(At, 0, 0); PG8_STAGE(PG8_SA(1, 1), a1 + hstep, voffA);
            PG8_WAIT_V(8); PG8_WAIT_L(0); PG8_BAR; PG8_MMA(0, 0, At, B0); PG8_MMA(0, 1, At, B1); PG8_BAR; PG8_SCHED;
            PG8_LDA(At, 0, 1); PG8_STAGE(PG8_SB(0, 0), b2, voffB); PG8_STAGE(PG8_SB(0, 1), b2 + hstep, voffB); PG8_STAGE(PG8_SA(0, 0), a2, voffA);
            PG8_WAIT_V(8); PG8_WAIT_L(0); PG8_BAR; PG8_MMA(1, 0, At, B0); PG8_MMA(1, 1, At, B1); PG8_BAR; PG8_SCHED;
            PG8_LDB(B0, 1, 0); PG8_LDB(B1, 1, 1); PG8_SCHED; PG8_LDA(At, 1, 0); PG8_STAGE(PG8_SA(0, 1), a2 + hstep, voffA);
            PG8_WAIT_V(8); PG8_WAIT_L(0); PG8_BAR; PG8_MMA(0, 0, At, B0); PG8_MMA(0, 1, At, B1); PG8_BAR; PG8_SCHED;
            PG8_LDA(At, 1, 1); PG8_STAGE(PG8_SB(1, 0), b3, voffB); PG8_STAGE(PG8_SB(1, 1), b3 + hstep, voffB); PG8_STAGE(PG8_SA(1, 0), a3, voffA);
            PG8_WAIT_V(8); PG8_WAIT_L(0); PG8_BAR; PG8_MMA(1, 0, At, B0); PG8_MMA(1, 1, At, B1); PG8_BAR; PG8_SCHED;
            } else {
            PG8_LDB(B0, 0, 0); PG8_SCHED; PG8_LDA(At, 0, 0); PG8_STAGE(PG8_SA(1, 1), a1 + hstep, voffA);
            PG8_WAIT_L(8); PG8_BAR; PG8_WAIT_L(0); PG8_MMA(0, 0, At, B0); PG8_BAR; PG8_SCHED;
            PG8_LDB(B1, 0, 1); PG8_STAGE(PG8_SB(0, 0), b2, voffB);
            PG8_BAR; PG8_WAIT_L(0); PG8_MMA(0, 1, At, B1); PG8_BAR;
            PG8_LDA(At, 0, 1); PG8_STAGE(PG8_SA(0, 0), a2, voffA);
            PG8_BAR; PG8_WAIT_L(0); PG8_MMA(1, 0, At, B0); PG8_BAR; PG8_SCHED;
            PG8_STAGE(PG8_SB(0, 1), b2 + hstep, voffB);
            PG8_WAIT_V(6); PG8_BAR; PG8_MMA(1, 1, At, B1); PG8_BAR;
            PG8_LDB(B0, 1, 0); PG8_SCHED; PG8_LDA(At, 1, 0); PG8_STAGE(PG8_SA(0, 1), a2 + hstep, voffA);
            PG8_WAIT_L(8); PG8_BAR; PG8_WAIT_L(0); PG8_MMA(0, 0, At, B0); PG8_BAR; PG8_SCHED;
            PG8_LDB(B1, 1, 1); PG8_STAGE(PG8_SB(1, 0), b3, voffB);
            PG8_BAR; PG8_WAIT_L(0); PG8_MMA(0, 1, At, B1); PG8_BAR;
            PG8_LDA(At, 1, 1); PG8_STAGE(PG8_SA(1, 0), a3, voffA);
            PG8_BAR; PG8_WAIT_L(0); PG8_MMA(1, 0, At, B0); PG8_BAR; PG8_SCHED;
            PG8_STAGE(PG8_SB(1, 1), b3 + hstep, voffB);
            PG8_WAIT_V(6); PG8_BAR; PG8_MMA(1, 1, At, B1); PG8_BAR;
            }
        }
        if constexpr (ALIGN_EPI) { if (wr == 0) PG8_BAR; }
        E(acc, cur, wr, wc, fr, fq); S.done(cur);
        if (!has_next) break;
#pragma unroll
        for (int a = 0; a < 2; ++a)
#pragma unroll
            for (int b = 0; b < 2; ++b)
#pragma unroll
                for (int m = 0; m < 4; ++m)
#pragma unroll
                    for (int n = 0; n < 2; ++n) acc[a][b][m][n] = (f32x4){0.f, 0.f, 0.f, 0.f};
        cur = nxt; cA = nA; cB = nB; ++ui;
        if constexpr (ALIGN_EPI) { if (wr == 1) PG8_BAR; }
    }
    PG8_WAIT_V(0);
    if constexpr (!ALIGN_EPI) { if (wr == 0) PG8_BAR; }
    PG8_BAR;
#undef PG8_SA
#undef PG8_SB
#undef PG8_STAGE
#undef PG8_LDA
#undef PG8_LDB
#undef PG8_MMA
#undef PG8_WAIT_V
#undef PG8_WAIT_L
#undef PG8_BAR
#undef PG8_SCHED
}
}

constexpr int NBATCH = 2, SEQ = 16384, T = NBATCH * SEQ, DM = 1024, NH = 8, HD = 128, NBLK = 64, BLK = 256;
constexpr float EPS = 1e-6f;
constexpr float QSCALE = 0.088388347648318440f * 1.4426950408889634f;

constexpr size_t MiB = 1u << 20;
constexpr size_t WS_CTL = 0, CTL_ZERO_BYTES = 1 * MiB;
constexpr size_t WS_WAIN = 2 * MiB, WS_WAOUT = 6 * MiB, WS_WB1 = 8 * MiB, WS_WBOUT = 16 * MiB, WS_WRG = 18 * MiB;
constexpr size_t WS_RS0 = 19 * MiB;
constexpr size_t WS_SSQ1 = 20 * MiB;
constexpr size_t WS_ROPE = 22 * MiB;
constexpr size_t WS_SUMA = 30 * MiB, WS_SUMB = 30 * MiB + 512 * 1024;
constexpr size_t WS_KMEAN = 31 * MiB;
constexpr size_t WS_ENT = 32 * MiB;
constexpr size_t WS_OFFS = 34 * MiB;
constexpr size_t WS_LSE = 36 * MiB;
constexpr size_t WS_SEGA = 44 * MiB, WS_SEGB = 46 * MiB;
constexpr size_t SLOT = 64 * MiB;
constexpr size_t WS_S0 = 1 * SLOT;
constexpr size_t WS_S1 = 2 * SLOT;
constexpr size_t WS_S2 = 3 * SLOT;
constexpr size_t WS_S3 = 4 * SLOT;
constexpr size_t WS_S6 = 7 * SLOT;
constexpr size_t WS_END = 8 * SLOT;
constexpr int OFFS_PITCH = 72;
constexpr int CW_BAR = 4096;
constexpr int CW_NTOT = 16384;

constexpr int LDS_BYTES = 163840;
constexpr int MISC_OFF = LDS_BYTES - 256;

#define GAS __attribute__((address_space(1)))
#define LAS __attribute__((address_space(3)))
typedef unsigned short bf16;
typedef unsigned v4u __attribute__((ext_vector_type(4)));
typedef unsigned v2u __attribute__((ext_vector_type(2)));
typedef float f32x4 __attribute__((ext_vector_type(4)));
typedef float f32x16 __attribute__((ext_vector_type(16)));
typedef short bf16x8 __attribute__((ext_vector_type(8)));
typedef short s16x4 __attribute__((ext_vector_type(4)));
#define LDS_WAIT() asm volatile("s_waitcnt lgkmcnt(0)" ::: "memory")
#define VM_WAIT() asm volatile("s_waitcnt vmcnt(0)" ::: "memory")
#define SBAR() __builtin_amdgcn_sched_barrier(0)

__device__ __forceinline__ unsigned f2bf(float f) { unsigned u = __builtin_bit_cast(unsigned, f); return (u + 0x7fffu + ((u >> 16) & 1u)) >> 16; }
__device__ __forceinline__ unsigned pk2(float lo, float hi) { return pg8::cvt_pk_bf16(lo, hi); }
__device__ __forceinline__ float bflo(unsigned w) { return __builtin_bit_cast(float, w << 16); }
__device__ __forceinline__ float bfhi(unsigned w) { return __builtin_bit_cast(float, w & 0xffff0000u); }
__device__ __forceinline__ float bf1(unsigned short h) { return __builtin_bit_cast(float, ((unsigned)h) << 16); }
__device__ __forceinline__ float fast_exp2(float x) { return __builtin_amdgcn_exp2f(x); }
__device__ __forceinline__ float sigmoidf_(float v) { return __builtin_amdgcn_rcpf(1.f + fast_exp2(-v * 1.4426950408889634f)); }
__device__ __forceinline__ float siluf_(float v) { return v * sigmoidf_(v); }

#define XB_TMO      128
#define XB_XCNT(j)  (256  + 64 * (j))
#define XB_XSUB(j)  (1280 + 64 * (j))
#define XB_XGEN(j)  (2304 + 64 * (j))
#define XB_TOP      3328
#define XB_TOPGEN   3392
#define XCD_BAR_WORDS 3456
#define XB_SPIN_CAP (1u << 20)
__device__ __forceinline__ unsigned xb_ld(unsigned* p)              { return __hip_atomic_load(p, __ATOMIC_RELAXED, __HIP_MEMORY_SCOPE_AGENT); }
__device__ __forceinline__ unsigned xb_add(unsigned* p, unsigned v) { return __hip_atomic_fetch_add(p, v, __ATOMIC_RELAXED, __HIP_MEMORY_SCOPE_AGENT); }
__device__ __forceinline__ unsigned xb_xcc_id() { return (unsigned)__builtin_amdgcn_s_getreg((3 << 11) | 20) & 0xFu; }
#define XB_SPIN(cond, bar) do { unsigned _sp = 0; while (cond) { __builtin_amdgcn_s_sleep(1); \
    if ((++_sp & 255u) == 0u) { if (xb_ld(&(bar)[XB_TMO])) break; if (_sp > XB_SPIN_CAP) { atomicAdd(&(bar)[XB_TMO], 1u); break; } } } } while (0)
struct XcdBarrier { unsigned* bar; unsigned x; volatile LAS unsigned* st; };
__device__ __forceinline__ XcdBarrier xcd_barrier_post(unsigned* bar, volatile LAS unsigned* st) {
    XcdBarrier b; b.bar = bar; b.x = xb_xcc_id(); b.st = st;
    if (threadIdx.x == 0) (void)xb_add(&bar[XB_XCNT(b.x)], 1u);
    return b;
}
__device__ __forceinline__ void xcd_barrier_complete(unsigned* bar, unsigned x, unsigned& nloc, unsigned& nx) {
    const unsigned G = gridDim.x * gridDim.y * gridDim.z;
    unsigned sum, cnt, mine, sp = 0u;
    for (;;) {
        sum = 0u; cnt = 0u; mine = 0u;
#pragma unroll
        for (unsigned j = 0; j < 16; ++j) { const unsigned c = xb_ld(&bar[XB_XCNT(j)]); sum += c; cnt += (c > 0u) ? 1u : 0u; mine = (j == x) ? c : mine; }
        if (sum == G) break;
        __builtin_amdgcn_s_sleep(1);
        if ((++sp & 255u) == 0u) { if (xb_ld(&bar[XB_TMO])) break; if (sp > XB_SPIN_CAP) { atomicAdd(&bar[XB_TMO], 1u); break; } }
    }
    nloc = mine > 0u ? mine : 1u; nx = cnt > 0u ? cnt : 1u;
}
__device__ __forceinline__ void xcd_barrier(const XcdBarrier& b) {
    asm volatile("s_waitcnt vmcnt(0)" ::: "memory");
    __syncthreads();
    if (threadIdx.x == 0) {
        unsigned* bar = b.bar;
        __builtin_amdgcn_s_waitcnt(0);
        unsigned nloc = b.st[0], nx = b.st[1];
        if (nloc == 0u) { xcd_barrier_complete(bar, b.x, nloc, nx); b.st[0] = nloc; b.st[1] = nx; }
        const unsigned old = xb_add(&bar[XB_XSUB(b.x)], 1u);
        const unsigned gen = old / nloc;
        if (old + 1u == (gen + 1u) * nloc) {
            __builtin_amdgcn_fence(__ATOMIC_RELEASE, "agent");
            asm volatile("s_waitcnt vmcnt(0)" ::: "memory");
            const unsigned og = xb_add(&bar[XB_TOP], 1u);
            const unsigned tg = og / nx;
            if (og + 1u == (tg + 1u) * nx) xb_add(&bar[XB_TOPGEN], 1u);
            else XB_SPIN(xb_ld(&bar[XB_TOPGEN]) == tg, bar);
            __builtin_amdgcn_fence(__ATOMIC_ACQUIRE, "agent");
            xb_add(&bar[XB_XGEN(b.x)], 1u);
            asm volatile("s_waitcnt vmcnt(0)" ::: "memory");
        } else {
            XB_SPIN(xb_ld(&bar[XB_XGEN(b.x)]) == gen, bar);
            __builtin_amdgcn_fence(__ATOMIC_ACQUIRE, "agent");
            asm volatile("s_waitcnt vmcnt(0)" ::: "memory");
        }
    }
    __syncthreads();
}

struct Args { const float* in[18]; float* out; unsigned char* ws; int ph_lo, ph_hi; };
__device__ __forceinline__ const float* inp(int k) {
    const __attribute__((address_space(4))) Args* ap = (const __attribute__((address_space(4))) Args*)__builtin_amdgcn_kernarg_segment_ptr();
    asm volatile("" : "+s"(ap));
    return ap->in[k];
}
struct Frame {
    LAS unsigned char* lds;
    int tid, lane, wave, vcu, G;
    bool probe;
    float* out;
    unsigned char* ws;
};
__device__ __forceinline__ float wave_sum(float v) {
#pragma unroll
    for (int o = 1; o < 64; o <<= 1) v += __shfl_xor(v, o);
    return v;
}

namespace pg8 {
struct EpiAll {
    static constexpr bool PERM = true, AFTER_DRAIN = false;
    int mode;
    unsigned char* ws;
    float* xout;
    bool probe;
    PG8_LAS float* ex;
    __device__ __forceinline__ void operator()(const f32x4 (&acc)[2][2][4][2], const Unit& u, int wr, int wc, int fr, int fq) const {
        const int row0 = u.pm * BM + wr * 64 + fr;
        bf16_t* const o0 = (bf16_t*)(ws + (mode == 1 ? WS_S3 : WS_S1)); bf16_t* const o1 = (bf16_t*)(ws + WS_S2); bf16_t* const o2 = (bf16_t*)(ws + WS_S0); bf16_t* const o3 = (bf16_t*)(ws + WS_S6);
        const float* const rs = (const float*)(ws + (mode == 0 ? WS_RS0 : WS_SSQ1)); float* const ssq = (float*)(ws + WS_SSQ1);
        if (mode == 2 && ((u.pn >> 2) == 0 || (u.pn >> 2) == 2)) {
            const bool isK = (u.pn >> 2) == 0;
            const float* G = isK ? inp(13) : inp(16); const float osc = isK ? 1.0f : QSCALE;
            const int i0 = 16 * wc + 4 * fq;
            const f32x4 glo = *(const f32x4*)(G + i0), ghi = *(const f32x4*)(G + 64 + i0);
            const float* RC = (const float*)(ws + WS_ROPE); const float* RSn = RC + (size_t)SEQ * 64;
            bf16_t* base = isK ? o0 : o2; const int col0 = (u.pn & 3) * BM + wc * 32 + 8 * fq;
            PG8_LAS float* SS = ex; PG8_LAS float* KM = ex + 2048;
            float rsv[8];
#pragma unroll
            for (int ai = 0; ai < 2; ++ai)
#pragma unroll
                for (int m = 0; m < 4; ++m) { const int row = row0 + ai * HALF + m * 16;
                    const f32x4* sp = (const f32x4*)(rs + (size_t)row * 16); const f32x4 s0 = sp[0], s1 = sp[1], s2 = sp[2], s3 = sp[3];
                    const float tot = ((s0[0] + s0[1]) + (s0[2] + s0[3])) + ((s1[0] + s1[1]) + (s1[2] + s1[3])) + ((s2[0] + s2[1]) + (s2[2] + s2[3])) + ((s3[0] + s3[1]) + (s3[2] + s3[3]));
                    const float sc = 1.0f / sqrtf(tot * (1.0f / DM) + EPS); rsv[ai * 4 + m] = sc;
#pragma unroll
                    for (int bj = 0; bj < 2; ++bj) { const f32x4 v0 = acc[ai][bj][m][0] * sc, v1 = acc[ai][bj][m][1] * sc;
                        float ss = ((v0[0] * v0[0] + v0[1] * v0[1]) + (v0[2] * v0[2] + v0[3] * v0[3])) + ((v1[0] * v1[0] + v1[1] * v1[1]) + (v1[2] * v1[2] + v1[3] * v1[3]));
                        ss += __shfl_xor(ss, 16); ss += __shfl_xor(ss, 32);
                        if (fq == 0) SS[((wr * 128 + ai * 64 + m * 16 + fr) * 2 + bj) * 4 + wc] = ss; } }
            asm volatile("s_waitcnt lgkmcnt(0)" ::: "memory"); __builtin_amdgcn_s_barrier(); asm volatile("" ::: "memory");
            float cs[2][8];
#pragma unroll
            for (int bj = 0; bj < 2; ++bj)
#pragma unroll
                for (int e = 0; e < 8; ++e) cs[bj][e] = 0.f;
#pragma unroll
            for (int ai = 0; ai < 2; ++ai)
#pragma unroll
                for (int m = 0; m < 4; ++m) { const int row = row0 + ai * HALF + m * 16; const int pos = row & (SEQ - 1);
                    const f32x4 cs4 = *(const f32x4*)(RC + (size_t)pos * 64 + i0), sn4 = *(const f32x4*)(RSn + (size_t)pos * 64 + i0);
                    bf16_t* rowp = base + (size_t)row * DM + col0;
#pragma unroll
                    for (int bj = 0; bj < 2; ++bj) { const f32x4 pt = *(const PG8_LAS f32x4*)&SS[((wr * 128 + ai * 64 + m * 16 + fr) * 2 + bj) * 4];
                        const float tot = (pt[0] + pt[1]) + (pt[2] + pt[3]);
                        const float rinv = (1.0f / sqrtf(tot * (1.0f / HD) + EPS)) * rsv[ai * 4 + m];
                        f32x4 o1, o2;
#pragma unroll
                        for (int e = 0; e < 4; ++e) { const float x1 = acc[ai][bj][m][0][e] * rinv * glo[e], x2 = acc[ai][bj][m][1][e] * rinv * ghi[e];
                            o1[e] = (x1 * cs4[e] - x2 * sn4[e]) * osc; o2[e] = (x2 * cs4[e] + x1 * sn4[e]) * osc; cs[bj][e] += o1[e]; cs[bj][4 + e] += o2[e]; }
                        u32x4 w; w.x = cvt_pk_bf16(o1[0], o1[1]); w.y = cvt_pk_bf16(o1[2], o1[3]); w.z = cvt_pk_bf16(o2[0], o2[1]); w.w = cvt_pk_bf16(o2[2], o2[3]);
                        *(u32x4*)(rowp + bj * HALF) = w; } }
            if (isK) {
#pragma unroll
                for (int bj = 0; bj < 2; ++bj)
#pragma unroll
                    for (int e = 0; e < 8; ++e) { float v = cs[bj][e]; v += __shfl_xor(v, 1); v += __shfl_xor(v, 2); v += __shfl_xor(v, 4); v += __shfl_xor(v, 8); cs[bj][e] = v; }
                if (fr == 0) {
#pragma unroll
                    for (int bj = 0; bj < 2; ++bj)
#pragma unroll
                        for (int e = 0; e < 8; ++e) KM[wr * 256 + bj * 128 + 32 * wc + 8 * fq + e] = cs[bj][e]; }
                asm volatile("s_waitcnt lgkmcnt(0)" ::: "memory"); __builtin_amdgcn_s_barrier(); asm volatile("" ::: "memory");
                if (wr == 0 && fr == 0) { float* KMEAN = (float*)(ws + WS_KMEAN);
#pragma unroll
                    for (int bj = 0; bj < 2; ++bj) { const int hh = (u.pn & 3) * 2 + bj; float* kp = KMEAN + ((size_t)((u.pm >> 6) * NH + hh) * NBLK + (u.pm & 63)) * HD + 32 * wc + 8 * fq;
                        const int c = bj * 128 + 32 * wc + 8 * fq;
#pragma unroll
                        for (int e = 0; e < 8; ++e) kp[e] = (KM[c + e] + KM[256 + c + e]) * (1.0f / BLK); } }
            }
        } else if (mode == 0 || mode == 2) {
            const int tt = u.pn >> 2; const bool act = (mode == 0) ? (tt == 1) : (tt == 3);
            bf16_t* base = tt == 0 ? o0 : (tt == 1 ? o1 : (tt == 2 ? o2 : o3)); const int col0 = (u.pn & 3) * BM + wc * 32 + 8 * fq;
#pragma unroll
            for (int ai = 0; ai < 2; ++ai)
#pragma unroll
                for (int m = 0; m < 4; ++m) { const int row = row0 + ai * HALF + m * 16; float s;
                    if (mode == 0) s = rs[row];
                    else { const f32x4* sp = (const f32x4*)(rs + (size_t)row * 16); const f32x4 s0 = sp[0], s1 = sp[1], s2 = sp[2], s3 = sp[3];
                        const float tot = ((s0[0] + s0[1]) + (s0[2] + s0[3])) + ((s1[0] + s1[1]) + (s1[2] + s1[3])) + ((s2[0] + s2[1]) + (s2[2] + s2[3])) + ((s3[0] + s3[1]) + (s3[2] + s3[3]));
                        s = 1.0f / sqrtf(tot * (1.0f / DM) + EPS); }
                    bf16_t* rowp = base + (size_t)row * DM + col0;
#pragma unroll
                    for (int bj = 0; bj < 2; ++bj) { f32x4 v0 = acc[ai][bj][m][0] * s, v1 = acc[ai][bj][m][1] * s;
                        if (act) {
#pragma unroll
                            for (int j = 0; j < 4; ++j) { v0[j] = siluf_(v0[j]); v1[j] = siluf_(v1[j]); } }
                        u32x4 w; w.x = cvt_pk_bf16(v0[0], v0[1]); w.y = cvt_pk_bf16(v0[2], v0[3]); w.z = cvt_pk_bf16(v1[0], v1[1]); w.w = cvt_pk_bf16(v1[2], v1[3]);
                        *(u32x4*)(rowp + bj * HALF) = w; } }
        } else if (mode == 1) {
            const float* const xin = inp(0);
            const int col0 = u.pn * BM + wc * 32 + 8 * fq;
#pragma unroll
            for (int ai = 0; ai < 2; ++ai)
#pragma unroll
                for (int m = 0; m < 4; ++m) { const int row = row0 + ai * HALF + m * 16; const size_t off = (size_t)row * DM + col0; float ss = 0.f;
#pragma unroll
                    for (int bj = 0; bj < 2; ++bj) { const f32x4 xa = *(const f32x4*)(xin + off + bj * HALF), xb = *(const f32x4*)(xin + off + bj * HALF + 4);
                        const f32x4 v0 = acc[ai][bj][m][0] + xa, v1 = acc[ai][bj][m][1] + xb;
                        *(f32x4*)(xout + off + bj * HALF) = v0; *(f32x4*)(xout + off + bj * HALF + 4) = v1;
                        ss += ((v0[0] * v0[0] + v0[1] * v0[1]) + (v0[2] * v0[2] + v0[3] * v0[3])) + ((v1[0] * v1[0] + v1[1] * v1[1]) + (v1[2] * v1[2] + v1[3] * v1[3]));
                        u32x4 w; w.x = cvt_pk_bf16(v0[0], v0[1]); w.y = cvt_pk_bf16(v0[2], v0[3]); w.z = cvt_pk_bf16(v1[0], v1[1]); w.w = cvt_pk_bf16(v1[2], v1[3]);
                        *(u32x4*)(o0 + off + bj * HALF) = w; }
                    ss += __shfl_xor(ss, 16); ss += __shfl_xor(ss, 32);
                    if (fq == 0) ssq[(size_t)row * 16 + u.pn * 4 + wc] = ss;
                    asm volatile("" ::: "memory"); }
        } else {
            const int col0 = u.pn * BM + wc * 32 + 8 * fq;
#pragma unroll
            for (int ai = 0; ai < 2; ++ai)
#pragma unroll
                for (int m = 0; m < 4; ++m) { const size_t off = (size_t)(row0 + ai * HALF + m * 16) * DM + col0;
#pragma unroll
                    for (int bj = 0; bj < 2; ++bj) { float* p = xout + off + bj * HALF; const f32x4 xa = *(const f32x4*)p, xb = *(const f32x4*)(p + 4);
                        float* pw = probe ? (float*)(ws + 48 * MiB + (((off + bj * HALF) * 4) & (8 * MiB - 1))) : p;
                        *(f32x4*)pw = acc[ai][bj][m][0] + xa; *(f32x4*)(pw + 4) = acc[ai][bj][m][1] + xb; }
                    asm volatile("" ::: "memory"); }
        }
    }
};
}

__device__ __forceinline__ int fperm(int p) { return ((p >> 2) & 1) * 64 + (p >> 5) * 16 + ((p >> 3) & 3) * 4 + (p & 3); }
template <int MODE  >
__device__ __forceinline__ void p0_transpose_item(const float* W, int ldw, int Kd, bf16* WT, int drow0, const float* gain, LAS float* scr, int k0, int n0, int lane) {
    const int nn = n0 + (lane & 31);
    const int sc = (MODE == 1 && nn < 1024) ? ((nn & ~127) + fperm(nn & 127)) : nn;
#pragma unroll 8
    for (int i = 0; i < 32; ++i) { const int kk = 2 * i + (lane >> 5); float v = W[(size_t)(k0 + kk) * ldw + sc]; if (gain) v *= gain[k0 + kk]; scr[kk * 33 + (lane & 31)] = v; }
    LDS_WAIT(); asm volatile("" ::: "memory");
    const int c = lane & 7;
#pragma unroll
    for (int j = 0; j < 4; ++j) { const int n = (lane >> 3) + 8 * j; const LAS float* s = scr + (8 * c) * 33 + n;
        v4u o; o.x = pk2(s[0 * 33], s[1 * 33]); o.y = pk2(s[2 * 33], s[3 * 33]); o.z = pk2(s[4 * 33], s[5 * 33]); o.w = pk2(s[6 * 33], s[7 * 33]);
        *(v4u*)(WT + (size_t)(drow0 + n0 + n) * Kd + k0 + 8 * c) = o; }
    LDS_WAIT(); asm volatile("" ::: "memory");
}
__device__ __forceinline__ void sincos_acc(float angf, float& s, float& c) {
    const double a = (double)angf;
    const double k = __builtin_rint(a * 0.63661977236758134308);
    const double y = __builtin_fma(-k, 1.57079632679489661923, a) - k * 6.123233995736766e-17;
    const double y2 = y * y;
    double sp = -1.0 / 1307674368000.0; sp = sp * y2 + 1.0 / 6227020800.0; sp = sp * y2 - 1.0 / 39916800.0; sp = sp * y2 + 1.0 / 362880.0; sp = sp * y2 - 1.0 / 5040.0; sp = sp * y2 + 1.0 / 120.0; sp = sp * y2 - 1.0 / 6.0; sp = sp * y2 + 1.0;
    const double sy = sp * y;
    double cp = 1.0 / 20922789888000.0; cp = cp * y2 - 1.0 / 87178291200.0; cp = cp * y2 + 1.0 / 479001600.0; cp = cp * y2 - 1.0 / 3628800.0; cp = cp * y2 + 1.0 / 40320.0; cp = cp * y2 - 1.0 / 720.0; cp = cp * y2 + 1.0 / 24.0; cp = cp * y2 - 0.5; cp = cp * y2 + 1.0;
    const int q = ((int)k) & 3;
    const double ss = (q == 0) ? sy : (q == 1) ? cp : (q == 2) ? -sy : -cp;
    const double cc = (q == 0) ? cp : (q == 1) ? -sy : (q == 2) ? -cp : sy;
    s = (float)ss; c = (float)cc;
}
__device__ __forceinline__ void p0_prologue(Frame& F) {
    static constexpr float ROPE_INV[64] = {
        1.000000000e+00f, 8.659643531e-01f, 7.498942018e-01f, 6.493816376e-01f, 5.623413324e-01f, 4.869675338e-01f, 4.216965139e-01f, 3.651741147e-01f, 3.162277639e-01f, 2.738419771e-01f, 2.371373773e-01f, 2.053525001e-01f, 1.778279394e-01f, 1.539926529e-01f, 1.333521456e-01f, 1.154781953e-01f,
        1.000000015e-01f, 8.659642935e-02f, 7.498942316e-02f, 6.493816525e-02f, 5.623413250e-02f, 4.869675264e-02f, 4.216964915e-02f, 3.651741147e-02f, 3.162277490e-02f, 2.738419548e-02f, 2.371373773e-02f, 2.053525113e-02f, 1.778279431e-02f, 1.539926510e-02f, 1.333521400e-02f, 1.154781971e-02f,
        9.999999776e-03f, 8.659643121e-03f, 7.498942316e-03f, 6.493816152e-03f, 5.623413250e-03f, 4.869675264e-03f, 4.216964822e-03f, 3.651741194e-03f, 3.162277630e-03f, 2.738419687e-03f, 2.371373819e-03f, 2.053525066e-03f, 1.778279431e-03f, 1.539926510e-03f, 1.333521446e-03f, 1.154782018e-03f,
        1.000000047e-03f, 8.659643354e-04f, 7.498941850e-04f, 6.493816036e-04f, 5.623413017e-04f, 4.869675322e-04f, 4.216965172e-04f, 3.651741135e-04f, 3.162277571e-04f, 2.738419571e-04f, 2.371373703e-04f, 2.053525095e-04f, 1.778279402e-04f, 1.539926598e-04f, 1.333521504e-04f, 1.154782003e-04f};
    LAS float* scr = (LAS float*)(F.lds + F.wave * 16384);
    const int gw = F.vcu * 8 + F.wave, NGW = F.G * 8;
    bf16* WAIN = (bf16*)(F.ws + WS_WAIN); bf16* WAOUT = (bf16*)(F.ws + WS_WAOUT); bf16* WB1 = (bf16*)(F.ws + WS_WB1); bf16* WBOUT = (bf16*)(F.ws + WS_WBOUT); bf16* WRG = (bf16*)(F.ws + WS_WRG);
    constexpr int I0 = 16 * 64, I1 = 16 * 32, I2 = 16 * 64, I3 = 16 * 64, I4 = 16 * 32, I5 = 16 * 8;
    constexpr int NITEMS = I0 + I1 + I2 + I3 + I4 + I5;
    for (int it = gw; it < NITEMS; it += NGW) {
        int r = it;
        if (r < I0) { p0_transpose_item<0>(inp(2), 2048, DM, WAIN, 0, inp(1), scr, (r / 64) * 64, (r % 64) * 32, F.lane); continue; } r -= I0;
        if (r < I1) { p0_transpose_item<0>(inp(10), 1024, DM, WAOUT, 0, nullptr, scr, (r / 32) * 64, (r % 32) * 32, F.lane); continue; } r -= I1;
        if (r < I2) { p0_transpose_item<1>(inp(12), 2048, DM, WB1, 0, inp(11), scr, (r / 64) * 64, (r % 64) * 32, F.lane); continue; } r -= I2;
        if (r < I3) { p0_transpose_item<1>(inp(15), 2048, DM, WB1, 2048, inp(14), scr, (r / 64) * 64, (r % 64) * 32, F.lane); continue; } r -= I3;
        if (r < I4) { p0_transpose_item<0>(inp(17), 1024, DM, WBOUT, 0, nullptr, scr, (r / 32) * 64, (r % 32) * 32, F.lane); continue; } r -= I4;
        { const int mat = r >> 3, sub = r & 7, n = mat >> 1, which = mat & 1;
          const float* W = (which ? inp(7) : inp(5)) + (size_t)n * 128 * 128;
          p0_transpose_item<0>(W, 128, 128, WRG, n * 256 + which * 128, nullptr, scr, (sub >> 2) * 64, (sub & 3) * 32, F.lane); }
    }
    bf16* XB = (bf16*)(F.ws + WS_S0); float* RS0 = (float*)(F.ws + WS_RS0);
    for (int m = gw; m < T; m += NGW) {
        const f32x4* xr = (const f32x4*)(inp(0) + (size_t)m * DM) + F.lane;
        f32x4 v[4]; float s = 0.f;
#pragma unroll
        for (int j = 0; j < 4; ++j) { v[j] = xr[64 * j]; s += (v[j][0] * v[j][0] + v[j][1] * v[j][1]) + (v[j][2] * v[j][2] + v[j][3] * v[j][3]); }
        s = wave_sum(s);
        if (F.lane == 0) RS0[m] = 1.0f / sqrtf(s * (1.0f / DM) + EPS);
        v2u* o8 = (v2u*)(XB + (size_t)m * DM) + F.lane;
#pragma unroll
        for (int j = 0; j < 4; ++j) { v2u w; w.x = pk2(v[j][0], v[j][1]); w.y = pk2(v[j][2], v[j][3]); o8[64 * j] = w; }
    }
    float* RC = (float*)(F.ws + WS_ROPE); float* RSn = RC + (size_t)SEQ * 64;
    for (int idx = gw * 64 + F.lane; idx < SEQ * 64; idx += NGW * 64) {
        const int pos = idx >> 6, i = idx & 63;
        const float inv = ROPE_INV[i];
        const float ang = (float)pos * inv; float s, c; sincos_acc(ang, s, c);
        RC[idx] = c; RSn[idx] = s;
    }
}

constexpr int XB_PITCH = 272;
constexpr int XB_TILE = 256 * XB_PITCH;
__device__ __forceinline__ int xb_addr(int tok, int byteoff) { return tok * XB_PITCH + ((((byteoff >> 4) ^ (((tok >> 6) & 3) << 2)) << 4) | (byteoff & 15)); }
__device__ __forceinline__ void scan_unit(Frame& F, const bool PASS2, int b, int c, int n) {
    LAS unsigned char* XBt = F.lds; LAS unsigned char* SGt = F.lds + XB_TILE;
    const bf16* UX = (const bf16*)(F.ws + WS_S1); const bf16* SG = (const bf16*)(F.ws + WS_S2); bf16* Y = (bf16*)(F.ws + WS_S0);
    float* SUMA = (float*)(F.ws + WS_SUMA); float* SUMB = (float*)(F.ws + WS_SUMB); float* SEGA = (float*)(F.ws + WS_SEGA); float* SEGB = (float*)(F.ws + WS_SEGB);
    const int t0 = c * BLK; const size_t rowbase = (size_t)b * SEQ + t0;
    {
        const int cg = F.tid & 15, tr = F.tid >> 4, chb = n * 128 + cg * 8;
        const float* cw = inp(3); const float* cb = inp(4);
        float w[4][8], bia[8];
#pragma unroll
        for (int k = 0; k < 4; ++k) { const f32x4 a = *(const f32x4*)(cw + k * DM + chb), bb = *(const f32x4*)(cw + k * DM + chb + 4);
            w[k][0] = a[0]; w[k][1] = a[1]; w[k][2] = a[2]; w[k][3] = a[3]; w[k][4] = bb[0]; w[k][5] = bb[1]; w[k][6] = bb[2]; w[k][7] = bb[3]; }
        { const f32x4 a = *(const f32x4*)(cb + chb), bb = *(const f32x4*)(cb + chb + 4); bia[0] = a[0]; bia[1] = a[1]; bia[2] = a[2]; bia[3] = a[3]; bia[4] = bb[0]; bia[5] = bb[1]; bia[6] = bb[2]; bia[7] = bb[3]; }
        v4u raw[11];
#pragma unroll
        for (int i = 0; i < 11; ++i) { const int t = 8 * tr + i - 3; const bool ok = (c > 0) || (t >= 0);
            raw[i] = ok ? *(const v4u*)(UX + (size_t)((long)rowbase + t) * DM + chb) : (v4u){0u, 0u, 0u, 0u}; }
        v4u sgv[8];
        if (PASS2) {
#pragma unroll
            for (int it = 0; it < 8; ++it) { const int id = F.tid + 512 * it, row = id >> 4, ch = id & 15; sgv[it] = *(const v4u*)(SG + (rowbase + row) * DM + n * 128 + ch * 8); }
        }
#pragma unroll
        for (int i = 0; i < 8; ++i) { float o[8];
#pragma unroll
            for (int e = 0; e < 8; ++e) o[e] = bia[e];
#pragma unroll
            for (int k = 0; k < 4; ++k) { const v4u r = raw[i + k];
                o[0] += w[k][0] * bflo(r.x); o[1] += w[k][1] * bfhi(r.x); o[2] += w[k][2] * bflo(r.y); o[3] += w[k][3] * bfhi(r.y);
                o[4] += w[k][4] * bflo(r.z); o[5] += w[k][5] * bfhi(r.z); o[6] += w[k][6] * bflo(r.w); o[7] += w[k][7] * bfhi(r.w); }
            v4u pk; pk.x = pk2(o[0], o[1]); pk.y = pk2(o[2], o[3]); pk.z = pk2(o[4], o[5]); pk.w = pk2(o[6], o[7]);
            *(LAS v4u*)(XBt + xb_addr(8 * tr + i, cg * 16)) = pk; }
        if (PASS2) {
#pragma unroll
            for (int it = 0; it < 8; ++it) { const int id = F.tid + 512 * it, row = id >> 4, ch = id & 15; *(LAS v4u*)(SGt + xb_addr(row, ch * 16)) = sgv[it]; }
        }
    }
    __syncthreads();
    {
        const int w = F.wave, cl = F.lane & 15, q = F.lane >> 4;
        const bf16* WRG = (const bf16*)(F.ws + WS_WRG);
        bf16x8 Br[4], Bi[4];
#pragma unroll
        for (int ks = 0; ks < 4; ++ks) { Br[ks] = *(const bf16x8*)(WRG + (size_t)(n * 256 + 16 * w + cl) * 128 + 32 * ks + 8 * q);
                                         Bi[ks] = *(const bf16x8*)(WRG + (size_t)(n * 256 + 128 + 16 * w + cl) * 128 + 32 * ks + 8 * q); }
        const int ch = n * 128 + 16 * w + cl;
        const float rb = inp(6)[ch] * -1.4426950408889634f, ib = inp(8)[ch] * -1.4426950408889634f, lam = inp(9)[ch];
        const float z = -lam; const float sp = fmaxf(z, 0.f) + log1pf(expf(-fabsf(z)));
        const float c8 = -8.0f * sp, c8l = c8 * 1.4426950408889634f;
        float Arun = 1.f, h = 0.f;
        if (PASS2) {
            float Aq = 1.f, Bq = 0.f;
            { float Av[16], Bv[16];
#pragma unroll
              for (int i = 0; i < 16; ++i) { const int cc = 16 * q + i; const bool ok = cc < c; Av[i] = ok ? SUMA[(size_t)(b * 64 + cc) * DM + ch] : 1.f; Bv[i] = ok ? SUMB[(size_t)(b * 64 + cc) * DM + ch] : 0.f; }
#pragma unroll
              for (int i = 0; i < 16; ++i) { Bq = Av[i] * Bq + Bv[i]; Aq *= Av[i]; } }
            float Sa[3], Sb[3];
#pragma unroll
            for (int i = 0; i < 3; ++i) { const bool ok = i < q; Sa[i] = ok ? SEGA[(size_t)(b * 256 + 4 * c + i) * DM + ch] : 1.f; Sb[i] = ok ? SEGB[(size_t)(b * 256 + 4 * c + i) * DM + ch] : 0.f; }
#pragma unroll
            for (int k = 0; k < 4; ++k) { const float Ak = __shfl(Aq, cl + 16 * k), Bk = __shfl(Bq, cl + 16 * k); h = Ak * h + Bk; }
#pragma unroll
            for (int i = 0; i < 3; ++i) h = Sa[i] * h + Sb[i];
        }
        const int arow = 64 * (cl >> 2) + (cl & 3);
        int aoffs[4];
#pragma unroll
        for (int ks = 0; ks < 4; ++ks) aoffs[ks] = xb_addr(arow, (32 * ks + 8 * q) * 2);
        const int eoff = xb_addr(64 * q, (16 * w + cl) * 2);
#pragma unroll 2
        for (int mt = 0; mt < 16; ++mt) {
            pg8::f32x4 accR = {0.f, 0.f, 0.f, 0.f}, accI = {0.f, 0.f, 0.f, 0.f};
#pragma unroll
            for (int ks = 0; ks < 4; ++ks) { const bf16x8 a = *(const LAS bf16x8*)(XBt + aoffs[ks] + 4 * mt * XB_PITCH);
                accR = __builtin_amdgcn_mfma_f32_16x16x32_bf16(a, Br[ks], accR, 0, 0, 0);
                accI = __builtin_amdgcn_mfma_f32_16x16x32_bf16(a, Bi[ks], accI, 0, 0, 0); }
#pragma unroll
            for (int r = 0; r < 4; ++r) { const int eo = eoff + (4 * mt + r) * XB_PITCH;
                const float xv = bf1(*(const LAS unsigned short*)(XBt + eo));
                const float rg = __builtin_amdgcn_rcpf(1.f + fast_exp2(accR[r] * -1.4426950408889634f + rb));
                const float ig = __builtin_amdgcn_rcpf(1.f + fast_exp2(accI[r] * -1.4426950408889634f + ib));
                const float a = fast_exp2(c8l * rg);
                const float x2 = 2.f * c8 * rg;
                float pz = 1.0f / 120.0f; pz = pz * x2 + 1.0f / 24.0f; pz = pz * x2 + 1.0f / 6.0f; pz = pz * x2 + 0.5f; pz = pz * x2 + 1.0f;
                const float em1 = (x2 > -0.3f) ? (-x2 * pz) : (1.0f - a * a);
                const float bt = __builtin_amdgcn_sqrtf(em1) * ig * xv;
                h = a * h + bt;
                if (!PASS2) Arun *= a;
                else { LAS unsigned short* sp2 = (LAS unsigned short*)(SGt + eo); const float g = bf1(*sp2); *sp2 = (unsigned short)f2bf(h * g); } }
        }
        if (!PASS2) {
            SEGA[(size_t)(b * 256 + 4 * c + q) * DM + ch] = Arun; SEGB[(size_t)(b * 256 + 4 * c + q) * DM + ch] = h;
            float Ac = 1.f, Bc = 0.f;
#pragma unroll
            for (int k = 0; k < 4; ++k) { const float Ak = __shfl(Arun, cl + 16 * k), Bk = __shfl(h, cl + 16 * k); Bc = Ak * Bc + Bk; Ac *= Ak; }
            if (q == 0) { SUMA[(size_t)(b * 64 + c) * DM + ch] = Ac; SUMB[(size_t)(b * 64 + c) * DM + ch] = Bc; }
        }
    }
    __syncthreads();
    if (PASS2) {
#pragma unroll
        for (int it = 0; it < 8; ++it) { const int id = F.tid + 512 * it, row = id >> 4, ch = id & 15;
            const v4u v = *(const LAS v4u*)(SGt + xb_addr(row, ch * 16));
            *(v4u*)(Y + (rowbase + row) * DM + n * 128 + ch * 8) = v; }
        __syncthreads();
    }
}

__device__ __forceinline__ void fix_unit(Frame& F, int b, int blk, int h, int which  ) {
    bf16* BUF = (bf16*)(F.ws + (which ? WS_S0 : WS_S1));
    const float* G = which ? inp(16) : inp(13);
    const float* RC = (const float*)(F.ws + WS_ROPE); const float* RSn = RC + (size_t)SEQ * 64;
    LAS float* red = (LAS float*)F.lds;
    const int k16 = F.tid & 15, ts = F.tid >> 4;
    float g[8];
    { const f32x4 a = *(const f32x4*)(G + 4 * k16), bb = *(const f32x4*)(G + 64 + 4 * k16); g[0] = a[0]; g[1] = a[1]; g[2] = a[2]; g[3] = a[3]; g[4] = bb[0]; g[5] = bb[1]; g[6] = bb[2]; g[7] = bb[3]; }
    const float osc = which ? QSCALE : 1.0f;
    float km[8] = {0.f, 0.f, 0.f, 0.f, 0.f, 0.f, 0.f, 0.f};
#pragma unroll 2
    for (int it = 0; it < 8; ++it) {
        const int tl = ts + 32 * it, pos = blk * BLK + tl; const size_t row = (size_t)b * SEQ + pos;
        bf16* p = BUF + row * DM + h * 128 + 8 * k16;
        const v4u raw = *(const v4u*)p;
        float v[8] = {bflo(raw.x), bfhi(raw.x), bflo(raw.y), bfhi(raw.y), bflo(raw.z), bfhi(raw.z), bflo(raw.w), bfhi(raw.w)};
        float ss = 0.f;
#pragma unroll
        for (int e = 0; e < 8; ++e) ss += v[e] * v[e];
        ss += __shfl_xor(ss, 1); ss += __shfl_xor(ss, 2); ss += __shfl_xor(ss, 4); ss += __shfl_xor(ss, 8);
        const float rinv = 1.0f / sqrtf(ss * (1.0f / HD) + EPS);
        const f32x4 cs = *(const f32x4*)(RC + (size_t)pos * 64 + 4 * k16), sn = *(const f32x4*)(RSn + (size_t)pos * 64 + 4 * k16);
        float o[8];
#pragma unroll
        for (int e = 0; e < 4; ++e) { const float x1 = v[e] * rinv * g[e], x2 = v[4 + e] * rinv * g[4 + e];
            o[e] = (x1 * cs[e] - x2 * sn[e]) * osc; o[4 + e] = (x2 * cs[e] + x1 * sn[e]) * osc; }
#pragma unroll
        for (int e = 0; e < 8; ++e) km[e] += o[e];
        v4u w; w.x = pk2(o[0], o[1]); w.y = pk2(o[2], o[3]); w.z = pk2(o[4], o[5]); w.w = pk2(o[6], o[7]);
        if (F.probe) *(v4u*)(F.ws + 48 * MiB + (((size_t)(p - BUF) * 2) & (8 * MiB - 1))) = w; else *(v4u*)p = w;
    }
    if (which == 0) {
#pragma unroll
        for (int e = 0; e < 8; ++e) red[ts * 128 + 8 * k16 + e] = km[e];
        __syncthreads();
        if (F.tid < 128) { float s = 0.f;
#pragma unroll 8
            for (int j = 0; j < 32; ++j) s += red[j * 128 + F.tid];
            ((float*)(F.ws + WS_KMEAN))[((size_t)(b * NH + h) * NBLK + blk) * HD + F.tid] = s * (1.0f / BLK); }
        __syncthreads();
    }
}

#define KSWZ(row, colB) ((row) * 256 + ((colB) ^ (((row) & 7) << 4)))
__device__ __forceinline__ int crow(int r, int hi) { return (r & 3) + 8 * (r >> 2) + 4 * hi; }
__device__ __forceinline__ int v_st(int k, int c) { const int kk = (k & ~0xC) | ((k & 4) << 1) | ((k & 8) >> 1); return ((kk >> 3) * 4 + (c >> 5)) * 512 + ((kk & 7) * 32 + (c & 31)) * 2; }
__device__ __forceinline__ int v_rd_base(int lane) { return ((lane & 3) << 3) | (((lane >> 2) & 3) << 6) | (((lane >> 4) & 1) << 5) | (((lane >> 5) & 1) << 8); }
constexpr int v_rd_off(int d0, int ks, int half) { return d0 * 512 + ks * 4096 + half * 2048; }
template <int OFF> __device__ __forceinline__ s16x4 tr_read(int vb) {
    s16x4 r; asm volatile("ds_read_b64_tr_b16 %0, %1 offset:%2" : "=&v"(r) : "v"(vb), "i"(OFF) : "memory"); return r;
}
__device__ __forceinline__ void qkt_acc(f32x16& p0, f32x16& p1, const LAS unsigned char* Ks, const bf16x8 (&qr)[8], int r32, int hi) {
#pragma unroll
    for (int d0 = 0; d0 < 8; ++d0) { const int cb = (d0 * 16 + hi * 8) * 2;
        const bf16x8 b0 = *(const LAS bf16x8*)(Ks + KSWZ(r32, cb));
        const bf16x8 b1 = *(const LAS bf16x8*)(Ks + KSWZ(32 + r32, cb));
        p0 = __builtin_amdgcn_mfma_f32_32x32x16_bf16(b0, qr[d0], p0, 0, 0, 0);
        p1 = __builtin_amdgcn_mfma_f32_32x32x16_bf16(b1, qr[d0], p1, 0, 0, 0); }
}
template <int D0> __device__ __forceinline__ void pv_one(f32x16& od, int vb, bf16x8 pa0, bf16x8 pa1, bf16x8 pa2, bf16x8 pa3) {
    const s16x4 l0 = tr_read<v_rd_off(D0, 0, 0)>(vb), h0 = tr_read<v_rd_off(D0, 0, 1)>(vb), l1 = tr_read<v_rd_off(D0, 1, 0)>(vb), h1 = tr_read<v_rd_off(D0, 1, 1)>(vb);
    const s16x4 l2 = tr_read<v_rd_off(D0, 2, 0)>(vb), h2 = tr_read<v_rd_off(D0, 2, 1)>(vb), l3 = tr_read<v_rd_off(D0, 3, 0)>(vb), h3 = tr_read<v_rd_off(D0, 3, 1)>(vb);
    asm volatile("s_waitcnt lgkmcnt(0)" ::: "memory"); SBAR();
#define PKV(L, H) (bf16x8){L[0], L[1], L[2], L[3], H[0], H[1], H[2], H[3]}
    od = __builtin_amdgcn_mfma_f32_32x32x16_bf16(PKV(l0, h0), pa0, od, 0, 0, 0);
    od = __builtin_amdgcn_mfma_f32_32x32x16_bf16(PKV(l1, h1), pa1, od, 0, 0, 0);
    od = __builtin_amdgcn_mfma_f32_32x32x16_bf16(PKV(l2, h2), pa2, od, 0, 0, 0);
    od = __builtin_amdgcn_mfma_f32_32x32x16_bf16(PKV(l3, h3), pa3, od, 0, 0, 0);
#undef PKV
}
constexpr float THR2 = 8.0f;
__device__ __forceinline__ void attn_subtile(f32x16 (&o)[4], float& m, float& l, const LAS unsigned char* Ks, int vb, const bf16x8 (&qr)[8], int r32, int hi, bool diag, int kb0, int qidx) {
    const bool fresh = m <= -1e29f;
    const float mref = fresh ? 0.f : m, nm = -mref;
    f32x16 p0, p1;
#pragma unroll
    for (int r = 0; r < 16; ++r) { p0[r] = nm; p1[r] = nm; }
    qkt_acc(p0, p1, Ks, qr, r32, hi);
    if (diag) {
#pragma unroll
        for (int r = 0; r < 16; ++r) { const int kk = kb0 + crow(r, hi); if (kk > qidx) p0[r] = -1e30f; if (kk + 32 > qidx) p1[r] = -1e30f; }
    }
    float pmax = p0[0];
#pragma unroll
    for (int r = 1; r < 16; ++r) pmax = fmaxf(pmax, p0[r]);
#pragma unroll
    for (int r = 0; r < 16; ++r) pmax = fmaxf(pmax, p1[r]);
    { auto rr = __builtin_amdgcn_permlane32_swap(__float_as_uint(pmax), __float_as_uint(pmax), false, false);
      pmax = fmaxf(__uint_as_float(rr[0]), __uint_as_float(rr[1])); }
    const bool need = fresh || (pmax > THR2);
    if (__any(need)) {
        const float d = need ? pmax : 0.f;
        const float alpha = fresh ? 0.f : fast_exp2(-d);
        m = mref + d; l *= alpha;
#pragma unroll
        for (int r = 0; r < 16; ++r) { p0[r] -= d; p1[r] -= d; }
#pragma unroll
        for (int dd = 0; dd < 4; ++dd)
#pragma unroll
            for (int r = 0; r < 16; ++r) o[dd][r] *= alpha;
    }
    float ps = 0.f;
#pragma unroll
    for (int r = 0; r < 16; ++r) { p0[r] = fast_exp2(p0[r]); ps += p0[r]; }
#pragma unroll
    for (int r = 0; r < 16; ++r) { p1[r] = fast_exp2(p1[r]); ps += p1[r]; }
    { auto rr = __builtin_amdgcn_permlane32_swap(__float_as_uint(ps), __float_as_uint(ps), false, false);
      ps = __uint_as_float(rr[0]) + __uint_as_float(rr[1]); }
    l += ps;
    bf16x8 pa0, pa1, pa2, pa3;
#define PK4(P, BASE, OUT) do { unsigned a0 = pk2(P[BASE + 0], P[BASE + 1]), a1 = pk2(P[BASE + 2], P[BASE + 3]);   \
    unsigned b0 = pk2(P[BASE + 4], P[BASE + 5]), b1 = pk2(P[BASE + 6], P[BASE + 7]);                              \
    auto r0 = __builtin_amdgcn_permlane32_swap(a0, b0, false, false); auto r1 = __builtin_amdgcn_permlane32_swap(a1, b1, false, false); \
    v4u w = {r0[0], r1[0], r0[1], r1[1]}; OUT = __builtin_bit_cast(bf16x8, w); } while (0)
    PK4(p0, 0, pa0); PK4(p0, 8, pa1); PK4(p1, 0, pa2); PK4(p1, 8, pa3);
#undef PK4
    pv_one<0>(o[0], vb, pa0, pa1, pa2, pa3); pv_one<1>(o[1], vb, pa0, pa1, pa2, pa3); pv_one<2>(o[2], vb, pa0, pa1, pa2, pa3); pv_one<3>(o[3], vb, pa0, pa1, pa2, pa3);
}
__device__ __forceinline__ void row_store_T(unsigned char* rowp, const f32x16 (&o)[4], float sc, int hi, bool pred) {
#pragma unroll
    for (int j = 0; j < 8; ++j) { const int d0 = j >> 1, g0 = (j & 1) * 2;
        unsigned ax = pk2(o[d0][4 * g0 + 0] * sc, o[d0][4 * g0 + 1] * sc), ay = pk2(o[d0][4 * g0 + 2] * sc, o[d0][4 * g0 + 3] * sc);
        unsigned bx = pk2(o[d0][4 * g0 + 4] * sc, o[d0][4 * g0 + 5] * sc), by = pk2(o[d0][4 * g0 + 6] * sc, o[d0][4 * g0 + 7] * sc);
        auto r0 = __builtin_amdgcn_permlane32_swap(ax, bx, false, false); auto r1 = __builtin_amdgcn_permlane32_swap(ay, by, false, false);
        const v4u w = {r0[0], r1[0], r0[1], r1[1]};
        if (pred) *(v4u*)(rowp + 32 * j + 16 * hi) = w; }
}
__device__ __forceinline__ void row_load_T(const unsigned char* rowp, f32x16 (&v)[4], int hi) {
    v4u w[8];
#pragma unroll
    for (int j = 0; j < 8; ++j) w[j] = *(const v4u*)(rowp + 32 * j + 16 * hi);
#pragma unroll
    for (int j = 0; j < 8; ++j) { const int d0 = j >> 1, g0 = (j & 1) * 2;
        auto r0 = __builtin_amdgcn_permlane32_swap(w[j].x, w[j].z, false, false); auto r1 = __builtin_amdgcn_permlane32_swap(w[j].y, w[j].w, false, false);
        const unsigned ax = r0[0], bx = r0[1], ay = r1[0], by = r1[1];
        v[d0][4 * g0 + 0] = bflo(ax); v[d0][4 * g0 + 1] = bfhi(ax); v[d0][4 * g0 + 2] = bflo(ay); v[d0][4 * g0 + 3] = bfhi(ay);
        v[d0][4 * g0 + 4] = bflo(bx); v[d0][4 * g0 + 5] = bfhi(bx); v[d0][4 * g0 + 6] = bflo(by); v[d0][4 * g0 + 7] = bfhi(by); }
}
constexpr int KIMG = 0, VIMG = 65536, ATT_AUX = 131072;
__device__ __forceinline__ void load_kv_block(Frame& F, int b, int h, int j) {
    const bf16* KB = (const bf16*)(F.ws + WS_S1); const bf16* VB = (const bf16*)(F.ws + WS_S2);
    const size_t base = ((size_t)b * SEQ + (size_t)j * BLK) * DM + h * 128;
    v4u kr[8], vr[8];
#pragma unroll
    for (int it = 0; it < 8; ++it) { const int id = F.tid + 512 * it, row = id >> 4, c = id & 15;
        kr[it] = *(const v4u*)(KB + base + (size_t)row * DM + c * 8); vr[it] = *(const v4u*)(VB + base + (size_t)row * DM + c * 8); }
#pragma unroll
    for (int it = 0; it < 8; ++it) { const int id = F.tid + 512 * it, row = id >> 4, c = id & 15;
        *(LAS v4u*)(F.lds + KIMG + (row >> 6) * 16384 + KSWZ(row & 63, c * 16)) = kr[it];
        *(LAS v4u*)(F.lds + VIMG + (row >> 6) * 16384 + v_st(row & 63, c * 8)) = vr[it]; }
}

__device__ __forceinline__ void select_unit(Frame& F, int b, int h, int qb) {
    LAS unsigned char* KH = F.lds; LAS unsigned char* KL = F.lds + 16384;
    LAS int* cnt = (LAS int*)(F.lds + 32768); LAS int* cursor = cnt + 64; LAS int* offs = cnt + 128; LAS unsigned short* ent = (LAS unsigned short*)(F.lds + 32768 + 1024);
    const float* KM = (const float*)(F.ws + WS_KMEAN) + (size_t)(b * NH + h) * NBLK * HD;
    const bf16* QB = (const bf16*)(F.ws + WS_S0);
    unsigned short* ENT = (unsigned short*)(F.ws + WS_ENT) + (size_t)((b * NH + h) * NBLK + qb) * 768;
    unsigned short* OFFS = (unsigned short*)(F.ws + WS_OFFS) + (size_t)((b * NH + h) * NBLK + qb) * OFFS_PITCH;
    unsigned* NTOT = (unsigned*)(F.ws + WS_CTL) + CW_NTOT + (b * NH + h) * NBLK;
#pragma unroll
    for (int it = 0; it < 2; ++it) { const int id = F.tid + 512 * it, row = id >> 4, c = id & 15;
        const f32x4 a = *(const f32x4*)(KM + row * HD + c * 8), bb = *(const f32x4*)(KM + row * HD + c * 8 + 4);
        float v[8] = {a[0], a[1], a[2], a[3], bb[0], bb[1], bb[2], bb[3]}; unsigned hw[8]; float lo[8];
#pragma unroll
        for (int e = 0; e < 8; ++e) { if (row >= qb) v[e] = 0.f; hw[e] = f2bf(v[e]); lo[e] = v[e] - __builtin_bit_cast(float, hw[e] << 16); }
        v4u wh = {hw[0] | (hw[1] << 16), hw[2] | (hw[3] << 16), hw[4] | (hw[5] << 16), hw[6] | (hw[7] << 16)};
        v4u wl = {pk2(lo[0], lo[1]), pk2(lo[2], lo[3]), pk2(lo[4], lo[5]), pk2(lo[6], lo[7])};
        *(LAS v4u*)(KH + KSWZ(row, c * 16)) = wh; *(LAS v4u*)(KL + KSWZ(row, c * 16)) = wl; }
    if (F.tid < 64) cnt[F.tid] = 0;
    __syncthreads();
    const int r32 = F.lane & 31, hi = F.lane >> 5, ql = 32 * F.wave + r32;
    const size_t tok = (size_t)b * SEQ + qb * BLK + ql;
    bf16x8 qr[8];
#pragma unroll
    for (int d0 = 0; d0 < 8; ++d0) qr[d0] = *(const bf16x8*)(QB + tok * DM + h * 128 + d0 * 16 + hi * 8);
    f32x16 p0 = {}, p1 = {};
    qkt_acc(p0, p1, KH, qr, r32, hi); qkt_acc(p0, p1, KL, qr, r32, hi);
    float cv[32]; int ci[32];
#pragma unroll
    for (int r = 0; r < 16; ++r) { const int j0 = crow(r, hi), j1 = 32 + crow(r, hi);
        cv[r] = j0 < qb ? p0[r] : -INFINITY; ci[r] = j0; cv[16 + r] = j1 < qb ? p1[r] : -INFINITY; ci[16 + r] = j1; }
    float tv[3]; int ti[3];
#pragma unroll
    for (int pass = 0; pass < 3; ++pass) { float bv = -INFINITY; int bi = 1000;
#pragma unroll
        for (int r = 0; r < 32; ++r) { const bool excl = (pass > 0 && ci[r] == ti[0]) || (pass > 1 && ci[r] == ti[1]);
            const bool take = !excl && ((cv[r] > bv) || (cv[r] == bv && ci[r] < bi)); bv = take ? cv[r] : bv; bi = take ? ci[r] : bi; }
        tv[pass] = bv; ti[pass] = bi; }
    float mv[6]; int mi[6];
#pragma unroll
    for (int k = 0; k < 3; ++k) { mv[k] = tv[k]; mi[k] = ti[k]; mv[3 + k] = __shfl_xor(tv[k], 32); mi[3 + k] = __shfl_xor(ti[k], 32); }
    int fi[3];
#pragma unroll
    for (int pass = 0; pass < 3; ++pass) { float bv = -INFINITY; int bi = 1000;
#pragma unroll
        for (int r = 0; r < 6; ++r) { const bool excl = (pass > 0 && mi[r] == fi[0]) || (pass > 1 && mi[r] == fi[1]);
            const bool take = !excl && ((mv[r] > bv) || (mv[r] == bv && mi[r] < bi)); bv = take ? mv[r] : bv; bi = take ? mi[r] : bi; }
        fi[pass] = bi; }
    const int i1 = fi[0], i2 = fi[1], i3 = fi[2];
    const int nv = qb < 3 ? qb : 3;
    const int js[3] = {i1, i2, i3};
    if (hi == 0) {
#pragma unroll
        for (int s = 0; s < 3; ++s) if (s < nv) __hip_atomic_fetch_add(&cnt[js[s]], 1, __ATOMIC_RELAXED, __HIP_MEMORY_SCOPE_WORKGROUP);
    }
    __syncthreads();
    if (F.wave == 0) {
        const int c = cnt[F.lane]; int incl = c;
#pragma unroll
        for (int o = 1; o < 64; o <<= 1) { const int t = __shfl_up(incl, o); if (F.lane >= o) incl += t; }
        offs[F.lane + 1] = incl; cursor[F.lane] = incl - c; if (F.lane == 0) offs[0] = 0;
        OFFS[F.lane + 1] = (unsigned short)incl; if (F.lane == 0) OFFS[0] = 0;
        if (F.lane < qb && c > 0 && !F.probe) atomicAdd(&NTOT[F.lane], (unsigned)c);
    }
    __syncthreads();
    if (hi == 0) {
#pragma unroll
        for (int s = 0; s < 3; ++s) if (s < nv) { const int idx = __hip_atomic_fetch_add(&cursor[js[s]], 1, __ATOMIC_RELAXED, __HIP_MEMORY_SCOPE_WORKGROUP); ent[idx] = (unsigned short)(ql | (s << 8)); }
    }
    __syncthreads();
    const int tot = offs[64];
    for (int i = F.tid; i < tot; i += 512) ENT[i] = ent[i];
    __syncthreads();
}

constexpr int P8_MAXSTEPS = 18;
__device__ __forceinline__ void gathered_attention(Frame& F) {
    LAS int* PFX = (LAS int*)(F.lds + ATT_AUX); LAS int* NT = PFX + 1024; LAS int* wtot = NT + 1024;
    LAS int* cumI = wtot + 16; LAS int* segoff = cumI + 64; LAS int* ctr = segoff + 64; LAS int* qinfo = (LAS int*)(F.lds + ATT_AUX + 9216);
    const unsigned* NTOT = (const unsigned*)(F.ws + WS_CTL) + CW_NTOT;
    const bf16* QB = (const bf16*)(F.ws + WS_S0);
    unsigned char* PART = F.ws + WS_S3; float* LSE = (float*)(F.ws + WS_LSE);
    {
        const int n0 = (int)NTOT[2 * F.tid], n1 = (int)NTOT[2 * F.tid + 1]; const int e0 = (n0 + 255) >> 8, e1 = (n1 + 255) >> 8;
        NT[2 * F.tid] = n0; NT[2 * F.tid + 1] = n1;
        int incl = e0 + e1;
#pragma unroll
        for (int o = 1; o < 64; o <<= 1) { const int t = __shfl_up(incl, o); if (F.lane >= o) incl += t; }
        if (F.lane == 63) wtot[F.wave] = incl;
        __syncthreads();
        int off = 0;
#pragma unroll
        for (int w = 0; w < 8; ++w) off += (w < F.wave) ? wtot[w] : 0;
        PFX[2 * F.tid + 1] = off + incl; PFX[2 * F.tid] = off + incl - e1;
        __syncthreads();
    }
    const int S_tot = PFX[1023];
    const int s_lo = (int)(((long)F.vcu * S_tot) / F.G), s_hi = (int)(((long)(F.vcu + 1) * S_tot) / F.G);
    const int r32 = F.lane & 31, hi = F.lane >> 5;
    const int vbase = (int)(uintptr_t)(F.lds + VIMG) + v_rd_base(F.lane);
    int s = s_lo;
    while (s < s_hi) {
        int lo = 0, hi_ = 1023;
        while (lo < hi_) { const int mid = (lo + hi_) >> 1; if (PFX[mid] > s) hi_ = mid; else lo = mid + 1; }
        const int u = lo; const int base = u ? PFX[u - 1] : 0; const int n = NT[u];
        const int k_lo = s - base; int nsteps = PFX[u] - s; if (nsteps > s_hi - s) nsteps = s_hi - s; if (nsteps > P8_MAXSTEPS) nsteps = P8_MAXSTEPS;
        const int ub = u >> 9, uh = (u >> 6) & 7, uj = u & 63;
        __syncthreads();
        load_kv_block(F, ub, uh, uj);
        if (F.wave == 0) {
            const int qb = F.lane; int o0 = 0, o1 = 0;
            if (qb > uj) { const unsigned short* OF = (const unsigned short*)(F.ws + WS_OFFS) + (size_t)((ub * NH + uh) * NBLK + qb) * OFFS_PITCH; o0 = OF[uj]; o1 = OF[uj + 1]; }
            int incl = o1 - o0;
#pragma unroll
            for (int o = 1; o < 64; o <<= 1) { const int t = __shfl_up(incl, o); if (F.lane >= o) incl += t; }
            cumI[qb] = incl; segoff[qb] = o0; if (F.lane == 0) ctr[0] = 0;
        }
        __syncthreads();
        int e_end = 256 * (k_lo + nsteps); if (e_end > n) e_end = n;
        const int nent = e_end - 256 * k_lo;
        for (int i = F.tid; i < nsteps * 256; i += 512) {
            int info = -1;
            if (i < nent) { const int e = 256 * k_lo + i;
                int a = 0, c = 63;
                while (a < c) { const int mid = (a + c) >> 1; if (cumI[mid] > e) c = mid; else a = mid + 1; }
                const int qb = a; const int idx = e - (qb ? cumI[qb - 1] : 0);
                const unsigned short en = ((const unsigned short*)(F.ws + WS_ENT))[(size_t)((ub * NH + uh) * NBLK + qb) * 768 + segoff[qb] + idx];
                info = (qb * BLK + (en & 255)) | ((en >> 8) << 16); }
            qinfo[i] = info;
        }
        __syncthreads();
        const int ntiles = (nent + 31) >> 5;
#define P8_GRAB(T) do { int _t = 0; if (F.lane == 0) _t = __hip_atomic_fetch_add(ctr, 1, __ATOMIC_RELAXED, __HIP_MEMORY_SCOPE_WORKGROUP); T = __builtin_amdgcn_readfirstlane(_t); } while (0)
#define P8_LOADQ(QR, INFO, T) do { INFO = qinfo[32 * (T) + r32]; const int _pos = INFO >= 0 ? (INFO & 0xffff) : 0; const bf16* _qp = QB + ((size_t)ub * SEQ + _pos) * DM + uh * 128 + hi * 8; \
        _Pragma("unroll") for (int d0 = 0; d0 < 8; ++d0) QR[d0] = *(const bf16x8*)(_qp + d0 * 16); } while (0)
#define P8_COMPUTE(QR, INFO) do { const bool _valid = INFO >= 0; const int _pos = _valid ? (INFO & 0xffff) : 0, _slot = _valid ? (INFO >> 16) : 0; const size_t _tok = (size_t)ub * SEQ + _pos; \
        f32x16 o[4] = {}; float m = -1e30f, l = 0.f; \
        _Pragma("unroll 1") for (int t = 0; t < 4; ++t) attn_subtile(o, m, l, F.lds + KIMG + t * 16384, vbase + t * 16384, QR, r32, hi, false, 0, 0); \
        const float _il = __builtin_amdgcn_rcpf(l); \
        row_store_T(PART + ((_tok * NH + uh) * 3 + _slot) * 256, o, _il, hi, _valid); \
        if (_valid && hi == 0) LSE[(_tok * NH + uh) * 4 + _slot] = m + __builtin_amdgcn_logf(l); } while (0)
        bf16x8 qa[8], qb_[8]; int ia = -1, ib = -1; int ta, tb;
        P8_GRAB(ta);
        if (ta < ntiles) P8_LOADQ(qa, ia, ta);
        while (ta < ntiles) {
            P8_GRAB(tb); if (tb < ntiles) P8_LOADQ(qb_, ib, tb);
            P8_COMPUTE(qa, ia);
            if (tb >= ntiles) break;
            P8_GRAB(ta); if (ta < ntiles) P8_LOADQ(qa, ia, ta);
            P8_COMPUTE(qb_, ib);
        }
#undef P8_GRAB
#undef P8_LOADQ
#undef P8_COMPUTE
        s += nsteps;
    }
    __syncthreads();
}

__device__ __forceinline__ void own_unit(Frame& F, int b, int h, int qb) {
    bf16* QB = (bf16*)(F.ws + WS_S0); const bf16* SG2 = (const bf16*)(F.ws + WS_S6);
    const unsigned char* PART = F.ws + WS_S3; const float* LSE = (const float*)(F.ws + WS_LSE);
    load_kv_block(F, b, h, qb);
    __syncthreads();
    const int r32 = F.lane & 31, hi = F.lane >> 5, w = F.wave, ql = 32 * w + r32;
    const int vbase = (int)(uintptr_t)(F.lds + VIMG) + v_rd_base(F.lane);
    const size_t tok = (size_t)b * SEQ + qb * BLK + ql;
    bf16x8 qr[8];
#pragma unroll
    for (int d0 = 0; d0 < 8; ++d0) qr[d0] = *(const bf16x8*)(QB + tok * DM + h * 128 + d0 * 16 + hi * 8);
    f32x16 o[4] = {}; float m = -1e30f, l = 0.f;
    const int tdiag = w >> 1;
#pragma unroll 1
    for (int t = 0; t <= tdiag; ++t) attn_subtile(o, m, l, F.lds + KIMG + t * 16384, vbase + t * 16384, qr, r32, hi, t == tdiag, 64 * t, ql);
    const int nv = qb < 3 ? qb : 3;
    float L[3]; float Mx = m;
#pragma unroll
    for (int s = 0; s < 3; ++s) { L[s] = (s < nv) ? LSE[(tok * NH + h) * 4 + s] : -1e30f; Mx = fmaxf(Mx, L[s]); }
    const float wo = fast_exp2(m - Mx); float den = l * wo;
#pragma unroll
    for (int d = 0; d < 4; ++d)
#pragma unroll
        for (int r = 0; r < 16; ++r) o[d][r] *= wo;
#pragma unroll 1
    for (int s = 0; s < nv; ++s) {
        const float ws_ = fast_exp2(L[s] - Mx); den += ws_;
        f32x16 pv[4]; row_load_T(PART + ((tok * NH + h) * 3 + s) * 256, pv, hi);
#pragma unroll
        for (int d = 0; d < 4; ++d)
#pragma unroll
            for (int r = 0; r < 16; ++r) o[d][r] += ws_ * pv[d][r];
    }
    const float iden = __builtin_amdgcn_rcpf(den);
    { f32x16 gv[4]; row_load_T((const unsigned char*)(SG2 + tok * DM + h * 128), gv, hi);
#pragma unroll
      for (int d = 0; d < 4; ++d)
#pragma unroll
          for (int r = 0; r < 16; ++r) o[d][r] *= gv[d][r]; }
    row_store_T(F.probe ? (F.ws + 48 * MiB + (((tok * DM + h * 128) * 2) & (8 * MiB - 1))) : (unsigned char*)(QB + tok * DM + h * 128), o, iden, hi, true);
    __syncthreads();
}

constexpr int N_PHASES = 11;
__global__ void __launch_bounds__(512, 2) hawk_moba_fwd(Args args) {
    extern __shared__ __attribute__((aligned(16))) unsigned char lds_raw[];
    Frame F;
    F.lds = (LAS unsigned char*)lds_raw;
    F.tid = threadIdx.x; F.lane = F.tid & 63; F.wave = __builtin_amdgcn_readfirstlane(F.tid >> 6);
    F.G = gridDim.x; { const int bx = blockIdx.x; F.vcu = (F.G % 8 == 0) ? (bx % 8) * (F.G / 8) + bx / 8 : bx; }
    F.out = args.out; F.ws = args.ws; F.probe = false;
    volatile LAS unsigned* MISC = (volatile LAS unsigned*)(F.lds + MISC_OFF);
    if (F.tid < 64) MISC[F.tid] = 0u;
    __syncthreads();
    unsigned* ctl = (unsigned*)(F.ws + WS_CTL);
    XcdBarrier bar; bar.bar = ctl + CW_BAR; bar.x = 0; bar.st = nullptr;
    const int lo = args.ph_lo, hi = args.ph_hi;
    if (hi - lo > 1) bar = xcd_barrier_post(ctl + CW_BAR, MISC + 8);
#define IN(k) (lo <= (k) && (k) < hi)
#define SEAM(k) do { if (IN(k) && IN((k) + 1)) xcd_barrier(bar); } while (0)

#define RUN_GEMM(MODE, AOFF, BOFF, NN) do { \
        pg8::Gemm g{(const pg8::bf16_t*)(F.ws + (AOFF)), (const pg8::bf16_t*)(F.ws + (BOFF)), T, (NN), DM}; \
        pg8::EpiAll E{(MODE), F.ws, F.out, F.probe, (LAS float*)(F.lds + pg8::STAGE_BYTES)}; pg8::StaticOrder S; S.init(T, (NN), F.G, (int)blockIdx.x); \
        pg8::gemm_phase<pg8::EpiAll, pg8::StaticOrder, true, true>(F.lds, g, S, E); } while (0)
    if (IN(0)) { for (int rep = 0; rep < (MK_REPEAT == 0 ? 2 : 1); ++rep) { if (rep) xcd_barrier(bar); p0_prologue(F); } } SEAM(0);
    if (IN(1)) { RUN_GEMM(0, WS_S0, WS_WAIN, 2048); } SEAM(1);
#if MK_REPEAT == 1
    if (IN(1)) { RUN_GEMM(0, WS_S0, WS_WAIN, 2048); } SEAM(1);
#endif
    if (IN(2)) { for (int rep = 0; rep < (MK_REPEAT == 2 ? 2 : 1); ++rep) { if (rep) xcd_barrier(bar); for (int u = F.vcu; u < 1024; u += F.G) scan_unit(F, false, u >> 9, (u >> 3) & 63, u & 7); } } SEAM(2);
    if (IN(3)) { for (int rep = 0; rep < (MK_REPEAT == 3 ? 2 : 1); ++rep) { if (rep) xcd_barrier(bar); for (int u = F.vcu; u < 1024; u += F.G) scan_unit(F, true, u >> 9, (u >> 3) & 63, u & 7); } } SEAM(3);
    if (IN(4)) { RUN_GEMM(1, WS_S0, WS_WAOUT, DM); } SEAM(4);
#if MK_REPEAT == 4
    if (IN(4)) { RUN_GEMM(1, WS_S0, WS_WAOUT, DM); } SEAM(4);
#endif
    if (IN(5)) { RUN_GEMM(2, WS_S3, WS_WB1, 4096); } SEAM(5);
#if MK_REPEAT == 5
    if (IN(5)) { RUN_GEMM(2, WS_S3, WS_WB1, 4096); } SEAM(5);
#endif
    if (IN(7)) { for (int rep = 0; rep < (MK_REPEAT == 7 ? 2 : 1); ++rep) { if (rep) xcd_barrier(bar); F.probe = (MK_REPEAT == 7 && rep == 0); for (int u = F.vcu; u < 1024; u += F.G) { const int qb = u & 63; if (qb > 0) select_unit(F, u >> 9, (u >> 6) & 7, qb); } } } SEAM(7);
    if (IN(8)) { for (int rep = 0; rep < (MK_REPEAT == 8 ? 2 : 1); ++rep) { if (rep) xcd_barrier(bar); gathered_attention(F); } } SEAM(8);
    if (IN(9)) { for (int rep = 0; rep < (MK_REPEAT == 9 ? 2 : 1); ++rep) { if (rep) xcd_barrier(bar); F.probe = (MK_REPEAT == 9 && rep == 0); for (int u = F.vcu; u < 1024; u += F.G) own_unit(F, u >> 9, (u >> 6) & 7, u & 63); } } SEAM(9);
#if MK_REPEAT == 20
    if (hi - lo > 1) { for (int i = 0; i < 10; ++i) xcd_barrier(bar); }
#endif
#if MK_REPEAT == 10
    if (IN(10)) { F.probe = true; RUN_GEMM(3, WS_S0, WS_WBOUT, DM); F.probe = false; xcd_barrier(bar); }
#endif
    if (IN(10)) { RUN_GEMM(3, WS_S0, WS_WBOUT, DM); }
#undef RUN_GEMM
#undef IN
#undef SEAM
}

extern "C" void kernel_launch(void* const* d_in, const int* in_sizes, int n_in, void* d_out, int out_size, void* d_ws, size_t ws_size, hipStream_t stream) {
    static int grid = 0;
    if (grid == 0) {
        if (n_in != 18 || in_sizes[0] != T * DM || out_size != T * DM || ws_size < WS_END) { fprintf(stderr, "kernel_launch: unexpected shapes (n_in %d, in0 %d, out %d, ws %zu < %zu)\n", n_in, n_in > 0 ? in_sizes[0] : -1, out_size, ws_size, (size_t)WS_END); grid = -1; return; }
        int dev = 0, cus = 0, per_cu = 0;
        if (hipGetDevice(&dev) != hipSuccess || hipDeviceGetAttribute(&cus, hipDeviceAttributeMultiprocessorCount, dev) != hipSuccess) { grid = -1; return; }
        if (hipFuncSetAttribute((const void*)hawk_moba_fwd, hipFuncAttributeMaxDynamicSharedMemorySize, LDS_BYTES) != hipSuccess) { fprintf(stderr, "kernel_launch: hipFuncSetAttribute failed\n"); grid = -1; return; }
        if (hipOccupancyMaxActiveBlocksPerMultiprocessor(&per_cu, (const void*)hawk_moba_fwd, 512, LDS_BYTES) != hipSuccess || per_cu < 1) { fprintf(stderr, "kernel_launch: occupancy query says %d blocks per CU\n", per_cu); (void)hipGetLastError(); grid = -1; return; }
        grid = cus;
    }
    if (grid < 0) return;
    (void)hipMemsetAsync((char*)d_ws + WS_CTL, 0, CTL_ZERO_BYTES, stream);
    Args a{};
    for (int i = 0; i < 18; ++i) a.in[i] = (const float*)d_in[i];
    a.out = (float*)d_out; a.ws = (unsigned char*)d_ws;
#if MK_N_LAUNCHES == 1
    a.ph_lo = 0; a.ph_hi = N_PHASES;
    hipLaunchKernelGGL(hawk_moba_fwd, dim3(grid), dim3(512), LDS_BYTES, stream, a);
#else
    for (int p = 0; p <= MK_LAST_PHASE; ++p) { a.ph_lo = p; a.ph_hi = p + 1; hipLaunchKernelGGL(hawk_moba_fwd, dim3(grid), dim3(512), LDS_BYTES, stream, a); }
#endif
}
```

```cpp
#include <hip/hip_runtime.h>
#include <cstdio>
#include <cstdint>

#ifndef MK_N_LAUNCHES
#define MK_N_LAUNCHES 1
#endif
#ifndef MK_PHMASK
#define MK_PHMASK 0x7ff
#endif
#ifndef MK_REPEAT
#define MK_REPEAT (-1)
#endif
#ifndef MK_STAMP
#define MK_STAMP 0
#endif
#ifndef MK_STAGGER
#define MK_STAGGER 0
#endif
#ifndef MK_LAST_PHASE
#define MK_LAST_PHASE 10
#endif

namespace pg8 {
#define PG8_LAS __attribute__((address_space(3)))
typedef unsigned short bf16_t;
typedef short bf16x8 __attribute__((ext_vector_type(8)));
typedef float f32x4 __attribute__((ext_vector_type(4)));
typedef unsigned u32x4 __attribute__((ext_vector_type(4)));
typedef unsigned u32x2 __attribute__((ext_vector_type(2)));
constexpr int BM = 256, BK = 64, HALF = 128, HTB = HALF * BK * 2, STAGE_BYTES = 8 * HTB, NXCD = 8, WGM = 8;

__host__ __device__ __forceinline__ int lds_byte(int r, int c) { const int st = (r >> 4) * 2 + (c >> 5), rr = r & 15, cc = c & 31, ob = rr * 64 + cc * 2; return st * 1024 + (ob ^ (((ob >> 9) & 1) << 5)); }
__host__ __device__ __forceinline__ void stage_rc(int b, int& R, int& C) { const int st = b / 1024, sb = b % 1024, swz = sb ^ (((sb >> 9) & 1) << 5); R = (st >> 1) * 16 + swz / 64; C = (st & 1) * 32 + (swz % 64) / 2; }
__host__ __device__ __forceinline__ int perm32(int rho) { const int n = rho >> 4, i = rho & 15; return 8 * (i >> 2) + 4 * n + (i & 3); }

struct Unit { int pm, pn; };
struct Gemm { const bf16_t* A; const bf16_t* Bt; int M, N, K; };

struct StaticOrder {
    int nM, nN, nwg, G, c;
    __host__ __device__ void init(int M, int N, int G_, int c_) { nM = M / BM; nN = N / BM; nwg = nM * nN; G = G_; c = c_; }
    __host__ __device__ __forceinline__ bool next(int i, Unit& u) const {
        const long L = (long)i * G + c; if (L >= nwg) return false;
        int wgid = (int)L; { const int q = nwg / NXCD, r = nwg % NXCD, xcd = wgid % NXCD, off = wgid / NXCD; wgid = (xcd < r ? xcd * (q + 1) : r * (q + 1) + (xcd - r) * q) + off; }
        const int nig = WGM * nN, gid = wgid / nig, fm = gid * WGM, gsz = (nM - fm) < WGM ? (nM - fm) : WGM;
        u.pm = fm + ((wgid % nig) % gsz); u.pn = (wgid % nig) / gsz; return true;
    }
    __device__ __forceinline__ void a_ready(const Unit&) const {}
    __device__ __forceinline__ void done(const Unit&) const {}
};

__device__ __forceinline__ unsigned cvt_pk_bf16(float lo, float hi) { unsigned r; asm volatile("v_cvt_pk_bf16_f32 %0, %1, %2" : "=v"(r) : "v"(lo), "v"(hi)); return r; }

template <class Epi, class Sched, bool ALIGN_EPI = false, bool SP2 = false>
__device__ __forceinline__ void gemm_phase(PG8_LAS unsigned char* lds, const Gemm g, const Sched& S, const Epi& E, unsigned long long& tacc) {
    const int tid = threadIdx.x, wid = __builtin_amdgcn_readfirstlane(tid >> 6), lane = tid & 63, wr = wid >> 2, wc = wid & 3, fr = lane & 15, fq = lane >> 4;
    const int K = g.K, nt = K / BK;
    unsigned voffA[2], voffB[2];
#pragma unroll
    for (int i = 0; i < 2; ++i) { int R, C; stage_rc(tid * 16 + i * 8192, R, C); const int Rb = Epi::PERM ? ((R & ~31) + perm32(R & 31)) : R;
        voffA[i] = (unsigned)(R * K + C) * 2u; voffB[i] = (unsigned)(Rb * K + C) * 2u; }
    const size_t kstep = (size_t)(BK * 2);
    const size_t hstep = (size_t)HALF * K * 2;
    const size_t tstep = 2 * hstep;
    const unsigned ldsw = (unsigned)wid * 1024u;
    const int aoff = lds_byte(wr * 64 + fr, fq * 8), boff = lds_byte(wc * 32 + fr, fq * 8);
#define PG8_SA(b, h) (((b) * 2 + (h)) * HTB)
#define PG8_SB(b, h) ((4 + (b) * 2 + (h)) * HTB)
#define PG8_STAGE(bufoff, gbase, voff) do { _Pragma("unroll") for (int _i = 0; _i < 2; ++_i) \
        __builtin_amdgcn_global_load_lds((const unsigned*)((const char*)(gbase) + (voff)[_i]), (PG8_LAS unsigned*)(lds + (bufoff) + ldsw + _i * 8192), 16, 0, 0); } while (0)
#define PG8_LDA(dst, b, h) do { _Pragma("unroll") for (int m = 0; m < 4; ++m) _Pragma("unroll") for (int k = 0; k < 2; ++k) dst[m][k] = *(const PG8_LAS bf16x8*)(lds + PG8_SA(b, h) + aoff + m * 2048 + k * 1024); } while (0)
#define PG8_LDB(dst, b, h) do { _Pragma("unroll") for (int n = 0; n < 2; ++n) _Pragma("unroll") for (int k = 0; k < 2; ++k) dst[n][k] = *(const PG8_LAS bf16x8*)(lds + PG8_SB(b, h) + boff + n * 2048 + k * 1024); } while (0)
#define PG8_MMA(ai, bj, At, Bt) do { __builtin_amdgcn_s_setprio(1); _Pragma("unroll") for (int m = 0; m < 4; ++m) _Pragma("unroll") for (int n = 0; n < 2; ++n) _Pragma("unroll") for (int k = 0; k < 2; ++k) \
        acc[ai][bj][m][n] = __builtin_amdgcn_mfma_f32_16x16x32_bf16(Bt[n][k], At[m][k], acc[ai][bj][m][n], 0, 0, 0); __builtin_amdgcn_s_setprio(0); } while (0)
#define PG8_WAIT_V(n) asm volatile("s_waitcnt vmcnt(" #n ")" ::: "memory")
#define PG8_WAIT_L(n) asm volatile("s_waitcnt lgkmcnt(" #n ")" ::: "memory")
#define PG8_BAR __builtin_amdgcn_s_barrier()
#define PG8_SCHED __builtin_amdgcn_sched_barrier(0)
    Unit cur, nxt; int ui = 0;
    if (!S.next(0, cur)) return;
    f32x4 acc[2][2][4][2];
#pragma unroll
    for (int a = 0; a < 2; ++a)
#pragma unroll
        for (int b = 0; b < 2; ++b)
#pragma unroll
            for (int m = 0; m < 4; ++m)
#pragma unroll
                for (int n = 0; n < 2; ++n) acc[a][b][m][n] = (f32x4){0.f, 0.f, 0.f, 0.f};
    bf16x8 At[4][2], B0[2][2], B1[2][2];
    const char* cA = (const char*)g.A + (size_t)cur.pm * tstep; const char* cB = (const char*)g.Bt + (size_t)cur.pn * tstep;
    S.a_ready(cur);
    if constexpr (SP2) {
        PG8_STAGE(PG8_SB(0, 0), cB, voffB); PG8_STAGE(PG8_SB(0, 1), cB + hstep, voffB); PG8_STAGE(PG8_SA(0, 0), cA, voffA); PG8_STAGE(PG8_SA(0, 1), cA + hstep, voffA);
        if (wr == 1) PG8_BAR;
        PG8_WAIT_V(2); PG8_BAR;
        PG8_STAGE(PG8_SB(1, 0), cB + kstep, voffB); PG8_STAGE(PG8_SA(1, 0), cA + kstep, voffA); PG8_STAGE(PG8_SB(1, 1), cB + hstep + kstep, voffB);
        PG8_WAIT_V(6); PG8_BAR;
    } else {
        PG8_STAGE(PG8_SB(0, 0), cB, voffB); PG8_STAGE(PG8_SA(0, 0), cA, voffA); PG8_STAGE(PG8_SB(0, 1), cB + hstep, voffB); PG8_STAGE(PG8_SA(0, 1), cA + hstep, voffA);
        if (wr == 1) PG8_BAR;
        PG8_WAIT_V(4); PG8_BAR;
        PG8_STAGE(PG8_SB(1, 0), cB + kstep, voffB); PG8_STAGE(PG8_SA(1, 0), cA + kstep, voffA); PG8_STAGE(PG8_SB(1, 1), cB + hstep + kstep, voffB);
        PG8_WAIT_V(6); PG8_BAR;
    }
    for (;;) {
        const bool has_next = S.next(ui + 1, nxt);
        const char* nA = has_next ? (const char*)g.A + (size_t)nxt.pm * tstep : cA; const char* nB = has_next ? (const char*)g.Bt + (size_t)nxt.pn * tstep : cB;
        for (int t = 0; t < nt; t += 2) {
            const bool last = (t == nt - 2);
            const char* a1 = cA + (size_t)(t + 1) * kstep;
            const char* a2 = last ? nA : cA + (size_t)(t + 2) * kstep; const char* b2 = last ? nB : cB + (size_t)(t + 2) * kstep;
            const char* a3 = a2 + kstep; const char* b3 = b2 + kstep;
            if (last && has_next) S.a_ready(nxt);
            if constexpr (SP2) {
            PG8_LDB(B0, 0, 0); PG8_LDB(B1, 0, 1); PG8_SCHED; PG8_LDA(At, 0, 0); PG8_STAGE(PG8_SA(1, 1), a1 + hstep, voffA);
            PG8_WAIT_V(8); PG8_WAIT_L(0); PG8_BAR; PG8_MMA(0, 0, At, B0); PG8_MMA(0, 1, At, B1); PG8_BAR; PG8_SCHED;
            PG8_LDA(At, 0, 1); PG8_STAGE(PG8_SB(0, 0), b2, voffB); PG8_STAGE(PG8_SB(0, 1), b2 + hstep, voffB); PG8_STAGE(PG8_SA(0, 0), a2, voffA);
            PG8_WAIT_V(8); PG8_WAIT_L(0); PG8_BAR; PG8_MMA(1, 0, At, B0); PG8_MMA(1, 1, At, B1); PG8_BAR; PG8_SCHED;
            PG8_LDB(B0, 1, 0); PG8_LDB(B1, 1, 1); PG8_SCHED; PG8_LDA(At, 1, 0); PG8_STAGE(PG8_SA(0, 1), a2 + hstep, voffA);
            PG8_WAIT_V(8); PG8_WAIT_L(0); PG8_BAR; PG8_MMA(0, 0, At, B0); PG8_MMA(0, 1, At, B1); PG8_BAR; PG8_SCHED;
            PG8_LDA(At, 1, 1); PG8_STAGE(PG8_SB(1, 0), b3, voffB); PG8_STAGE(PG8_SB(1, 1), b3 + hstep, voffB); PG8_STAGE(PG8_SA(1, 0), a3, voffA);
            PG8_WAIT_V(8); PG8_WAIT_L(0); PG8_BAR; PG8_MMA(1, 0, At, B0); PG8_MMA(1, 1, At, B1); PG8_BAR; PG8_SCHED;
            } else {
            PG8_LDB(B0, 0, 0); PG8_SCHED; PG8_LDA(At, 0, 0); PG8_STAGE(PG8_SA(1, 1), a1 + hstep, voffA);
            PG8_WAIT_L(8); PG8_BAR; PG8_WAIT_L(0); PG8_MMA(0, 0, At, B0); PG8_BAR; PG8_SCHED;
            PG8_LDB(B1, 0, 1); PG8_STAGE(PG8_SB(0, 0), b2, voffB);
            PG8_BAR; PG8_WAIT_L(0); PG8_MMA(0, 1, At, B1); PG8_BAR;
            PG8_LDA(At, 0, 1); PG8_STAGE(PG8_SA(0, 0), a2, voffA);
            PG8_BAR; PG8_WAIT_L(0); PG8_MMA(1, 0, At, B0); PG8_BAR; PG8_SCHED;
            PG8_STAGE(PG8_SB(0, 1), b2 + hstep, voffB);
            PG8_WAIT_V(6); PG8_BAR; PG8_MMA(1, 1, At, B1); PG8_BAR;
            PG8_LDB(B0, 1, 0); PG8_SCHED; PG8_LDA(At, 1, 0); PG8_STAGE(PG8_SA(0, 1), a2 + hstep, voffA);
            PG8_WAIT_L(8); PG8_BAR; PG8_WAIT_L(0); PG8_MMA(0, 0, At, B0); PG8_BAR; PG8_SCHED;
            PG8_LDB(B1, 1, 1); PG8_STAGE(PG8_SB(1, 0), b3, voffB);
            PG8_BAR; PG8_WAIT_L(0); PG8_MMA(0, 1, At, B1); PG8_BAR;
            PG8_LDA(At, 1, 1); PG8_STAGE(PG8_SA(1, 0), a3, voffA);
            PG8_BAR; PG8_WAIT_L(0); PG8_MMA(1, 0, At, B0); PG8_BAR; PG8_SCHED;
            PG8_STAGE(PG8_SB(1, 1), b3 + hstep, voffB);
            PG8_WAIT_V(6); PG8_BAR; PG8_MMA(1, 1, At, B1); PG8_BAR;
            }
        }
        unsigned long long _t0 = 0; if (MK_STAMP == 31) _t0 = __builtin_amdgcn_s_memrealtime();
        if constexpr (ALIGN_EPI) { if (wr == 0) PG8_BAR; }
        if (MK_STAMP == 31) tacc += __builtin_amdgcn_s_memrealtime() - _t0;
        if (MK_STAMP == 30 || MK_STAMP == 32) _t0 = __builtin_amdgcn_s_memrealtime();
        E(acc, cur, wr, wc, fr, fq, ui); S.done(cur);
        if (MK_STAMP == 30) { asm volatile("s_waitcnt vmcnt(0)" ::: "memory"); tacc += __builtin_amdgcn_s_memrealtime() - _t0; }
        if (MK_STAMP == 32) tacc += __builtin_amdgcn_s_memrealtime() - _t0;
        if (!has_next) break;
#pragma unroll
        for (int a = 0; a < 2; ++a)
#pragma unroll
            for (int b = 0; b < 2; ++b)
#pragma unroll
                for (int m = 0; m < 4; ++m)
#pragma unroll
                    for (int n = 0; n < 2; ++n) acc[a][b][m][n] = (f32x4){0.f, 0.f, 0.f, 0.f};
        cur = nxt; cA = nA; cB = nB; ++ui;
        if constexpr (ALIGN_EPI) { if (wr == 1) PG8_BAR; }
    }
    PG8_WAIT_V(0);
    if constexpr (!ALIGN_EPI) { if (wr == 0) PG8_BAR; }
    PG8_BAR;
#undef PG8_SA
#undef PG8_SB
#undef PG8_STAGE
#undef PG8_LDA
#undef PG8_LDB
#undef PG8_MMA
#undef PG8_WAIT_V
#undef PG8_WAIT_L
#undef PG8_BAR
#undef PG8_SCHED
}
}

constexpr int NBATCH = 2, SEQ = 16384, T = NBATCH * SEQ, DM = 1024, NH = 8, HD = 128, NBLK = 64, BLK = 256;
constexpr float EPS = 1e-6f;
constexpr float QSCALE = 0.088388347648318440f * 1.4426950408889634f;

constexpr size_t MiB = 1u << 20;
constexpr size_t WS_CTL = 0, CTL_ZERO_BYTES = 1 * MiB;
constexpr size_t WS_WAIN = 2 * MiB, WS_WAOUT = 6 * MiB, WS_WB1 = 8 * MiB, WS_WBOUT = 16 * MiB, WS_WRG = 18 * MiB;
constexpr size_t WS_RS0 = 19 * MiB;
constexpr size_t WS_SSQ1 = 20 * MiB;
constexpr size_t WS_ROPE = 22 * MiB;
constexpr size_t WS_SUMA = 30 * MiB, WS_SUMB = 30 * MiB + 512 * 1024;
constexpr size_t WS_KMEAN = 31 * MiB;
constexpr size_t WS_ENT = 32 * MiB;
constexpr size_t WS_OFFS = 34 * MiB;
constexpr size_t WS_LSE = 36 * MiB;
constexpr size_t WS_SEGA = 44 * MiB, WS_SEGB = 46 * MiB;
constexpr size_t SLOT = 64 * MiB;
constexpr size_t WS_S0 = 1 * SLOT;
constexpr size_t WS_S1 = 2 * SLOT;
constexpr size_t WS_S2 = 3 * SLOT;
constexpr size_t WS_S3 = 4 * SLOT;
constexpr size_t WS_S6 = 7 * SLOT;
constexpr size_t WS_END = 8 * SLOT;
constexpr int OFFS_PITCH = 72;
constexpr int CW_BAR = 4096;
constexpr int CW_NTOT = 16384;

constexpr int LDS_BYTES = 163840;
constexpr int MISC_OFF = LDS_BYTES - 256;

#define GAS __attribute__((address_space(1)))
#define LAS __attribute__((address_space(3)))
typedef unsigned short bf16;
typedef unsigned v4u __attribute__((ext_vector_type(4)));
typedef unsigned v2u __attribute__((ext_vector_type(2)));
typedef float f32x4 __attribute__((ext_vector_type(4)));
typedef float f32x16 __attribute__((ext_vector_type(16)));
typedef short bf16x8 __attribute__((ext_vector_type(8)));
typedef short s16x4 __attribute__((ext_vector_type(4)));
#define LDS_WAIT() asm volatile("s_waitcnt lgkmcnt(0)" ::: "memory")
#define VM_WAIT() asm volatile("s_waitcnt vmcnt(0)" ::: "memory")
#define SBAR() __builtin_amdgcn_sched_barrier(0)

__device__ __forceinline__ unsigned f2bf(float f) { unsigned u = __builtin_bit_cast(unsigned, f); return (u + 0x7fffu + ((u >> 16) & 1u)) >> 16; }
__device__ __forceinline__ unsigned pk2(float lo, float hi) { return pg8::cvt_pk_bf16(lo, hi); }
__device__ __forceinline__ float bflo(unsigned w) { return __builtin_bit_cast(float, w << 16); }
__device__ __forceinline__ float bfhi(unsigned w) { return __builtin_bit_cast(float, w & 0xffff0000u); }
__device__ __forceinline__ float bf1(unsigned short h) { return __builtin_bit_cast(float, ((unsigned)h) << 16); }
__device__ __forceinline__ float fast_exp2(float x) { return __builtin_amdgcn_exp2f(x); }
__device__ __forceinline__ float sigmoidf_(float v) { return __builtin_amdgcn_rcpf(1.f + fast_exp2(-v * 1.4426950408889634f)); }
__device__ __forceinline__ float siluf_(float v) { return v * sigmoidf_(v); }

#define XB_TMO      128
#define XB_XCNT(j)  (256  + 64 * (j))
#define XB_XSUB(j)  (1280 + 64 * (j))
#define XB_XGEN(j)  (2304 + 64 * (j))
#define XB_TOP      3328
#define XB_TOPGEN   3392
#define XCD_BAR_WORDS 3456
#define XB_SPIN_CAP (1u << 20)
__device__ __forceinline__ unsigned xb_ld(unsigned* p)              { return __hip_atomic_load(p, __ATOMIC_RELAXED, __HIP_MEMORY_SCOPE_AGENT); }
__device__ __forceinline__ unsigned xb_add(unsigned* p, unsigned v) { return __hip_atomic_fetch_add(p, v, __ATOMIC_RELAXED, __HIP_MEMORY_SCOPE_AGENT); }
__device__ __forceinline__ unsigned xb_xcc_id() { return (unsigned)__builtin_amdgcn_s_getreg((3 << 11) | 20) & 0xFu; }
#define XB_SPIN(cond, bar) do { unsigned _sp = 0; while (cond) { __builtin_amdgcn_s_sleep(1); \
    if ((++_sp & 255u) == 0u) { if (xb_ld(&(bar)[XB_TMO])) break; if (_sp > XB_SPIN_CAP) { atomicAdd(&(bar)[XB_TMO], 1u); break; } } } } while (0)
struct XcdBarrier { unsigned* bar; unsigned x; volatile LAS unsigned* st; };
__device__ __forceinline__ XcdBarrier xcd_barrier_post(unsigned* bar, volatile LAS unsigned* st) {
    XcdBarrier b; b.bar = bar; b.x = xb_xcc_id(); b.st = st;
    if (threadIdx.x == 0) (void)xb_add(&bar[XB_XCNT(b.x)], 1u);
    return b;
}
__device__ __forceinline__ void xcd_barrier_complete(unsigned* bar, unsigned x, unsigned& nloc, unsigned& nx) {
    const unsigned G = gridDim.x * gridDim.y * gridDim.z;
    unsigned sum, cnt, mine, sp = 0u;
    for (;;) {
        sum = 0u; cnt = 0u; mine = 0u;
#pragma unroll
        for (unsigned j = 0; j < 16; ++j) { const unsigned c = xb_ld(&bar[XB_XCNT(j)]); sum += c; cnt += (c > 0u) ? 1u : 0u; mine = (j == x) ? c : mine; }
        if (sum == G) break;
        __builtin_amdgcn_s_sleep(1);
        if ((++sp & 255u) == 0u) { if (xb_ld(&bar[XB_TMO])) break; if (sp > XB_SPIN_CAP) { atomicAdd(&bar[XB_TMO], 1u); break; } }
    }
    nloc = mine > 0u ? mine : 1u; nx = cnt > 0u ? cnt : 1u;
}
__device__ __forceinline__ void xcd_barrier(const XcdBarrier& b) {
    asm volatile("s_waitcnt vmcnt(0)" ::: "memory");
    __syncthreads();
    if (threadIdx.x == 0) {
        unsigned* bar = b.bar;
        __builtin_amdgcn_s_waitcnt(0);
        unsigned nloc = b.st[0], nx = b.st[1];
        if (nloc == 0u) { xcd_barrier_complete(bar, b.x, nloc, nx); b.st[0] = nloc; b.st[1] = nx; }
        const unsigned old = xb_add(&bar[XB_XSUB(b.x)], 1u);
        const unsigned gen = old / nloc;
        if (old + 1u == (gen + 1u) * nloc) {
            __builtin_amdgcn_fence(__ATOMIC_RELEASE, "agent");
            asm volatile("s_waitcnt vmcnt(0)" ::: "memory");
            const unsigned og = xb_add(&bar[XB_TOP], 1u);
            const unsigned tg = og / nx;
            if (og + 1u == (tg + 1u) * nx) xb_add(&bar[XB_TOPGEN], 1u);
            else XB_SPIN(xb_ld(&bar[XB_TOPGEN]) == tg, bar);
            __builtin_amdgcn_fence(__ATOMIC_ACQUIRE, "agent");
            xb_add(&bar[XB_XGEN(b.x)], 1u);
            asm volatile("s_waitcnt vmcnt(0)" ::: "memory");
        } else {
            XB_SPIN(xb_ld(&bar[XB_XGEN(b.x)]) == gen, bar);
            __builtin_amdgcn_fence(__ATOMIC_ACQUIRE, "agent");
            asm volatile("s_waitcnt vmcnt(0)" ::: "memory");
        }
    }
    __syncthreads();
}

struct Args { const float* in[18]; float* out; unsigned char* ws; int ph_lo, ph_hi; };
__device__ __forceinline__ const float* inp(int k) {
    const __attribute__((address_space(4))) Args* ap = (const __attribute__((address_space(4))) Args*)__builtin_amdgcn_kernarg_segment_ptr();
    asm volatile("" : "+s"(ap));
    return ap->in[k];
}
struct Frame {
    LAS unsigned char* lds;
    int tid, lane, wave, vcu, G;
    unsigned long long tacc, t0;
    bool probe;
    float* out;
    unsigned char* ws;
};
#define TS_BEGIN(ID) do { if (MK_STAMP == (ID)) F.t0 = __builtin_amdgcn_s_memrealtime(); } while (0)
#define TS_END(ID) do { if (MK_STAMP == (ID)) F.tacc += __builtin_amdgcn_s_memrealtime() - F.t0; } while (0)
__device__ __forceinline__ float wave_sum(float v) {
#pragma unroll
    for (int o = 1; o < 64; o <<= 1) v += __shfl_xor(v, o);
    return v;
}

namespace pg8 {
struct EpiAll {
    static constexpr bool PERM = true, AFTER_DRAIN = false;
    int mode;
    unsigned char* ws;
    float* xout;
    bool probe;
    PG8_LAS float* ex;
    __device__ __forceinline__ void operator()(const f32x4 (&acc)[2][2][4][2], const Unit& u, int wr, int wc, int fr, int fq, int ui) const {
        const PG8_LAS float* const rst = ex + 2560 + ui * 256 + wr * 64 + fr;
        const int row0 = u.pm * BM + wr * 64 + fr;
        bf16_t* const o0 = (bf16_t*)(ws + (mode == 1 ? WS_S6 : WS_S1)); bf16_t* const o1 = (bf16_t*)(ws + WS_S2); bf16_t* const o2 = (bf16_t*)(ws + WS_S0); bf16_t* const o3 = (bf16_t*)xout;
        const float* const rs = (const float*)(ws + (mode == 0 ? WS_RS0 : WS_SSQ1)); float* const ssq = (float*)(ws + WS_SSQ1);
        if (mode == 2 && ((u.pn >> 2) == 0 || (u.pn >> 2) == 2)) {
            const bool isK = (u.pn >> 2) == 0;
            const float* G = isK ? inp(13) : inp(16); const float osc = isK ? 1.0f : QSCALE;
            const int i0 = 16 * wc + 4 * fq;
            const f32x4 glo = *(const f32x4*)(G + i0), ghi = *(const f32x4*)(G + 64 + i0);
            const float* RC = (const float*)(ws + WS_ROPE); const float* RSn = RC + (size_t)SEQ * 64;
            bf16_t* base = isK ? o0 : o2; const int col0 = (u.pn & 3) * BM + wc * 32 + 8 * fq;
            PG8_LAS float* SS = ex; PG8_LAS float* KM = ex + 2048;
            float rsv[8];
#pragma unroll
            for (int i = 0; i < 8; ++i) rsv[i] = rst[(i >> 2) * 128 + (i & 3) * 16];
#pragma unroll
            for (int ai = 0; ai < 2; ++ai)
#pragma unroll
                for (int m = 0; m < 4; ++m) { const float sc = rsv[ai * 4 + m];
#pragma unroll
                    for (int bj = 0; bj < 2; ++bj) { const f32x4 v0 = acc[ai][bj][m][0] * sc, v1 = acc[ai][bj][m][1] * sc;
                        float ss = ((v0[0] * v0[0] + v0[1] * v0[1]) + (v0[2] * v0[2] + v0[3] * v0[3])) + ((v1[0] * v1[0] + v1[1] * v1[1]) + (v1[2] * v1[2] + v1[3] * v1[3]));
                        ss += __shfl_xor(ss, 16); ss += __shfl_xor(ss, 32);
                        if (fq == 0) SS[((wr * 128 + ai * 64 + m * 16 + fr) * 2 + bj) * 4 + wc] = ss; } }
            asm volatile("s_waitcnt lgkmcnt(0)" ::: "memory"); __builtin_amdgcn_s_barrier(); asm volatile("" ::: "memory");
            float cs[2][8];
#pragma unroll
            for (int bj = 0; bj < 2; ++bj)
#pragma unroll
                for (int e = 0; e < 8; ++e) cs[bj][e] = 0.f;
#pragma unroll
            for (int ai = 0; ai < 2; ++ai) {
                f32x4 csv[4], snv[4];
#pragma unroll
                for (int i = 0; i < 4; ++i) { const int pos = (row0 + ai * HALF + i * 16) & (SEQ - 1); csv[i] = *(const f32x4*)(RC + (size_t)pos * 64 + i0); snv[i] = *(const f32x4*)(RSn + (size_t)pos * 64 + i0); }
#pragma unroll
                for (int m = 0; m < 4; ++m) { const int row = row0 + ai * HALF + m * 16;
                    const f32x4 cs4 = csv[m], sn4 = snv[m];
                    bf16_t* rowp = base + (size_t)row * DM + col0;
#pragma unroll
                    for (int bj = 0; bj < 2; ++bj) { const f32x4 pt = *(const PG8_LAS f32x4*)&SS[((wr * 128 + ai * 64 + m * 16 + fr) * 2 + bj) * 4];
                        const float tot = (pt[0] + pt[1]) + (pt[2] + pt[3]);
                        const float rinv = (1.0f / sqrtf(tot * (1.0f / HD) + EPS)) * rsv[ai * 4 + m];
                        f32x4 o1, o2;
#pragma unroll
                        for (int e = 0; e < 4; ++e) { const float x1 = acc[ai][bj][m][0][e] * rinv * glo[e], x2 = acc[ai][bj][m][1][e] * rinv * ghi[e];
                            o1[e] = (x1 * cs4[e] - x2 * sn4[e]) * osc; o2[e] = (x2 * cs4[e] + x1 * sn4[e]) * osc; cs[bj][e] += o1[e]; cs[bj][4 + e] += o2[e]; }
                        u32x4 w; w.x = cvt_pk_bf16(o1[0], o1[1]); w.y = cvt_pk_bf16(o1[2], o1[3]); w.z = cvt_pk_bf16(o2[0], o2[1]); w.w = cvt_pk_bf16(o2[2], o2[3]);
                        *(u32x4*)(rowp + bj * HALF) = w; } }
            }
            if (isK) {
#pragma unroll
                for (int bj = 0; bj < 2; ++bj)
#pragma unroll
                    for (int e = 0; e < 8; ++e) { float v = cs[bj][e]; v += __shfl_xor(v, 1); v += __shfl_xor(v, 2); v += __shfl_xor(v, 4); v += __shfl_xor(v, 8); cs[bj][e] = v; }
                if (fr == 0) {
#pragma unroll
                    for (int bj = 0; bj < 2; ++bj)
#pragma unroll
                        for (int e = 0; e < 8; ++e) KM[wr * 256 + bj * 128 + 32 * wc + 8 * fq + e] = cs[bj][e]; }
                asm volatile("s_waitcnt lgkmcnt(0)" ::: "memory"); __builtin_amdgcn_s_barrier(); asm volatile("" ::: "memory");
                if (wr == 0 && fr == 0) { float* KMEAN = (float*)(ws + WS_KMEAN);
#pragma unroll
                    for (int bj = 0; bj < 2; ++bj) { const int hh = (u.pn & 3) * 2 + bj; float* kp = KMEAN + ((size_t)((u.pm >> 6) * NH + hh) * NBLK + (u.pm & 63)) * HD + 32 * wc + 8 * fq;
                        const int c = bj * 128 + 32 * wc + 8 * fq;
#pragma unroll
                        for (int e = 0; e < 8; ++e) kp[e] = (KM[c + e] + KM[256 + c + e]) * (1.0f / BLK); } }
            }
        } else if (mode == 0 || mode == 2) {
            const int tt = u.pn >> 2; const bool act = (mode == 0) ? (tt == 1) : (tt == 3);
            bf16_t* base = tt == 0 ? o0 : (tt == 1 ? o1 : (tt == 2 ? o2 : o3)); const int col0 = (u.pn & 3) * BM + wc * 32 + 8 * fq;
            float sv[8];
#pragma unroll
            for (int i = 0; i < 8; ++i) sv[i] = rst[(i >> 2) * 128 + (i & 3) * 16];
#pragma unroll
            for (int ai = 0; ai < 2; ++ai)
#pragma unroll
                for (int m = 0; m < 4; ++m) { const int row = row0 + ai * HALF + m * 16; const float s = sv[ai * 4 + m];
                    bf16_t* rowp = base + (size_t)row * DM + col0;
#pragma unroll
                    for (int bj = 0; bj < 2; ++bj) { f32x4 v0 = acc[ai][bj][m][0] * s, v1 = acc[ai][bj][m][1] * s;
                        if (act) {
#pragma unroll
                            for (int j = 0; j < 4; ++j) { v0[j] = siluf_(v0[j]); v1[j] = siluf_(v1[j]); } }
                        u32x4 w; w.x = cvt_pk_bf16(v0[0], v0[1]); w.y = cvt_pk_bf16(v0[2], v0[3]); w.z = cvt_pk_bf16(v1[0], v1[1]); w.w = cvt_pk_bf16(v1[2], v1[3]);
                        *(u32x4*)(rowp + bj * HALF) = w; } }
        } else if (mode == 1) {
            const float* const xin = inp(0);
            const int col0 = u.pn * BM + wc * 32 + 8 * fq;
#pragma unroll
            for (int ai = 0; ai < 2; ++ai) {
                f32x4 xv[4][2][2];
#pragma unroll
                for (int m = 0; m < 4; ++m) { const size_t off = (size_t)(row0 + ai * HALF + m * 16) * DM + col0;
#pragma unroll
                    for (int bj = 0; bj < 2; ++bj) { xv[m][bj][0] = __builtin_nontemporal_load((const f32x4*)(xin + off + bj * HALF)); xv[m][bj][1] = __builtin_nontemporal_load((const f32x4*)(xin + off + bj * HALF + 4)); } }
#pragma unroll
                for (int m = 0; m < 4; ++m) { const int row = row0 + ai * HALF + m * 16; const size_t off = (size_t)row * DM + col0; float ss = 0.f;
#pragma unroll
                    for (int bj = 0; bj < 2; ++bj) { const f32x4 v0 = acc[ai][bj][m][0] + xv[m][bj][0], v1 = acc[ai][bj][m][1] + xv[m][bj][1];
                        ss += ((v0[0] * v0[0] + v0[1] * v0[1]) + (v0[2] * v0[2] + v0[3] * v0[3])) + ((v1[0] * v1[0] + v1[1] * v1[1]) + (v1[2] * v1[2] + v1[3] * v1[3]));
                        u32x4 w; w.x = cvt_pk_bf16(v0[0], v0[1]); w.y = cvt_pk_bf16(v0[2], v0[3]); w.z = cvt_pk_bf16(v1[0], v1[1]); w.w = cvt_pk_bf16(v1[2], v1[3]);
                        *(u32x4*)(o0 + off + bj * HALF) = w; }
                    ss += __shfl_xor(ss, 16); ss += __shfl_xor(ss, 32);
                    if (fq == 0) ssq[(size_t)row * 16 + u.pn * 4 + wc] = ss; }
            }
        } else {
            const int col0 = u.pn * BM + wc * 32 + 8 * fq;
            u32x4 xr[8][2];
#pragma unroll
            for (int i = 0; i < 8; ++i) { const size_t off = (size_t)(row0 + (i >> 2) * HALF + (i & 3) * 16) * DM + col0;
                xr[i][0] = __builtin_nontemporal_load((const u32x4*)((const bf16_t*)(ws + WS_S6) + off)); xr[i][1] = __builtin_nontemporal_load((const u32x4*)((const bf16_t*)(ws + WS_S6) + off + HALF)); }
#pragma unroll
            for (int ai = 0; ai < 2; ++ai)
#pragma unroll
                for (int m = 0; m < 4; ++m) { const size_t off = (size_t)(row0 + ai * HALF + m * 16) * DM + col0;
#pragma unroll
                    for (int bj = 0; bj < 2; ++bj) { float* p = xout + off + bj * HALF; const u32x4 x4 = xr[ai * 4 + m][bj];
                        const f32x4 xa = {__builtin_bit_cast(float, x4.x << 16), __builtin_bit_cast(float, x4.x & 0xffff0000u), __builtin_bit_cast(float, x4.y << 16), __builtin_bit_cast(float, x4.y & 0xffff0000u)};
                        const f32x4 xb = {__builtin_bit_cast(float, x4.z << 16), __builtin_bit_cast(float, x4.z & 0xffff0000u), __builtin_bit_cast(float, x4.w << 16), __builtin_bit_cast(float, x4.w & 0xffff0000u)};
                        const f32x4 v0 = acc[ai][bj][m][0] + xa, v1 = acc[ai][bj][m][1] + xb; const bool lower = (fr & 8) == 0;
                        const f32x4 snd = lower ? v1 : v0; f32x4 rcv;
#pragma unroll
                        for (int e = 0; e < 4; ++e) rcv[e] = __shfl_xor(snd[e], 8);
                        const f32x4 s1 = lower ? v0 : rcv, s2 = lower ? rcv : v1;
                        float* pr = xout + (size_t)(u.pm * BM + wr * 64 + ai * HALF + m * 16 + (fr & 7)) * DM + u.pn * BM + bj * HALF + wc * 32 + 8 * fq + (lower ? 0 : 4);
                        __builtin_nontemporal_store(s1, (f32x4*)pr); __builtin_nontemporal_store(s2, (f32x4*)(pr + 8 * DM)); (void)p; } }
        }
    }
};
}

__device__ __forceinline__ int fperm(int p) { return ((p >> 2) & 1) * 64 + (p >> 5) * 16 + ((p >> 3) & 3) * 4 + (p & 3); }
template <int MODE  >
__device__ __forceinline__ void p0_transpose_item(const float* W, int ldw, int Kd, bf16* WT, int drow0, const float* gain, LAS float* scr, int k0, int n0, int lane) {
    const int g = lane & 7, kr = lane >> 3;
    const int nn = n0 + 4 * g;
    const int sc = (MODE == 1 && nn < 1024) ? ((nn & ~127) + fperm(nn & 127)) : nn;
    f32x4 v[8];
#pragma unroll
    for (int i = 0; i < 8; ++i) v[i] = *(const f32x4*)(W + (size_t)(k0 + kr + 8 * i) * ldw + sc);
#pragma unroll
    for (int i = 0; i < 8; ++i) { const int kk = kr + 8 * i; const float gm = gain ? gain[k0 + kk] : 1.0f;
        scr[kk * 33 + 4 * g + 0] = v[i][0] * gm; scr[kk * 33 + 4 * g + 1] = v[i][1] * gm; scr[kk * 33 + 4 * g + 2] = v[i][2] * gm; scr[kk * 33 + 4 * g + 3] = v[i][3] * gm; }
    LDS_WAIT(); asm volatile("" ::: "memory");
    const int c = lane & 7;
#pragma unroll
    for (int j = 0; j < 4; ++j) { const int n = (lane >> 3) + 8 * j; const LAS float* sp = scr + (8 * c) * 33 + n;
        v4u o; o.x = pk2(sp[0 * 33], sp[1 * 33]); o.y = pk2(sp[2 * 33], sp[3 * 33]); o.z = pk2(sp[4 * 33], sp[5 * 33]); o.w = pk2(sp[6 * 33], sp[7 * 33]);
        *(v4u*)(WT + (size_t)(drow0 + n0 + n) * Kd + k0 + 8 * c) = o; }
    LDS_WAIT(); asm volatile("" ::: "memory");
}
__device__ __forceinline__ void sincos_acc(float angf, float& s, float& c) {
    const double a = (double)angf;
    const double k = __builtin_rint(a * 0.63661977236758134308);
    const double y = __builtin_fma(-k, 1.57079632679489661923, a) - k * 6.123233995736766e-17;
    const double y2 = y * y;
    double sp = -1.0 / 1307674368000.0; sp = sp * y2 + 1.0 / 6227020800.0; sp = sp * y2 - 1.0 / 39916800.0; sp = sp * y2 + 1.0 / 362880.0; sp = sp * y2 - 1.0 / 5040.0; sp = sp * y2 + 1.0 / 120.0; sp = sp * y2 - 1.0 / 6.0; sp = sp * y2 + 1.0;
    const double sy = sp * y;
    double cp = 1.0 / 20922789888000.0; cp = cp * y2 - 1.0 / 87178291200.0; cp = cp * y2 + 1.0 / 479001600.0; cp = cp * y2 - 1.0 / 3628800.0; cp = cp * y2 + 1.0 / 40320.0; cp = cp * y2 - 1.0 / 720.0; cp = cp * y2 + 1.0 / 24.0; cp = cp * y2 - 0.5; cp = cp * y2 + 1.0;
    const int q = ((int)k) & 3;
    const double ss = (q == 0) ? sy : (q == 1) ? cp : (q == 2) ? -sy : -cp;
    const double cc = (q == 0) ? cp : (q == 1) ? -sy : (q == 2) ? -cp : sy;
    s = (float)ss; c = (float)cc;
}
__device__ __forceinline__ void p0_prologue(Frame& F) {
    static constexpr float ROPE_INV[64] = {
        1.000000000e+00f, 8.659643531e-01f, 7.498942018e-01f, 6.493816376e-01f, 5.623413324e-01f, 4.869675338e-01f, 4.216965139e-01f, 3.651741147e-01f, 3.162277639e-01f, 2.738419771e-01f, 2.371373773e-01f, 2.053525001e-01f, 1.778279394e-01f, 1.539926529e-01f, 1.333521456e-01f, 1.154781953e-01f,
        1.000000015e-01f, 8.659642935e-02f, 7.498942316e-02f, 6.493816525e-02f, 5.623413250e-02f, 4.869675264e-02f, 4.216964915e-02f, 3.651741147e-02f, 3.162277490e-02f, 2.738419548e-02f, 2.371373773e-02f, 2.053525113e-02f, 1.778279431e-02f, 1.539926510e-02f, 1.333521400e-02f, 1.154781971e-02f,
        9.999999776e-03f, 8.659643121e-03f, 7.498942316e-03f, 6.493816152e-03f, 5.623413250e-03f, 4.869675264e-03f, 4.216964822e-03f, 3.651741194e-03f, 3.162277630e-03f, 2.738419687e-03f, 2.371373819e-03f, 2.053525066e-03f, 1.778279431e-03f, 1.539926510e-03f, 1.333521446e-03f, 1.154782018e-03f,
        1.000000047e-03f, 8.659643354e-04f, 7.498941850e-04f, 6.493816036e-04f, 5.623413017e-04f, 4.869675322e-04f, 4.216965172e-04f, 3.651741135e-04f, 3.162277571e-04f, 2.738419571e-04f, 2.371373703e-04f, 2.053525095e-04f, 1.778279402e-04f, 1.539926598e-04f, 1.333521504e-04f, 1.154782003e-04f};
    LAS float* scr = (LAS float*)(F.lds + F.wave * 16384);
    const int gw = F.vcu * 8 + F.wave, NGW = F.G * 8;
    bf16* WAIN = (bf16*)(F.ws + WS_WAIN); bf16* WAOUT = (bf16*)(F.ws + WS_WAOUT); bf16* WB1 = (bf16*)(F.ws + WS_WB1); bf16* WBOUT = (bf16*)(F.ws + WS_WBOUT); bf16* WRG = (bf16*)(F.ws + WS_WRG);
    constexpr int I0 = 16 * 64, I1 = 16 * 32, I2 = 16 * 64, I3 = 16 * 64, I4 = 16 * 32, I5 = 16 * 8;
    constexpr int NITEMS = I0 + I1 + I2 + I3 + I4 + I5;
    for (int it = gw; it < NITEMS; it += NGW) {
        int r = it;
        if (r < I0) { p0_transpose_item<0>(inp(2), 2048, DM, WAIN, 0, inp(1), scr, (r / 64) * 64, (r % 64) * 32, F.lane); continue; } r -= I0;
        if (r < I1) { p0_transpose_item<0>(inp(10), 1024, DM, WAOUT, 0, nullptr, scr, (r / 32) * 64, (r % 32) * 32, F.lane); continue; } r -= I1;
        if (r < I2) { p0_transpose_item<1>(inp(12), 2048, DM, WB1, 0, inp(11), scr, (r / 64) * 64, (r % 64) * 32, F.lane); continue; } r -= I2;
        if (r < I3) { p0_transpose_item<1>(inp(15), 2048, DM, WB1, 2048, inp(14), scr, (r / 64) * 64, (r % 64) * 32, F.lane); continue; } r -= I3;
        if (r < I4) { p0_transpose_item<0>(inp(17), 1024, DM, WBOUT, 0, nullptr, scr, (r / 32) * 64, (r % 32) * 32, F.lane); continue; } r -= I4;
        { const int mat = r >> 3, sub = r & 7, n = mat >> 1, which = mat & 1;
          const float* W = (which ? inp(7) : inp(5)) + (size_t)n * 128 * 128;
          p0_transpose_item<0>(W, 128, 128, WRG, n * 256 + which * 128, nullptr, scr, (sub >> 2) * 64, (sub & 3) * 32, F.lane); }
    }
    bf16* XB = (bf16*)(F.ws + WS_S0); float* RS0 = (float*)(F.ws + WS_RS0);
    for (int m0 = gw * 8; m0 < T; m0 += NGW * 8) {
        const float* xin = inp(0);
        f32x4 v[8][4];
#pragma unroll
        for (int r = 0; r < 8; ++r) { const f32x4* xr = (const f32x4*)(xin + (size_t)(m0 + r) * DM) + F.lane;
#pragma unroll
            for (int j = 0; j < 4; ++j) v[r][j] = __builtin_nontemporal_load(xr + 64 * j); }
#pragma unroll
        for (int r = 0; r < 8; ++r) { float s = 0.f;
#pragma unroll
            for (int j = 0; j < 4; ++j) s += (v[r][j][0] * v[r][j][0] + v[r][j][1] * v[r][j][1]) + (v[r][j][2] * v[r][j][2] + v[r][j][3] * v[r][j][3]);
            s = wave_sum(s);
            if (F.lane == 0) RS0[m0 + r] = 1.0f / sqrtf(s * (1.0f / DM) + EPS);
            v2u* o8 = (v2u*)(XB + (size_t)(m0 + r) * DM) + F.lane;
#pragma unroll
            for (int j = 0; j < 4; ++j) { v2u w; w.x = pk2(v[r][j][0], v[r][j][1]); w.y = pk2(v[r][j][2], v[r][j][3]); o8[64 * j] = w; } }
    }
    float* RC = (float*)(F.ws + WS_ROPE); float* RSn = RC + (size_t)SEQ * 64;
    for (int idx = gw * 64 + F.lane; idx < SEQ * 64; idx += NGW * 64) {
        const int pos = idx >> 6, i = idx & 63;
        const float inv = ROPE_INV[i];
        const float ang = (float)pos * inv; float s, c; sincos_acc(ang, s, c);
        RC[idx] = c; RSn[idx] = s;
    }
}

constexpr int XB_PITCH = 272;
constexpr int XB_TILE = 256 * XB_PITCH;
__device__ __forceinline__ int xb_addr(int tok, int byteoff) { return tok * XB_PITCH + ((((byteoff >> 4) ^ (((tok >> 6) & 3) << 2)) << 4) | (byteoff & 15)); }
__device__ __forceinline__ unsigned pk_half2(float lo, float hi) { const _Float16 a = (_Float16)lo, b = (_Float16)hi; return (unsigned)__builtin_bit_cast(unsigned short, a) | ((unsigned)__builtin_bit_cast(unsigned short, b) << 16); }
__device__ __forceinline__ float half_lo(unsigned w) { return (float)__builtin_bit_cast(_Float16, (unsigned short)(w & 0xffffu)); }
__device__ __forceinline__ float half_hi(unsigned w) { return (float)__builtin_bit_cast(_Float16, (unsigned short)(w >> 16)); }
constexpr float LA_SCALE = 256.0f;
__device__ __forceinline__ void scan_unit(Frame& F, int b, int c, int n) {
    LAS unsigned char* XBt = F.lds;
    const bf16* UX = (const bf16*)(F.ws + WS_S1); unsigned* LB = (unsigned*)(F.ws + WS_S3);
    float* SUMA = (float*)(F.ws + WS_SUMA); float* SUMB = (float*)(F.ws + WS_SUMB); float* SEGA = (float*)(F.ws + WS_SEGA); float* SEGB = (float*)(F.ws + WS_SEGB);
    const int t0 = c * BLK; const size_t rowbase = (size_t)b * SEQ + t0;
    TS_BEGIN(1);
    {
        const int cg = F.tid & 15, tr = F.tid >> 4, chb = n * 128 + cg * 8;
        const float* cw = inp(3); const float* cb = inp(4);
        float w[4][8], bia[8];
#pragma unroll
        for (int k = 0; k < 4; ++k) { const f32x4 a = *(const f32x4*)(cw + k * DM + chb), bb = *(const f32x4*)(cw + k * DM + chb + 4);
            w[k][0] = a[0]; w[k][1] = a[1]; w[k][2] = a[2]; w[k][3] = a[3]; w[k][4] = bb[0]; w[k][5] = bb[1]; w[k][6] = bb[2]; w[k][7] = bb[3]; }
        { const f32x4 a = *(const f32x4*)(cb + chb), bb = *(const f32x4*)(cb + chb + 4); bia[0] = a[0]; bia[1] = a[1]; bia[2] = a[2]; bia[3] = a[3]; bia[4] = bb[0]; bia[5] = bb[1]; bia[6] = bb[2]; bia[7] = bb[3]; }
        v4u raw[11];
#pragma unroll
        for (int i = 0; i < 11; ++i) { const int t = 8 * tr + i - 3; const bool ok = (c > 0) || (t >= 0);
            raw[i] = ok ? __builtin_nontemporal_load((const v4u*)(UX + (size_t)((long)rowbase + t) * DM + chb)) : (v4u){0u, 0u, 0u, 0u}; }
#pragma unroll
        for (int i = 0; i < 8; ++i) { float o[8];
#pragma unroll
            for (int e = 0; e < 8; ++e) o[e] = bia[e];
#pragma unroll
            for (int k = 0; k < 4; ++k) { const v4u r = raw[i + k];
                o[0] += w[k][0] * bflo(r.x); o[1] += w[k][1] * bfhi(r.x); o[2] += w[k][2] * bflo(r.y); o[3] += w[k][3] * bfhi(r.y);
                o[4] += w[k][4] * bflo(r.z); o[5] += w[k][5] * bfhi(r.z); o[6] += w[k][6] * bflo(r.w); o[7] += w[k][7] * bfhi(r.w); }
            v4u pk; pk.x = pk2(o[0], o[1]); pk.y = pk2(o[2], o[3]); pk.z = pk2(o[4], o[5]); pk.w = pk2(o[6], o[7]);
            *(LAS v4u*)(XBt + xb_addr(8 * tr + i, cg * 16)) = pk; }
    }
    __syncthreads();
    TS_END(1); TS_BEGIN(2);
    {
        const int w = F.wave, cl = F.lane & 15, q = F.lane >> 4;
        const bf16* WRG = (const bf16*)(F.ws + WS_WRG);
        bf16x8 Br[4], Bi[4];
#pragma unroll
        for (int ks = 0; ks < 4; ++ks) { Br[ks] = *(const bf16x8*)(WRG + (size_t)(n * 256 + 16 * w + cl) * 128 + 32 * ks + 8 * q);
                                         Bi[ks] = *(const bf16x8*)(WRG + (size_t)(n * 256 + 128 + 16 * w + cl) * 128 + 32 * ks + 8 * q); }
        const int ch = n * 128 + 16 * w + cl;
        const float rb = inp(6)[ch] * -1.4426950408889634f, ib = inp(8)[ch] * -1.4426950408889634f, lam = inp(9)[ch];
        const float z = -lam; const float sp = fmaxf(z, 0.f) + log1pf(expf(-fabsf(z)));
        const float c8 = -8.0f * sp, c8l = c8 * 1.4426950408889634f;
        float Arun = 1.f, h = 0.f;
        const int arow = 64 * (cl >> 2) + (cl & 3);
        int aoffs[4];
#pragma unroll
        for (int ks = 0; ks < 4; ++ks) aoffs[ks] = xb_addr(arow, (32 * ks + 8 * q) * 2);
        const int eoff = xb_addr(64 * q, (16 * w + cl) * 2);
        unsigned* lbp = LB + (rowbase + 64 * q) * DM + ch;
#pragma unroll 2
        for (int mt = 0; mt < 16; ++mt) {
            pg8::f32x4 accR = {0.f, 0.f, 0.f, 0.f}, accI = {0.f, 0.f, 0.f, 0.f};
#pragma unroll
            for (int ks = 0; ks < 4; ++ks) { const bf16x8 a = *(const LAS bf16x8*)(XBt + aoffs[ks] + 4 * mt * XB_PITCH);
                accR = __builtin_amdgcn_mfma_f32_16x16x32_bf16(a, Br[ks], accR, 0, 0, 0);
                accI = __builtin_amdgcn_mfma_f32_16x16x32_bf16(a, Bi[ks], accI, 0, 0, 0); }
            typedef float f32x2 __attribute__((ext_vector_type(2)));
#pragma unroll
            for (int rp = 0; rp < 4; rp += 2) {
                const int eo = eoff + (4 * mt + rp) * XB_PITCH;
                const f32x2 xv = {bf1(*(const LAS unsigned short*)(XBt + eo)), bf1(*(const LAS unsigned short*)(XBt + eo + XB_PITCH))};
                const f32x2 zr = (f32x2){accR[rp], accR[rp + 1]} * -1.4426950408889634f + rb, zi = (f32x2){accI[rp], accI[rp + 1]} * -1.4426950408889634f + ib;
                const f32x2 er = {fast_exp2(zr[0]), fast_exp2(zr[1])}, ei = {fast_exp2(zi[0]), fast_exp2(zi[1])};
                const f32x2 dr = er + 1.0f, di = ei + 1.0f;
                const f32x2 rg = {__builtin_amdgcn_rcpf(dr[0]), __builtin_amdgcn_rcpf(dr[1])}, ig = {__builtin_amdgcn_rcpf(di[0]), __builtin_amdgcn_rcpf(di[1])};
                const f32x2 la2 = rg * c8l;
                const f32x2 av = {fast_exp2(la2[0]), fast_exp2(la2[1])};
                const f32x2 x2 = rg * (2.f * c8);
                f32x2 pz = x2 * (1.0f / 120.0f) + (1.0f / 24.0f); pz = pz * x2 + (1.0f / 6.0f); pz = pz * x2 + 0.5f; pz = pz * x2 + 1.0f;
                const f32x2 ser = -x2 * pz, dir = 1.0f - av * av;
                const f32x2 em1 = {fminf(ser[0], dir[0]), fminf(ser[1], dir[1])};
                const f32x2 sq = {__builtin_amdgcn_sqrtf(em1[0]), __builtin_amdgcn_sqrtf(em1[1])};
                const f32x2 bt = sq * ig * xv; const f32x2 las = la2 * LA_SCALE;
                h = av[0] * h + bt[0]; lbp[(size_t)(4 * mt + rp) * DM] = pk_half2(las[0], bt[0]);
                h = av[1] * h + bt[1]; lbp[(size_t)(4 * mt + rp + 1) * DM] = pk_half2(las[1], bt[1]);
                Arun *= av[0] * av[1]; }
        }
        SEGA[(size_t)(b * 256 + 4 * c + q) * DM + ch] = Arun; SEGB[(size_t)(b * 256 + 4 * c + q) * DM + ch] = h;
        float Ac = 1.f, Bc = 0.f;
#pragma unroll
        for (int k = 0; k < 4; ++k) { const float Ak = __shfl(Arun, cl + 16 * k), Bk = __shfl(h, cl + 16 * k); Bc = Ak * Bc + Bk; Ac *= Ak; }
        if (q == 0) { SUMA[(size_t)(b * 64 + c) * DM + ch] = Ac; SUMB[(size_t)(b * 64 + c) * DM + ch] = Bc; }
    }
    __syncthreads();
    TS_END(2);
}
__device__ __forceinline__ void scan_apply_unit(Frame& F, int b, int seg) {
    const unsigned* LB = (const unsigned*)(F.ws + WS_S3); const bf16* SG = (const bf16*)(F.ws + WS_S2); bf16* Y = (bf16*)(F.ws + WS_S0);
    const float* SUMA = (const float*)(F.ws + WS_SUMA); const float* SUMB = (const float*)(F.ws + WS_SUMB); const float* SEGA = (const float*)(F.ws + WS_SEGA); const float* SEGB = (const float*)(F.ws + WS_SEGB);
    typedef float f32x2 __attribute__((ext_vector_type(2)));
    const int ch = 2 * F.tid, c = seg >> 2, qq = seg & 3;
    float h0 = 0.f, h1 = 0.f;
    TS_BEGIN(11);
    for (int cc0 = 0; cc0 < c; cc0 += 8) {
        f32x2 A[8], Bv[8];
#pragma unroll
        for (int i = 0; i < 8; ++i) { const bool ok = cc0 + i < c; const size_t o = (size_t)(b * 64 + cc0 + i) * DM + ch;
            A[i] = ok ? *(const f32x2*)(SUMA + o) : (f32x2){1.f, 1.f}; Bv[i] = ok ? *(const f32x2*)(SUMB + o) : (f32x2){0.f, 0.f}; }
#pragma unroll
        for (int i = 0; i < 8; ++i) { h0 = A[i][0] * h0 + Bv[i][0]; h1 = A[i][1] * h1 + Bv[i][1]; }
    }
    {   f32x2 A[3], Bv[3];
#pragma unroll
        for (int i = 0; i < 3; ++i) { const bool ok = i < qq; const size_t o = (size_t)(b * 256 + 4 * c + i) * DM + ch;
            A[i] = ok ? *(const f32x2*)(SEGA + o) : (f32x2){1.f, 1.f}; Bv[i] = ok ? *(const f32x2*)(SEGB + o) : (f32x2){0.f, 0.f}; }
#pragma unroll
        for (int i = 0; i < 3; ++i) { h0 = A[i][0] * h0 + Bv[i][0]; h1 = A[i][1] * h1 + Bv[i][1]; } }
    TS_END(11); TS_BEGIN(12);
    const size_t row0 = (size_t)b * SEQ + (size_t)seg * 64;
#pragma unroll 1
    for (int t0 = 0; t0 < 64; t0 += 16) {
        v2u lb[16]; unsigned sg[16];
#pragma unroll
        for (int i = 0; i < 16; ++i) { const size_t o = (row0 + t0 + i) * DM + ch; lb[i] = *(const v2u*)(LB + o); sg[i] = *(const unsigned*)(SG + o); }
#pragma unroll
        for (int i = 0; i < 16; ++i) {
            h0 = fast_exp2(half_lo(lb[i].x) * (1.0f / LA_SCALE)) * h0 + half_hi(lb[i].x);
            h1 = fast_exp2(half_lo(lb[i].y) * (1.0f / LA_SCALE)) * h1 + half_hi(lb[i].y);
            *(unsigned*)(Y + (row0 + t0 + i) * DM + ch) = pk2(h0 * bflo(sg[i]), h1 * bfhi(sg[i])); }
    }
    TS_END(12);
}

__device__ __forceinline__ void fix_unit(Frame& F, int b, int blk, int h, int which  ) {
    bf16* BUF = (bf16*)(F.ws + (which ? WS_S0 : WS_S1));
    const float* G = which ? inp(16) : inp(13);
    const float* RC = (const float*)(F.ws + WS_ROPE); const float* RSn = RC + (size_t)SEQ * 64;
    LAS float* red = (LAS float*)F.lds;
    const int k16 = F.tid & 15, ts = F.tid >> 4;
    float g[8];
    { const f32x4 a = *(const f32x4*)(G + 4 * k16), bb = *(const f32x4*)(G + 64 + 4 * k16); g[0] = a[0]; g[1] = a[1]; g[2] = a[2]; g[3] = a[3]; g[4] = bb[0]; g[5] = bb[1]; g[6] = bb[2]; g[7] = bb[3]; }
    const float osc = which ? QSCALE : 1.0f;
    float km[8] = {0.f, 0.f, 0.f, 0.f, 0.f, 0.f, 0.f, 0.f};
#pragma unroll 2
    for (int it = 0; it < 8; ++it) {
        const int tl = ts + 32 * it, pos = blk * BLK + tl; const size_t row = (size_t)b * SEQ + pos;
        bf16* p = BUF + row * DM + h * 128 + 8 * k16;
        const v4u raw = *(const v4u*)p;
        float v[8] = {bflo(raw.x), bfhi(raw.x), bflo(raw.y), bfhi(raw.y), bflo(raw.z), bfhi(raw.z), bflo(raw.w), bfhi(raw.w)};
        float ss = 0.f;
#pragma unroll
        for (int e = 0; e < 8; ++e) ss += v[e] * v[e];
        ss += __shfl_xor(ss, 1); ss += __shfl_xor(ss, 2); ss += __shfl_xor(ss, 4); ss += __shfl_xor(ss, 8);
        const float rinv = 1.0f / sqrtf(ss * (1.0f / HD) + EPS);
        const f32x4 cs = *(const f32x4*)(RC + (size_t)pos * 64 + 4 * k16), sn = *(const f32x4*)(RSn + (size_t)pos * 64 + 4 * k16);
        float o[8];
#pragma unroll
        for (int e = 0; e < 4; ++e) { const float x1 = v[e] * rinv * g[e], x2 = v[4 + e] * rinv * g[4 + e];
            o[e] = (x1 * cs[e] - x2 * sn[e]) * osc; o[4 + e] = (x2 * cs[e] + x1 * sn[e]) * osc; }
#pragma unroll
        for (int e = 0; e < 8; ++e) km[e] += o[e];
        v4u w; w.x = pk2(o[0], o[1]); w.y = pk2(o[2], o[3]); w.z = pk2(o[4], o[5]); w.w = pk2(o[6], o[7]);
        if (F.probe) *(v4u*)(F.ws + 48 * MiB + (((size_t)(p - BUF) * 2) & (8 * MiB - 1))) = w; else *(v4u*)p = w;
    }
    if (which == 0) {
#pragma unroll
        for (int e = 0; e < 8; ++e) red[ts * 128 + 8 * k16 + e] = km[e];
        __syncthreads();
        if (F.tid < 128) { float s = 0.f;
#pragma unroll 8
            for (int j = 0; j < 32; ++j) s += red[j * 128 + F.tid];
            ((float*)(F.ws + WS_KMEAN))[((size_t)(b * NH + h) * NBLK + blk) * HD + F.tid] = s * (1.0f / BLK); }
        __syncthreads();
    }
}

#define KSWZ(row, colB) ((row) * 256 + ((colB) ^ (((row) & 7) << 4)))
__device__ __forceinline__ int crow(int r, int hi) { return (r & 3) + 8 * (r >> 2) + 4 * hi; }
__device__ __forceinline__ int v_st(int k, int c) { const int kk = (k & ~0xC) | ((k & 4) << 1) | ((k & 8) >> 1); return ((kk >> 3) * 4 + (c >> 5)) * 512 + ((kk & 7) * 32 + (c & 31)) * 2; }
__device__ __forceinline__ int v_rd_base(int lane) { return ((lane & 3) << 3) | (((lane >> 2) & 3) << 6) | (((lane >> 4) & 1) << 5) | (((lane >> 5) & 1) << 8); }
constexpr int v_rd_off(int d0, int ks, int half) { return d0 * 512 + ks * 4096 + half * 2048; }
template <int OFF> __device__ __forceinline__ s16x4 tr_read(int vb) {
    s16x4 r; asm volatile("ds_read_b64_tr_b16 %0, %1 offset:%2" : "=&v"(r) : "v"(vb), "i"(OFF) : "memory"); return r;
}
__device__ __forceinline__ void qkt_acc(f32x16& p0, f32x16& p1, const LAS unsigned char* Ks, const bf16x8 (&qr)[8], int r32, int hi) {
    bf16x8 b0[8], b1[8];
#pragma unroll
    for (int d0 = 0; d0 < 8; ++d0) { const int cb = (d0 * 16 + hi * 8) * 2;
        b0[d0] = *(const LAS bf16x8*)(Ks + KSWZ(r32, cb)); b1[d0] = *(const LAS bf16x8*)(Ks + KSWZ(32 + r32, cb)); }
#pragma unroll
    for (int d0 = 0; d0 < 8; ++d0) {
        p0 = __builtin_amdgcn_mfma_f32_32x32x16_bf16(b0[d0], qr[d0], p0, 0, 0, 0);
        p1 = __builtin_amdgcn_mfma_f32_32x32x16_bf16(b1[d0], qr[d0], p1, 0, 0, 0); }
}
template <int D0> __device__ __forceinline__ void pv_one(f32x16& od, int vb, bf16x8 pa0, bf16x8 pa1, bf16x8 pa2, bf16x8 pa3) {
    const s16x4 l0 = tr_read<v_rd_off(D0, 0, 0)>(vb), h0 = tr_read<v_rd_off(D0, 0, 1)>(vb), l1 = tr_read<v_rd_off(D0, 1, 0)>(vb), h1 = tr_read<v_rd_off(D0, 1, 1)>(vb);
    const s16x4 l2 = tr_read<v_rd_off(D0, 2, 0)>(vb), h2 = tr_read<v_rd_off(D0, 2, 1)>(vb), l3 = tr_read<v_rd_off(D0, 3, 0)>(vb), h3 = tr_read<v_rd_off(D0, 3, 1)>(vb);
    asm volatile("s_waitcnt lgkmcnt(0)" ::: "memory"); SBAR();
#define PKV(L, H) (bf16x8){L[0], L[1], L[2], L[3], H[0], H[1], H[2], H[3]}
    od = __builtin_amdgcn_mfma_f32_32x32x16_bf16(PKV(l0, h0), pa0, od, 0, 0, 0);
    od = __builtin_amdgcn_mfma_f32_32x32x16_bf16(PKV(l1, h1), pa1, od, 0, 0, 0);
    od = __builtin_amdgcn_mfma_f32_32x32x16_bf16(PKV(l2, h2), pa2, od, 0, 0, 0);
    od = __builtin_amdgcn_mfma_f32_32x32x16_bf16(PKV(l3, h3), pa3, od, 0, 0, 0);
#undef PKV
}
constexpr float THR2 = 8.0f;
template <bool DIAG>
__device__ __forceinline__ void attn_subtile(f32x16 (&o)[4], float& m, float& l, const LAS unsigned char* Ks, int vb, const bf16x8 (&qr)[8], int r32, int hi, int kb0, int qidx) {
    const bool fresh = m <= -1e29f;
    const float mref = fresh ? 0.f : m, nm = -mref;
    f32x16 p0, p1;
#pragma unroll
    for (int r = 0; r < 16; ++r) { p0[r] = nm; p1[r] = nm; }
    qkt_acc(p0, p1, Ks, qr, r32, hi);
    if (DIAG) {
#pragma unroll
        for (int r = 0; r < 16; ++r) { const int kk = kb0 + crow(r, hi); if (kk > qidx) p0[r] = -1e30f; if (kk + 32 > qidx) p1[r] = -1e30f; }
    }
    float pmax = p0[0];
#pragma unroll
    for (int r = 1; r < 16; ++r) pmax = fmaxf(pmax, p0[r]);
#pragma unroll
    for (int r = 0; r < 16; ++r) pmax = fmaxf(pmax, p1[r]);
    { auto rr = __builtin_amdgcn_permlane32_swap(__float_as_uint(pmax), __float_as_uint(pmax), false, false);
      pmax = fmaxf(__uint_as_float(rr[0]), __uint_as_float(rr[1])); }
    const bool need = fresh || (pmax > THR2);
    if (__any(need)) {
        const float d = need ? pmax : 0.f;
        const float alpha = fresh ? 0.f : fast_exp2(-d);
        m = mref + d; l *= alpha;
#pragma unroll
        for (int r = 0; r < 16; ++r) { p0[r] -= d; p1[r] -= d; }
#pragma unroll
        for (int dd = 0; dd < 4; ++dd)
#pragma unroll
            for (int r = 0; r < 16; ++r) o[dd][r] *= alpha;
    }
    float ps = 0.f;
#pragma unroll
    for (int r = 0; r < 16; ++r) { p0[r] = fast_exp2(p0[r]); ps += p0[r]; }
#pragma unroll
    for (int r = 0; r < 16; ++r) { p1[r] = fast_exp2(p1[r]); ps += p1[r]; }
    { auto rr = __builtin_amdgcn_permlane32_swap(__float_as_uint(ps), __float_as_uint(ps), false, false);
      ps = __uint_as_float(rr[0]) + __uint_as_float(rr[1]); }
    l += ps;
    bf16x8 pa0, pa1, pa2, pa3;
#define PK4(P, BASE, OUT) do { unsigned a0 = pk2(P[BASE + 0], P[BASE + 1]), a1 = pk2(P[BASE + 2], P[BASE + 3]);   \
    unsigned b0 = pk2(P[BASE + 4], P[BASE + 5]), b1 = pk2(P[BASE + 6], P[BASE + 7]);                              \
    auto r0 = __builtin_amdgcn_permlane32_swap(a0, b0, false, false); auto r1 = __builtin_amdgcn_permlane32_swap(a1, b1, false, false); \
    v4u w = {r0[0], r1[0], r0[1], r1[1]}; OUT = __builtin_bit_cast(bf16x8, w); } while (0)
    PK4(p0, 0, pa0); PK4(p0, 8, pa1); PK4(p1, 0, pa2); PK4(p1, 8, pa3);
#undef PK4
    pv_one<0>(o[0], vb, pa0, pa1, pa2, pa3); pv_one<1>(o[1], vb, pa0, pa1, pa2, pa3); pv_one<2>(o[2], vb, pa0, pa1, pa2, pa3); pv_one<3>(o[3], vb, pa0, pa1, pa2, pa3);
}
__device__ __forceinline__ void row_store_T(unsigned char* rowp, const f32x16 (&o)[4], float sc, int hi, bool pred) {
#pragma unroll
    for (int j = 0; j < 8; ++j) { const int d0 = j >> 1, g0 = (j & 1) * 2;
        unsigned ax = pk2(o[d0][4 * g0 + 0] * sc, o[d0][4 * g0 + 1] * sc), ay = pk2(o[d0][4 * g0 + 2] * sc, o[d0][4 * g0 + 3] * sc);
        unsigned bx = pk2(o[d0][4 * g0 + 4] * sc, o[d0][4 * g0 + 5] * sc), by = pk2(o[d0][4 * g0 + 6] * sc, o[d0][4 * g0 + 7] * sc);
        auto r0 = __builtin_amdgcn_permlane32_swap(ax, bx, false, false); auto r1 = __builtin_amdgcn_permlane32_swap(ay, by, false, false);
        const v4u w = {r0[0], r1[0], r0[1], r1[1]};
        if (pred) *(v4u*)(rowp + 32 * j + 16 * hi) = w; }
}
__device__ __forceinline__ void row_load_T(const unsigned char* rowp, f32x16 (&v)[4], int hi) {
    v4u w[8];
#pragma unroll
    for (int j = 0; j < 8; ++j) w[j] = *(const v4u*)(rowp + 32 * j + 16 * hi);
#pragma unroll
    for (int j = 0; j < 8; ++j) { const int d0 = j >> 1, g0 = (j & 1) * 2;
        auto r0 = __builtin_amdgcn_permlane32_swap(w[j].x, w[j].z, false, false); auto r1 = __builtin_amdgcn_permlane32_swap(w[j].y, w[j].w, false, false);
        const unsigned ax = r0[0], bx = r0[1], ay = r1[0], by = r1[1];
        v[d0][4 * g0 + 0] = bflo(ax); v[d0][4 * g0 + 1] = bfhi(ax); v[d0][4 * g0 + 2] = bflo(ay); v[d0][4 * g0 + 3] = bfhi(ay);
        v[d0][4 * g0 + 4] = bflo(bx); v[d0][4 * g0 + 5] = bfhi(bx); v[d0][4 * g0 + 6] = bflo(by); v[d0][4 * g0 + 7] = bfhi(by); }
}
constexpr int KIMG = 0, VIMG = 65536, ATT_AUX = 131072;
__device__ __forceinline__ void load_kv_block(Frame& F, int b, int h, int j) {
    const bf16* KB = (const bf16*)(F.ws + WS_S1); const bf16* VB = (const bf16*)(F.ws + WS_S2);
    const size_t base = ((size_t)b * SEQ + (size_t)j * BLK) * DM + h * 128;
    v4u kr[8], vr[8];
#pragma unroll
    for (int it = 0; it < 8; ++it) { const int id = F.tid + 512 * it, row = id >> 4, c = id & 15;
        kr[it] = *(const v4u*)(KB + base + (size_t)row * DM + c * 8); vr[it] = *(const v4u*)(VB + base + (size_t)row * DM + c * 8); }
#pragma unroll
    for (int it = 0; it < 8; ++it) { const int id = F.tid + 512 * it, row = id >> 4, c = id & 15;
        *(LAS v4u*)(F.lds + KIMG + (row >> 6) * 16384 + KSWZ(row & 63, c * 16)) = kr[it];
        *(LAS v4u*)(F.lds + VIMG + (row >> 6) * 16384 + v_st(row & 63, c * 8)) = vr[it]; }
}

__device__ __forceinline__ void select_loads(Frame& F, int b, int h, int qb, f32x4 (&km)[4], bf16x8 (&qr)[8]) {
    const float* KM = (const float*)(F.ws + WS_KMEAN) + (size_t)(b * NH + h) * NBLK * HD;
    const bf16* QB = (const bf16*)(F.ws + WS_S0);
    const int r32 = F.lane & 31, hi = F.lane >> 5, ql = 32 * F.wave + r32;
    const size_t tok = (size_t)b * SEQ + qb * BLK + ql;
#pragma unroll
    for (int d0 = 0; d0 < 8; ++d0) qr[d0] = *(const bf16x8*)(QB + tok * DM + h * 128 + d0 * 16 + hi * 8);
#pragma unroll
    for (int it = 0; it < 2; ++it) { const int id = F.tid + 512 * it, row = id >> 4, c = id & 15;
        km[2 * it] = *(const f32x4*)(KM + row * HD + c * 8); km[2 * it + 1] = *(const f32x4*)(KM + row * HD + c * 8 + 4); }
}
__device__ __forceinline__ void select_unit(Frame& F, int b, int h, int qb, f32x4 (&km)[4], bf16x8 (&qr)[8], int nb, int nh, int nqb) {
    LAS unsigned char* KH = F.lds; LAS unsigned char* KL = F.lds + 16384;
    LAS int* cnt = (LAS int*)(F.lds + 32768); LAS int* cursor = cnt + 64; LAS int* offs = cnt + 128; LAS unsigned short* ent = (LAS unsigned short*)(F.lds + 32768 + 1024);
    unsigned short* ENT = (unsigned short*)(F.ws + WS_ENT) + (size_t)((b * NH + h) * NBLK + qb) * 768;
    unsigned short* OFFS = (unsigned short*)(F.ws + WS_OFFS) + (size_t)((b * NH + h) * NBLK + qb) * OFFS_PITCH;
    unsigned* NTOT = (unsigned*)(F.ws + WS_CTL) + CW_NTOT + (b * NH + h) * NBLK;
    TS_BEGIN(70);
#pragma unroll
    for (int it = 0; it < 2; ++it) { const int id = F.tid + 512 * it, row = id >> 4, c = id & 15;
        const f32x4 a = km[2 * it], bb = km[2 * it + 1];
        float v[8] = {a[0], a[1], a[2], a[3], bb[0], bb[1], bb[2], bb[3]}; unsigned hw[8]; float lo[8];
#pragma unroll
        for (int e = 0; e < 8; ++e) { if (row >= qb) v[e] = 0.f; hw[e] = f2bf(v[e]); lo[e] = v[e] - __builtin_bit_cast(float, hw[e] << 16); }
        v4u wh = {hw[0] | (hw[1] << 16), hw[2] | (hw[3] << 16), hw[4] | (hw[5] << 16), hw[6] | (hw[7] << 16)};
        v4u wl = {pk2(lo[0], lo[1]), pk2(lo[2], lo[3]), pk2(lo[4], lo[5]), pk2(lo[6], lo[7])};
        *(LAS v4u*)(KH + KSWZ(row, c * 16)) = wh; *(LAS v4u*)(KL + KSWZ(row, c * 16)) = wl; }
    if (F.tid < 64) cnt[F.tid] = 0;
    __syncthreads();
    TS_END(70); TS_BEGIN(71);
    const int r32 = F.lane & 31, hi = F.lane >> 5, ql = 32 * F.wave + r32;
    f32x16 p0 = {}, p1 = {};
    qkt_acc(p0, p1, KH, qr, r32, hi); qkt_acc(p0, p1, KL, qr, r32, hi);
    if (nqb >= 0) select_loads(F, nb, nh, nqb, km, qr);
    unsigned key[32];
#pragma unroll
    for (int r = 0; r < 16; ++r) { const int j0 = crow(r, hi), j1 = 32 + crow(r, hi);
        const unsigned b0 = __float_as_uint(p0[r]), b1 = __float_as_uint(p1[r]);
        const unsigned u0 = b0 ^ (((int)b0 >> 31) | 0x80000000u), u1 = b1 ^ (((int)b1 >> 31) | 0x80000000u);
        key[r] = j0 < qb ? ((u0 & ~63u) | (unsigned)(63 - j0)) : 0u; key[16 + r] = j1 < qb ? ((u1 & ~63u) | (unsigned)(63 - j1)) : 0u; }
    unsigned tk[3];
#pragma unroll
    for (int pass = 0; pass < 3; ++pass) { unsigned bk = key[0];
#pragma unroll
        for (int r = 1; r < 32; ++r) bk = bk > key[r] ? bk : key[r];
        tk[pass] = bk;
#pragma unroll
        for (int r = 0; r < 32; ++r) key[r] = (key[r] == bk) ? 0u : key[r]; }
    unsigned mk[6];
#pragma unroll
    for (int k = 0; k < 3; ++k) { mk[k] = tk[k]; mk[3 + k] = (unsigned)__shfl_xor((int)tk[k], 32); }
    unsigned fk[3];
#pragma unroll
    for (int pass = 0; pass < 3; ++pass) { unsigned bk = mk[0];
#pragma unroll
        for (int r = 1; r < 6; ++r) bk = bk > mk[r] ? bk : mk[r];
        fk[pass] = bk;
#pragma unroll
        for (int r = 0; r < 6; ++r) mk[r] = (mk[r] == bk) ? 0u : mk[r]; }
    const int i1 = 63 - (int)(fk[0] & 63u), i2 = 63 - (int)(fk[1] & 63u), i3 = 63 - (int)(fk[2] & 63u);
    TS_END(71); TS_BEGIN(72);
    const int nv = qb < 3 ? qb : 3;
    const int js[3] = {i1, i2, i3};
    if (hi == 0) {
#pragma unroll
        for (int s = 0; s < 3; ++s) if (s < nv) __hip_atomic_fetch_add(&cnt[js[s]], 1, __ATOMIC_RELAXED, __HIP_MEMORY_SCOPE_WORKGROUP);
    }
    __syncthreads();
    if (F.wave == 0) {
        const int c = cnt[F.lane]; int incl = c;
#pragma unroll
        for (int o = 1; o < 64; o <<= 1) { const int t = __shfl_up(incl, o); if (F.lane >= o) incl += t; }
        offs[F.lane + 1] = incl; cursor[F.lane] = incl - c; if (F.lane == 0) offs[0] = 0;
        OFFS[F.lane + 1] = (unsigned short)incl; if (F.lane == 0) OFFS[0] = 0;
        if (F.lane < qb && c > 0 && !F.probe) atomicAdd(&NTOT[F.lane], (unsigned)c);
    }
    __syncthreads();
    if (hi == 0) {
#pragma unroll
        for (int s = 0; s < 3; ++s) if (s < nv) { const int idx = __hip_atomic_fetch_add(&cursor[js[s]], 1, __ATOMIC_RELAXED, __HIP_MEMORY_SCOPE_WORKGROUP); ent[idx] = (unsigned short)(ql | (s << 8)); }
    }
    __syncthreads();
    const int tot = offs[64];
    for (int i = F.tid; i < tot; i += 512) ENT[i] = ent[i];
    __syncthreads();
    TS_END(72);
}

constexpr int P8_MAXSTEPS = 18;
constexpr int P8_OVH = 3;
constexpr size_t OWNP_OFF = 64 * MiB;
__device__ __forceinline__ void gathered_attention(Frame& F) {
    LAS int* PFX = (LAS int*)(F.lds + ATT_AUX); LAS int* NT = PFX + 1024; LAS int* wtot = NT + 1024;
    LAS int* ctr = wtot + 16; LAS int* qinfo = (LAS int*)(F.lds + ATT_AUX + 9216);
    const unsigned* NTOT = (const unsigned*)(F.ws + WS_CTL) + CW_NTOT;
    const bf16* QB = (const bf16*)(F.ws + WS_S0);
    unsigned char* PART = F.ws + WS_S3; unsigned char* OWNP = (unsigned char*)F.out + OWNP_OFF; float* LSE = (float*)(F.ws + WS_LSE);
    {
        const int n0 = (int)NTOT[2 * F.tid], n1 = (int)NTOT[2 * F.tid + 1]; const int s0 = ((n0 + 255) >> 8) + 1, s1 = ((n1 + 255) >> 8) + 1;
        const int e0 = 4 * s0 + P8_OVH, e1 = 4 * s1 + P8_OVH;
        NT[2 * F.tid] = n0; NT[2 * F.tid + 1] = n1;
        int incl = e0 + e1;
#pragma unroll
        for (int o = 1; o < 64; o <<= 1) { const int t = __shfl_up(incl, o); if (F.lane >= o) incl += t; }
        if (F.lane == 63) wtot[F.wave] = incl;
        __syncthreads();
        int off = 0;
#pragma unroll
        for (int w = 0; w < 8; ++w) off += (w < F.wave) ? wtot[w] : 0;
        PFX[2 * F.tid + 1] = off + incl; PFX[2 * F.tid] = off + incl - e1;
        __syncthreads();
    }
    const int V_tot = PFX[1023];
    const int v_lo = (int)(((long)F.vcu * V_tot) / F.G), v_hi = (int)(((long)(F.vcu + 1) * V_tot) / F.G);
    const int r32 = F.lane & 31, hi = F.lane >> 5;
    const int vbase = (int)(uintptr_t)(F.lds + VIMG) + v_rd_base(F.lane);
    int u; { int lo = 0, hi_ = 1023; while (lo < hi_) { const int mid = (lo + hi_) >> 1; if (PFX[mid] > v_lo) hi_ = mid; else lo = mid + 1; } u = lo; }
    int done = 0;
    while (u < 1024) {
        const int base = u ? PFX[u - 1] : 0; if (base >= v_hi) break;
        const int n = NT[u]; const int ns_g = (n + 255) >> 8, ns_u = ns_g + 1;
        int k_lo = (v_lo - base - P8_OVH + 3) >> 2; if (v_lo - base - P8_OVH + 3 < 0) k_lo = 0;
        int k_hi = (v_hi - base - P8_OVH + 3) >> 2; if (v_hi - base - P8_OVH + 3 < 0) k_hi = 0; if (k_hi > ns_u) k_hi = ns_u;
        k_lo += done;
        if (k_lo >= k_hi) { ++u; done = 0; continue; }
        int nsteps = k_hi - k_lo; bool more = false; if (nsteps > P8_MAXSTEPS) { nsteps = P8_MAXSTEPS; more = true; }
        const int ub = u >> 9, uh = (u >> 6) & 7, uj = u & 63;
        const bool own = (k_lo + nsteps == ns_u);
        const int ngs = nsteps - (own ? 1 : 0);
        TS_BEGIN(5);
        __syncthreads();
        {
            const bf16* KB = (const bf16*)(F.ws + WS_S1); const bf16* VB = (const bf16*)(F.ws + WS_S2);
            const size_t kvbase = ((size_t)ub * SEQ + (size_t)uj * BLK) * DM + uh * 128;
            v4u kr[8], vr[8];
#pragma unroll
            for (int it = 0; it < 8; ++it) { const int id = F.tid + 512 * it, row = id >> 4, c = id & 15;
                kr[it] = __builtin_nontemporal_load((const v4u*)(KB + kvbase + (size_t)row * DM + c * 8)); vr[it] = __builtin_nontemporal_load((const v4u*)(VB + kvbase + (size_t)row * DM + c * 8)); }
            int o0 = 0, o1 = 0;
            { const int qb = F.lane; if (qb > uj) { const unsigned short* OF = (const unsigned short*)(F.ws + WS_OFFS) + (size_t)((ub * NH + uh) * NBLK + qb) * OFFS_PITCH; o0 = OF[uj]; o1 = OF[uj + 1]; } }
            int cum = o1 - o0;
#pragma unroll
            for (int o = 1; o < 64; o <<= 1) { const int t = __shfl_up(cum, o); if (F.lane >= o) cum += t; }
            int e_end = 256 * (k_lo + ngs); if (e_end > n) e_end = n;
            const int nent = ngs > 0 ? e_end - 256 * k_lo : 0;
            for (int i0 = 0; i0 < ngs * 256; i0 += 512) { const int i = i0 + F.tid;
                int info = -1; const int e = 256 * k_lo + i; const bool ok = i < nent;
                int a = 0, c = 63;
#pragma unroll
                for (int it = 0; it < 6; ++it) { const int mid = (a + c) >> 1; const int cm = __shfl(cum, mid); if (cm > e) c = mid; else a = mid + 1; }
                const int qb = a; const int cprev = __shfl(cum, qb > 0 ? qb - 1 : 0); const int so = __shfl(o0, qb);
                if (ok) { const int idx = e - (qb ? cprev : 0);
                    const unsigned short en = ((const unsigned short*)(F.ws + WS_ENT))[(size_t)((ub * NH + uh) * NBLK + qb) * 768 + so + idx];
                    info = (qb * BLK + (en & 255)) | ((en >> 8) << 16); }
                if (i < ngs * 256) qinfo[i] = info; }
            if (own && F.tid < 256) qinfo[ngs * 256 + F.tid] = (uj * BLK + F.tid) | (3 << 16);
            if (F.tid == 0) ctr[0] = 0;
#pragma unroll
            for (int it = 0; it < 8; ++it) { const int id = F.tid + 512 * it, row = id >> 4, c = id & 15;
                *(LAS v4u*)(F.lds + KIMG + (row >> 6) * 16384 + KSWZ(row & 63, c * 16)) = kr[it];
                *(LAS v4u*)(F.lds + VIMG + (row >> 6) * 16384 + v_st(row & 63, c * 8)) = vr[it]; }
            __syncthreads();
            TS_END(5); TS_BEGIN(6);
            const int ntg = (nent + 31) >> 5;
            const int ntiles = ntg + (own ? 8 : 0);
            bf16x8 qa[8]; int ta;
#define P8_GRAB(T) do { int _t = 0; if (F.lane == 0) _t = __hip_atomic_fetch_add(ctr, 1, __ATOMIC_RELAXED, __HIP_MEMORY_SCOPE_WORKGROUP); T = __builtin_amdgcn_readfirstlane(_t); } while (0)
            P8_GRAB(ta);
            while (ta < ntiles) {
                const bool ownt = ta >= ntg; const int ot = ownt ? 7 - (ta - ntg) : 0;
                const int info = qinfo[ownt ? (ngs * 256 + 32 * ot + r32) : (32 * ta + r32)];
                const bool valid = info >= 0; const int pos = valid ? (info & 0xffff) : 0, slot = valid ? ((info >> 16) & 3) : 0; const size_t tok = (size_t)ub * SEQ + pos;
                { const bf16* qp = QB + tok * DM + uh * 128 + hi * 8;
#pragma unroll
                  for (int d0 = 0; d0 < 8; ++d0) qa[d0] = *(const bf16x8*)(qp + d0 * 16); }
                f32x16 o[4] = {}; float m = -1e30f, l = 0.f;
                const int tlast = ownt ? (ot >> 1) : 3;
                const int tfull = ownt ? tlast : 4;
#pragma unroll 1
                for (int t = 0; t < tfull; ++t) attn_subtile<false>(o, m, l, F.lds + KIMG + t * 16384, vbase + t * 16384, qa, r32, hi, 0, 0);
                if (ownt) attn_subtile<true>(o, m, l, F.lds + KIMG + tlast * 16384, vbase + tlast * 16384, qa, r32, hi, 64 * tlast, 32 * ot + r32);
                const float il = __builtin_amdgcn_rcpf(l);
                unsigned char* orow = ownt ? (OWNP + (tok * NH + uh) * 256) : (PART + ((tok * NH + uh) * 3 + slot) * 256);
                row_store_T(orow, o, il, hi, valid);
                if (valid && hi == 0) LSE[(tok * NH + uh) * 4 + slot] = m + __builtin_amdgcn_logf(l);
                P8_GRAB(ta);
            }
#undef P8_GRAB
            TS_END(6);
        }
        if (more) done += nsteps; else { ++u; done = 0; }
    }
    __syncthreads();
}

__device__ __forceinline__ void combine_phase(Frame& F) {
    const unsigned char* PART = F.ws + WS_S3; const unsigned char* OWNP = (const unsigned char*)F.out + OWNP_OFF; const float* LSE = (const float*)(F.ws + WS_LSE);
    const bf16* SG2 = (const bf16*)F.out; bf16* O = (bf16*)(F.ws + WS_S0);
    const long NIT = (long)T * NH * 16;
    for (long it = (long)F.vcu * 512 + F.tid; it < NIT; it += (long)F.G * 512) {
        const int c16 = (int)(it & 15); const long th = it >> 4;
        const int h = (int)(th & 7); const long tok = th >> 3; const int qb = (int)((tok & (SEQ - 1)) >> 8); const int nv = qb < 3 ? qb : 3;
        const f32x4 L4 = *(const f32x4*)(LSE + th * 4);
        const v4u po = __builtin_nontemporal_load((const v4u*)(OWNP + th * 256 + c16 * 16));
        v4u p0 = {0u, 0u, 0u, 0u}, p1 = p0, p2 = p0;
        if (nv > 0) p0 = __builtin_nontemporal_load((const v4u*)(PART + (th * 3 + 0) * 256 + c16 * 16));
        if (nv > 1) p1 = __builtin_nontemporal_load((const v4u*)(PART + (th * 3 + 1) * 256 + c16 * 16));
        if (nv > 2) p2 = __builtin_nontemporal_load((const v4u*)(PART + (th * 3 + 2) * 256 + c16 * 16));
        const v4u g = __builtin_nontemporal_load((const v4u*)(SG2 + tok * DM + h * 128 + c16 * 8));
        const float l0 = nv > 0 ? L4[0] : -1e30f, l1 = nv > 1 ? L4[1] : -1e30f, l2 = nv > 2 ? L4[2] : -1e30f, l3 = L4[3];
        const float M = fmaxf(fmaxf(l0, l1), fmaxf(l2, l3));
        const float w0 = fast_exp2(l0 - M), w1 = fast_exp2(l1 - M), w2 = fast_exp2(l2 - M), w3 = fast_exp2(l3 - M);
        const float inv = __builtin_amdgcn_rcpf((w0 + w1) + (w2 + w3));
        unsigned ow[4];
#pragma unroll
        for (int k = 0; k < 4; ++k) {
            const float a = (w0 * bflo(p0[k]) + w1 * bflo(p1[k])) + (w2 * bflo(p2[k]) + w3 * bflo(po[k]));
            const float bq = (w0 * bfhi(p0[k]) + w1 * bfhi(p1[k])) + (w2 * bfhi(p2[k]) + w3 * bfhi(po[k]));
            ow[k] = pk2(a * inv * bflo(g[k]), bq * inv * bfhi(g[k])); }
        const v4u ov = {ow[0], ow[1], ow[2], ow[3]};
        *(v4u*)(O + tok * DM + h * 128 + c16 * 8) = ov;
    }
}

constexpr int N_PHASES = 11;
__global__ void __launch_bounds__(512, 2) hawk_moba_fwd(Args args) {
    extern __shared__ __attribute__((aligned(16))) unsigned char lds_raw[];
    Frame F;
    F.lds = (LAS unsigned char*)lds_raw;
    F.tid = threadIdx.x; F.lane = F.tid & 63; F.wave = __builtin_amdgcn_readfirstlane(F.tid >> 6);
    F.G = gridDim.x; { const int bx = blockIdx.x; F.vcu = (F.G % 8 == 0) ? (bx % 8) * (F.G / 8) + bx / 8 : bx; }
    F.out = args.out; F.ws = args.ws; F.probe = false; F.tacc = 0ull; F.t0 = 0ull;
    volatile LAS unsigned* MISC = (volatile LAS unsigned*)(F.lds + MISC_OFF);
    if (F.tid < 64) MISC[F.tid] = 0u;
    __syncthreads();
    unsigned* ctl = (unsigned*)(F.ws + WS_CTL);
    XcdBarrier bar; bar.bar = ctl + CW_BAR; bar.x = 0; bar.st = nullptr;
    const int lo = args.ph_lo, hi = args.ph_hi;
    if (hi - lo > 1) bar = xcd_barrier_post(ctl + CW_BAR, MISC + 8);
#define IN(k) (lo <= (k) && (k) < hi)
#define SEAM(k) do { if (IN(k) && IN((k) + 1)) { TS_BEGIN(100 + (k)); xcd_barrier(bar); TS_END(100 + (k)); } } while (0)

#define RUN_GEMM(MODE, AOFF, BOFF, NN) do { \
        if ((MODE) == 0 || (MODE) == 2) {     \
            LAS float* rst = (LAS float*)(F.lds + pg8::STAGE_BYTES) + 2560; pg8::Unit uu; pg8::StaticOrder S0; S0.init(T, (NN), F.G, (int)blockIdx.x); \
            _Pragma("unroll") for (int i = 0; i < 8; ++i) { const bool okk = S0.next(i, uu); if (okk && F.tid < 256) { const int row = uu.pm * 256 + F.tid; float sc; \
                if ((MODE) == 0) sc = ((const float*)(F.ws + WS_RS0))[row]; \
                else { const f32x4* sp = (const f32x4*)((const float*)(F.ws + WS_SSQ1) + (size_t)row * 16); const f32x4 t4 = (sp[0] + sp[1]) + (sp[2] + sp[3]); sc = 1.0f / sqrtf(((t4[0] + t4[1]) + (t4[2] + t4[3])) * (1.0f / DM) + EPS); } \
                rst[i * 256 + F.tid] = sc; } } \
            __syncthreads(); } \
        { pg8::Gemm g{(const pg8::bf16_t*)(F.ws + (AOFF)), (const pg8::bf16_t*)(F.ws + (BOFF)), T, (NN), DM}; \
          pg8::EpiAll E{(MODE), F.ws, F.out, F.probe, (LAS float*)(F.lds + pg8::STAGE_BYTES)}; pg8::StaticOrder S; S.init(T, (NN), F.G, (int)blockIdx.x); \
          pg8::gemm_phase<pg8::EpiAll, pg8::StaticOrder, true, true>(F.lds, g, S, E, F.tacc); } } while (0)
    TS_BEGIN(200 + 0); if (IN(0)) { for (int rep = 0; rep < (MK_REPEAT == 0 ? 2 : 1); ++rep) { if (rep) xcd_barrier(bar); p0_prologue(F); } } TS_END(200 + 0); SEAM(0);
    TS_BEGIN(200 + 1); if (IN(1)) { RUN_GEMM(0, WS_S0, WS_WAIN, 2048); } TS_END(200 + 1); SEAM(1);
#if MK_REPEAT == 1
    TS_BEGIN(200 + 1); if (IN(1)) { RUN_GEMM(0, WS_S0, WS_WAIN, 2048); } TS_END(200 + 1); SEAM(1);
#endif
    TS_BEGIN(200 + 2); if (IN(2)) { for (int rep = 0; rep < (MK_REPEAT == 2 ? 2 : 1); ++rep) { if (rep) xcd_barrier(bar); for (int u = F.vcu; u < 1024; u += F.G) scan_unit(F, u >> 9, (u >> 3) & 63, u & 7); } } TS_END(200 + 2); SEAM(2);
    TS_BEGIN(200 + 3); if (IN(3)) { for (int rep = 0; rep < (MK_REPEAT == 3 ? 2 : 1); ++rep) { if (rep) xcd_barrier(bar); for (int u = F.vcu; u < 512; u += F.G) scan_apply_unit(F, u >> 8, u & 255); } } TS_END(200 + 3); SEAM(3);
    TS_BEGIN(200 + 4); if (IN(4)) { RUN_GEMM(1, WS_S0, WS_WAOUT, DM); } TS_END(200 + 4); SEAM(4);
#if MK_REPEAT == 4
    TS_BEGIN(200 + 4); if (IN(4)) { RUN_GEMM(1, WS_S0, WS_WAOUT, DM); } TS_END(200 + 4); SEAM(4);
#endif
    TS_BEGIN(200 + 5); if (IN(5)) { RUN_GEMM(2, WS_S6, WS_WB1, 4096); } TS_END(200 + 5); SEAM(5);
#if MK_REPEAT == 5
    TS_BEGIN(200 + 5); if (IN(5)) { RUN_GEMM(2, WS_S6, WS_WB1, 4096); } TS_END(200 + 5); SEAM(5);
#endif
    TS_BEGIN(200 + 7); if (IN(7)) { for (int rep = 0; rep < (MK_REPEAT == 7 ? 2 : 1); ++rep) { if (rep) xcd_barrier(bar); F.probe = (MK_REPEAT == 7 && rep == 0); { f32x4 km[4]; bf16x8 qr[8]; int u = F.vcu; while (u < 1024 && (u & 63) == 0) u += F.G;     if (u < 1024) select_loads(F, u >> 9, (u >> 6) & 7, u & 63, km, qr); while (u < 1024) { int un = u + F.G; while (un < 1024 && (un & 63) == 0) un += F.G; const bool hn = un < 1024; select_unit(F, u >> 9, (u >> 6) & 7, u & 63, km, qr, hn ? (un >> 9) : 0, hn ? ((un >> 6) & 7) : 0, hn ? (un & 63) : -1); u = un; } } } } TS_END(200 + 7); SEAM(7);
    TS_BEGIN(200 + 8); if (IN(8)) { for (int rep = 0; rep < (MK_REPEAT == 8 ? 2 : 1); ++rep) { if (rep) xcd_barrier(bar); gathered_attention(F); } } TS_END(200 + 8); SEAM(8);
    TS_BEGIN(200 + 9); if (IN(9)) { for (int rep = 0; rep < (MK_REPEAT == 9 ? 2 : 1); ++rep) { if (rep) xcd_barrier(bar); F.probe = (MK_REPEAT == 9 && rep == 0); combine_phase(F); } } TS_END(200 + 9); SEAM(9);
#if MK_REPEAT == 20
    if (hi - lo > 1) { for (int i = 0; i < 10; ++i) xcd_barrier(bar); }
#endif
#if MK_REPEAT == 10
    if (IN(10)) { F.probe = true; RUN_GEMM(3, WS_S0, WS_WBOUT, DM); F.probe = false; xcd_barrier(bar); }
#endif
    TS_BEGIN(210); if (IN(10)) { RUN_GEMM(3, WS_S0, WS_WBOUT, DM); }
#undef RUN_GEMM
#undef IN
#undef SEAM
    if (MK_STAMP != 0) {
        unsigned long long* mx = (unsigned long long*)(ctl + 32768);
        if (F.tid == 0) atomicMax(mx, F.tacc);
        xcd_barrier(bar);
        if (blockIdx.x == 0 && F.tid == 0) { const unsigned long long tw = __hip_atomic_load(mx, __ATOMIC_RELAXED, __HIP_MEMORY_SCOPE_AGENT);
            const unsigned long long t0 = __builtin_amdgcn_s_memrealtime(); while (__builtin_amdgcn_s_memrealtime() - t0 < tw) __builtin_amdgcn_s_sleep(4); }
    }
}

extern "C" void kernel_launch(void* const* d_in, const int* in_sizes, int n_in, void* d_out, int out_size, void* d_ws, size_t ws_size, hipStream_t stream) {
    static int grid = 0;
    if (grid == 0) {
        if (n_in != 18 || in_sizes[0] != T * DM || out_size != T * DM || ws_size < WS_END) { fprintf(stderr, "kernel_launch: unexpected shapes (n_in %d, in0 %d, out %d, ws %zu < %zu)\n", n_in, n_in > 0 ? in_sizes[0] : -1, out_size, ws_size, (size_t)WS_END); grid = -1; return; }
        int dev = 0, cus = 0, per_cu = 0;
        if (hipGetDevice(&dev) != hipSuccess || hipDeviceGetAttribute(&cus, hipDeviceAttributeMultiprocessorCount, dev) != hipSuccess) { grid = -1; return; }
        if (hipFuncSetAttribute((const void*)hawk_moba_fwd, hipFuncAttributeMaxDynamicSharedMemorySize, LDS_BYTES) != hipSuccess) { fprintf(stderr, "kernel_launch: hipFuncSetAttribute failed\n"); grid = -1; return; }
        if (hipOccupancyMaxActiveBlocksPerMultiprocessor(&per_cu, (const void*)hawk_moba_fwd, 512, LDS_BYTES) != hipSuccess || per_cu < 1) { fprintf(stderr, "kernel_launch: occupancy query says %d blocks per CU\n", per_cu); (void)hipGetLastError(); grid = -1; return; }
        grid = cus;
    }
    if (grid < 0) return;
    (void)hipMemsetAsync((char*)d_ws + WS_CTL, 0, CTL_ZERO_BYTES, stream);
    Args a{};
    for (int i = 0; i < 18; ++i) a.in[i] = (const float*)d_in[i];
    a.out = (float*)d_out; a.ws = (unsigned char*)d_ws;
#if MK_N_LAUNCHES == 1
    a.ph_lo = 0; a.ph_hi = N_PHASES;
    hipLaunchKernelGGL(hawk_moba_fwd, dim3(grid), dim3(512), LDS_BYTES, stream, a);
#else
    for (int p = 0; p <= MK_LAST_PHASE; ++p) { a.ph_lo = p; a.ph_hi = p + 1; hipLaunchKernelGGL(hawk_moba_fwd, dim3(grid), dim3(512), LDS_BYTES, stream, a); }
#endif
}
```

```cpp
#include <hip/hip_runtime.h>
#include <cstdio>
#include <cstdint>

#ifndef MK_N_LAUNCHES
#define MK_N_LAUNCHES 1
#endif
#ifndef MK_PHMASK
#define MK_PHMASK 0x7ff
#endif
#ifndef MK_REPEAT
#define MK_REPEAT (-1)
#endif
#ifndef MK_STAMP
#define MK_STAMP 0
#endif
#ifndef MK_STAGGER
#define MK_STAGGER 0
#endif
#ifndef MK_LAST_PHASE
#define MK_LAST_PHASE 10
#endif

namespace pg8 {
#define PG8_LAS __attribute__((address_space(3)))
typedef unsigned short bf16_t;
typedef short bf16x8 __attribute__((ext_vector_type(8)));
typedef float f32x4 __attribute__((ext_vector_type(4)));
typedef unsigned u32x4 __attribute__((ext_vector_type(4)));
typedef unsigned u32x2 __attribute__((ext_vector_type(2)));
constexpr int BM = 256, BK = 64, HALF = 128, HTB = HALF * BK * 2, STAGE_BYTES = 8 * HTB, NXCD = 8, WGM = 8;

__host__ __device__ __forceinline__ int lds_byte(int r, int c) { const int st = (r >> 4) * 2 + (c >> 5), rr = r & 15, cc = c & 31, ob = rr * 64 + cc * 2; return st * 1024 + (ob ^ (((ob >> 9) & 1) << 5)); }
__host__ __device__ __forceinline__ void stage_rc(int b, int& R, int& C) { const int st = b / 1024, sb = b % 1024, swz = sb ^ (((sb >> 9) & 1) << 5); R = (st >> 1) * 16 + swz / 64; C = (st & 1) * 32 + (swz % 64) / 2; }
__host__ __device__ __forceinline__ int perm32(int rho) { const int n = rho >> 4, i = rho & 15; return 8 * (i >> 2) + 4 * n + (i & 3); }

struct Unit { int pm, pn; };
struct Gemm { const bf16_t* A; const bf16_t* Bt; int M, N, K; };

struct StaticOrder {
    int nM, nN, nwg, G, c;
    __host__ __device__ void init(int M, int N, int G_, int c_) { nM = M / BM; nN = N / BM; nwg = nM * nN; G = G_; c = c_; }
    __host__ __device__ __forceinline__ bool next(int i, Unit& u) const {
        const long L = (long)i * G + c; if (L >= nwg) return false;
        int wgid = (int)L; { const int q = nwg / NXCD, r = nwg % NXCD, xcd = wgid % NXCD, off = wgid / NXCD; wgid = (xcd < r ? xcd * (q + 1) : r * (q + 1) + (xcd - r) * q) + off; }
        const int nig = WGM * nN, gid = wgid / nig, fm = gid * WGM, gsz = (nM - fm) < WGM ? (nM - fm) : WGM;
        u.pm = fm + ((wgid % nig) % gsz); u.pn = (wgid % nig) / gsz; return true;
    }
    __device__ __forceinline__ void a_ready(const Unit&) const {}
    __device__ __forceinline__ void done(const Unit&) const {}
};

__device__ __forceinline__ unsigned cvt_pk_bf16(float lo, float hi) { unsigned r; asm volatile("v_cvt_pk_bf16_f32 %0, %1, %2" : "=v"(r) : "v"(lo), "v"(hi)); return r; }

template <class Epi, class Sched, bool ALIGN_EPI = false, bool SP2 = false>
__device__ __forceinline__ void gemm_phase(PG8_LAS unsigned char* lds, const Gemm g, const Sched& S, const Epi& E, unsigned long long& tacc) {
    const int tid = threadIdx.x, wid = __builtin_amdgcn_readfirstlane(tid >> 6), lane = tid & 63, wr = wid >> 2, wc = wid & 3, fr = lane & 15, fq = lane >> 4;
    const int K = g.K, nt = K / BK;
    unsigned voffA[2], voffB[2];
#pragma unroll
    for (int i = 0; i < 2; ++i) { int R, C; stage_rc(tid * 16 + i * 8192, R, C); const int Rb = Epi::PERM ? ((R & ~31) + perm32(R & 31)) : R;
        voffA[i] = (unsigned)(R * K + C) * 2u; voffB[i] = (unsigned)(Rb * K + C) * 2u; }
    const size_t kstep = (size_t)(BK * 2);
    const size_t hstep = (size_t)HALF * K * 2;
    const size_t tstep = 2 * hstep;
    const unsigned ldsw = (unsigned)wid * 1024u;
    const int aoff = lds_byte(wr * 64 + fr, fq * 8), boff = lds_byte(wc * 32 + fr, fq * 8);
#define PG8_SA(b, h) (((b) * 2 + (h)) * HTB)
#define PG8_SB(b, h) ((4 + (b) * 2 + (h)) * HTB)
#define PG8_STAGE(bufoff, gbase, voff) do { _Pragma("unroll") for (int _i = 0; _i < 2; ++_i) \
        __builtin_amdgcn_global_load_lds((const unsigned*)((const char*)(gbase) + (voff)[_i]), (PG8_LAS unsigned*)(lds + (bufoff) + ldsw + _i * 8192), 16, 0, 0); } while (0)
#define PG8_LDA(dst, b, h) do { _Pragma("unroll") for (int m = 0; m < 4; ++m) _Pragma("unroll") for (int k = 0; k < 2; ++k) dst[m][k] = *(const PG8_LAS bf16x8*)(lds + PG8_SA(b, h) + aoff + m * 2048 + k * 1024); } while (0)
#define PG8_LDB(dst, b, h) do { _Pragma("unroll") for (int n = 0; n < 2; ++n) _Pragma("unroll") for (int k = 0; k < 2; ++k) dst[n][k] = *(const PG8_LAS bf16x8*)(lds + PG8_SB(b, h) + boff + n * 2048 + k * 1024); } while (0)
#define PG8_MMA(ai, bj, At, Bt) do { __builtin_amdgcn_s_setprio(1); _Pragma("unroll") for (int m = 0; m < 4; ++m) _Pragma("unroll") for (int n = 0; n < 2; ++n) _Pragma("unroll") for (int k = 0; k < 2; ++k) \
        acc[ai][bj][m][n] = __builtin_amdgcn_mfma_f32_16x16x32_bf16(Bt[n][k], At[m][k], acc[ai][bj][m][n], 0, 0, 0); __builtin_amdgcn_s_setprio(0); } while (0)
#define PG8_WAIT_V(n) asm volatile("s_waitcnt vmcnt(" #n ")" ::: "memory")
#define PG8_WAIT_L(n) asm volatile("s_waitcnt lgkmcnt(" #n ")" ::: "memory")
#define PG8_BAR __builtin_amdgcn_s_barrier()
#define PG8_SCHED __builtin_amdgcn_sched_barrier(0)
    Unit cur, nxt; int ui = 0;
    if (!S.next(0, cur)) return;
    f32x4 acc[2][2][4][2];
#pragma unroll
    for (int a = 0; a < 2; ++a)
#pragma unroll
        for (int b = 0; b < 2; ++b)
#pragma unroll
            for (int m = 0; m < 4; ++m)
#pragma unroll
                for (int n = 0; n < 2; ++n) acc[a][b][m][n] = (f32x4){0.f, 0.f, 0.f, 0.f};
    bf16x8 At[4][2], B0[2][2], B1[2][2];
    const char* cA = (const char*)g.A + (size_t)cur.pm * tstep; const char* cB = (const char*)g.Bt + (size_t)cur.pn * tstep;
    S.a_ready(cur);
    if constexpr (SP2) {
        PG8_STAGE(PG8_SB(0, 0), cB, voffB); PG8_STAGE(PG8_SB(0, 1), cB + hstep, voffB); PG8_STAGE(PG8_SA(0, 0), cA, voffA); PG8_STAGE(PG8_SA(0, 1), cA + hstep, voffA);
        if (wr == 1) PG8_BAR;
        PG8_WAIT_V(2); PG8_BAR;
        PG8_STAGE(PG8_SB(1, 0), cB + kstep, voffB); PG8_STAGE(PG8_SA(1, 0), cA + kstep, voffA); PG8_STAGE(PG8_SB(1, 1), cB + hstep + kstep, voffB);
        PG8_WAIT_V(6); PG8_BAR;
    } else {
        PG8_STAGE(PG8_SB(0, 0), cB, voffB); PG8_STAGE(PG8_SA(0, 0), cA, voffA); PG8_STAGE(PG8_SB(0, 1), cB + hstep, voffB); PG8_STAGE(PG8_SA(0, 1), cA + hstep, voffA);
        if (wr == 1) PG8_BAR;
        PG8_WAIT_V(4); PG8_BAR;
        PG8_STAGE(PG8_SB(1, 0), cB + kstep, voffB); PG8_STAGE(PG8_SA(1, 0), cA + kstep, voffA); PG8_STAGE(PG8_SB(1, 1), cB + hstep + kstep, voffB);
        PG8_WAIT_V(6); PG8_BAR;
    }
    for (;;) {
        const bool has_next = S.next(ui + 1, nxt);
        const char* nA = has_next ? (const char*)g.A + (size_t)nxt.pm * tstep : cA; const char* nB = has_next ? (const char*)g.Bt + (size_t)nxt.pn * tstep : cB;
        for (int t = 0; t < nt; t += 2) {
            const bool last = (t == nt - 2);
            const char* a1 = cA + (size_t)(t + 1) * kstep;
            const char* a2 = last ? nA : cA + (size_t)(t + 2) * kstep; const char* b2 = last ? nB : cB + (size_t)(t + 2) * kstep;
            const char* a3 = a2 + kstep; const char* b3 = b2 + kstep;
            if (last && has_next) S.a_ready(nxt);
            if constexpr (SP2) {
            PG8_LDB(B0, 0, 0); PG8_LDB(B1, 0, 1); PG8_SCHED; PG8_LDA(At, 0, 0); PG8_STAGE(PG8_SA(1, 1), a1 + hstep, voffA);
            PG8_WAIT_V(8); PG8_WAIT_L(0); PG8_BAR; PG8_MMA(0, 0, At, B0); PG8_MMA(0, 1, At, B1); PG8_BAR; PG8_SCHED;
            PG8_LDA(At, 0, 1); PG8_STAGE(PG8_SB(0, 0), b2, voffB); PG8_STAGE(PG8_SB(0, 1), b2 + hstep, voffB); PG8_STAGE(PG8_SA(0, 0), a2, voffA);
            PG8_WAIT_V(8); PG8_WAIT_L(0); PG8_BAR; PG8_MMA(1, 0, At, B0); PG8_MMA(1, 1, At, B1); PG8_BAR; PG8_SCHED;
            PG8_LDB(B0, 1, 0); PG8_LDB(B1, 1, 1); PG8_SCHED; PG8_LDA(At, 1, 0); PG8_STAGE(PG8_SA(0, 1), a2 + hstep, voffA);
            PG8_WAIT_V(8); PG8_WAIT_L(0); PG8_BAR; PG8_MMA(0, 0, At, B0); PG8_MMA(0, 1, At, B1); PG8_BAR; PG8_SCHED;
            PG8_LDA(At, 1, 1); PG8_STAGE(PG8_SB(1, 0), b3, voffB); PG8_STAGE(PG8_SB(1, 1), b3 + hstep, voffB); PG8_STAGE(PG8_SA(1, 0), a3, voffA);
            PG8_WAIT_V(8); PG8_WAIT_L(0); PG8_BAR; PG8_MMA(1, 0, At, B0); PG8_MMA(1, 1, At, B1); PG8_BAR; PG8_SCHED;
            } else {
            PG8_LDB(B0, 0, 0); PG8_SCHED; PG8_LDA(At, 0, 0); PG8_STAGE(PG8_SA(1, 1), a1 + hstep, voffA);
            PG8_WAIT_L(8); PG8_BAR; PG8_WAIT_L(0); PG8_MMA(0, 0, At, B0); PG8_BAR; PG8_SCHED;
            PG8_LDB(B1, 0, 1); PG8_STAGE(PG8_SB(0, 0), b2, voffB);
            PG8_BAR; PG8_WAIT_L(0); PG8_MMA(0, 1, At, B1); PG8_BAR;
            PG8_LDA(At, 0, 1); PG8_STAGE(PG8_SA(0, 0), a2, voffA);
            PG8_BAR; PG8_WAIT_L(0); PG8_MMA(1, 0, At, B0); PG8_BAR; PG8_SCHED;
            PG8_STAGE(PG8_SB(0, 1), b2 + hstep, voffB);
            PG8_WAIT_V(6); PG8_BAR; PG8_MMA(1, 1, At, B1); PG8_BAR;
            PG8_LDB(B0, 1, 0); PG8_SCHED; PG8_LDA(At, 1, 0); PG8_STAGE(PG8_SA(0, 1), a2 + hstep, voffA);
            PG8_WAIT_L(8); PG8_BAR; PG8_WAIT_L(0); PG8_MMA(0, 0, At, B0); PG8_BAR; PG8_SCHED;
            PG8_LDB(B1, 1, 1); PG8_STAGE(PG8_SB(1, 0), b3, voffB);
            PG8_BAR; PG8_WAIT_L(0); PG8_MMA(0, 1, At, B1); PG8_BAR;
            PG8_LDA(At, 1, 1); PG8_STAGE(PG8_SA(1, 0), a3, voffA);
            PG8_BAR; PG8_WAIT_L(0); PG8_MMA(1, 0, At, B0); PG8_BAR; PG8_SCHED;
            PG8_STAGE(PG8_SB(1, 1), b3 + hstep, voffB);
            PG8_WAIT_V(6); PG8_BAR; PG8_MMA(1, 1, At, B1); PG8_BAR;
            }
        }
        unsigned long long _t0 = 0; if (MK_STAMP == 31) _t0 = __builtin_amdgcn_s_memrealtime();
        if constexpr (ALIGN_EPI) { if (wr == 0) PG8_BAR; }
        if (MK_STAMP == 31) tacc += __builtin_amdgcn_s_memrealtime() - _t0;
        if (MK_STAMP == 30 || MK_STAMP == 32) _t0 = __builtin_amdgcn_s_memrealtime();
        E(acc, cur, wr, wc, fr, fq, ui); S.done(cur);
        if (MK_STAMP == 30) { asm volatile("s_waitcnt vmcnt(0)" ::: "memory"); tacc += __builtin_amdgcn_s_memrealtime() - _t0; }
        if (MK_STAMP == 32) tacc += __builtin_amdgcn_s_memrealtime() - _t0;
        if (!has_next) break;
#pragma unroll
        for (int a = 0; a < 2; ++a)
#pragma unroll
            for (int b = 0; b < 2; ++b)
#pragma unroll
                for (int m = 0; m < 4; ++m)
#pragma unroll
                    for (int n = 0; n < 2; ++n) acc[a][b][m][n] = (f32x4){0.f, 0.f, 0.f, 0.f};
        cur = nxt; cA = nA; cB = nB; ++ui;
        if constexpr (ALIGN_EPI) { if (wr == 1) PG8_BAR; }
    }
    PG8_WAIT_V(0);
    if constexpr (!ALIGN_EPI) { if (wr == 0) PG8_BAR; }
    PG8_BAR;
#undef PG8_SA
#undef PG8_SB
#undef PG8_STAGE
#undef PG8_LDA
#undef PG8_LDB
#undef PG8_MMA
#undef PG8_WAIT_V
#undef PG8_WAIT_L
#undef PG8_BAR
#undef PG8_SCHED
}
}

constexpr int NBATCH = 2, SEQ = 16384, T = NBATCH * SEQ, DM = 1024, NH = 8, HD = 128, NBLK = 64, BLK = 256;
constexpr float EPS = 1e-6f;
constexpr float QSCALE = 0.088388347648318440f * 1.4426950408889634f;

constexpr size_t MiB = 1u << 20;
constexpr size_t WS_CTL = 0, CTL_ZERO_BYTES = 1 * MiB;
constexpr size_t WS_WAIN = 2 * MiB, WS_WAOUT = 6 * MiB, WS_WB1 = 8 * MiB, WS_WBOUT = 16 * MiB, WS_WRG = 18 * MiB;
constexpr size_t WS_RS0 = 19 * MiB;
constexpr size_t WS_SSQ1 = 20 * MiB;
constexpr size_t WS_ROPE = 22 * MiB;
constexpr size_t WS_SUMA = 30 * MiB, WS_SUMB = 30 * MiB + 512 * 1024;
constexpr size_t WS_KMEAN = 31 * MiB;
constexpr size_t WS_ENT = 32 * MiB;
constexpr size_t WS_OFFS = 34 * MiB;
constexpr size_t WS_LSE = 36 * MiB;
constexpr size_t WS_SEGA = 44 * MiB, WS_SEGB = 46 * MiB;
constexpr size_t SLOT = 64 * MiB;
constexpr size_t WS_S0 = 1 * SLOT;
constexpr size_t WS_S1 = 2 * SLOT;
constexpr size_t WS_S2 = 3 * SLOT;
constexpr size_t WS_S3 = 4 * SLOT;
constexpr size_t WS_S6 = 7 * SLOT;
constexpr size_t WS_END = 8 * SLOT;
constexpr int OFFS_PITCH = 72;
constexpr int CW_BAR = 4096;
constexpr int CW_NTOT = 16384;

constexpr int LDS_BYTES = 163840;
constexpr int MISC_OFF = LDS_BYTES - 256;

#define GAS __attribute__((address_space(1)))
#define LAS __attribute__((address_space(3)))
typedef unsigned short bf16;
typedef unsigned v4u __attribute__((ext_vector_type(4)));
typedef unsigned v2u __attribute__((ext_vector_type(2)));
typedef float f32x4 __attribute__((ext_vector_type(4)));
typedef float f32x16 __attribute__((ext_vector_type(16)));
typedef short bf16x8 __attribute__((ext_vector_type(8)));
typedef short s16x4 __attribute__((ext_vector_type(4)));
#define LDS_WAIT() asm volatile("s_waitcnt lgkmcnt(0)" ::: "memory")
#define VM_WAIT() asm volatile("s_waitcnt vmcnt(0)" ::: "memory")
#define SBAR() __builtin_amdgcn_sched_barrier(0)

__device__ __forceinline__ unsigned f2bf(float f) { unsigned u = __builtin_bit_cast(unsigned, f); return (u + 0x7fffu + ((u >> 16) & 1u)) >> 16; }
__device__ __forceinline__ unsigned pk2(float lo, float hi) { return pg8::cvt_pk_bf16(lo, hi); }
__device__ __forceinline__ float bflo(unsigned w) { return __builtin_bit_cast(float, w << 16); }
__device__ __forceinline__ float bfhi(unsigned w) { return __builtin_bit_cast(float, w & 0xffff0000u); }
__device__ __forceinline__ float bf1(unsigned short h) { return __builtin_bit_cast(float, ((unsigned)h) << 16); }
__device__ __forceinline__ float fast_exp2(float x) { return __builtin_amdgcn_exp2f(x); }
__device__ __forceinline__ float sigmoidf_(float v) { return __builtin_amdgcn_rcpf(1.f + fast_exp2(-v * 1.4426950408889634f)); }
__device__ __forceinline__ float siluf_(float v) { return v * sigmoidf_(v); }

#define XB_TMO      128
#define XB_XCNT(j)  (256  + 64 * (j))
#define XB_XSUB(j)  (1280 + 64 * (j))
#define XB_XGEN(j)  (2304 + 64 * (j))
#define XB_TOP      3328
#define XB_TOPGEN   3392
#define XCD_BAR_WORDS 3456
#define XB_SPIN_CAP (1u << 20)
__device__ __forceinline__ unsigned xb_ld(unsigned* p)              { return __hip_atomic_load(p, __ATOMIC_RELAXED, __HIP_MEMORY_SCOPE_AGENT); }
__device__ __forceinline__ unsigned xb_add(unsigned* p, unsigned v) { return __hip_atomic_fetch_add(p, v, __ATOMIC_RELAXED, __HIP_MEMORY_SCOPE_AGENT); }
__device__ __forceinline__ unsigned xb_xcc_id() { return (unsigned)__builtin_amdgcn_s_getreg((3 << 11) | 20) & 0xFu; }
#define XB_SPIN(cond, bar) do { unsigned _sp = 0; while (cond) { __builtin_amdgcn_s_sleep(1); \
    if ((++_sp & 255u) == 0u) { if (xb_ld(&(bar)[XB_TMO])) break; if (_sp > XB_SPIN_CAP) { atomicAdd(&(bar)[XB_TMO], 1u); break; } } } } while (0)
struct XcdBarrier { unsigned* bar; unsigned x; volatile LAS unsigned* st; };
__device__ __forceinline__ XcdBarrier xcd_barrier_post(unsigned* bar, volatile LAS unsigned* st) {
    XcdBarrier b; b.bar = bar; b.x = xb_xcc_id(); b.st = st;
    if (threadIdx.x == 0) (void)xb_add(&bar[XB_XCNT(b.x)], 1u);
    return b;
}
__device__ __forceinline__ void xcd_barrier_complete(unsigned* bar, unsigned x, unsigned& nloc, unsigned& nx) {
    const unsigned G = gridDim.x * gridDim.y * gridDim.z;
    unsigned sum, cnt, mine, sp = 0u;
    for (;;) {
        sum = 0u; cnt = 0u; mine = 0u;
#pragma unroll
        for (unsigned j = 0; j < 16; ++j) { const unsigned c = xb_ld(&bar[XB_XCNT(j)]); sum += c; cnt += (c > 0u) ? 1u : 0u; mine = (j == x) ? c : mine; }
        if (sum == G) break;
        __builtin_amdgcn_s_sleep(1);
        if ((++sp & 255u) == 0u) { if (xb_ld(&bar[XB_TMO])) break; if (sp > XB_SPIN_CAP) { atomicAdd(&bar[XB_TMO], 1u); break; } }
    }
    nloc = mine > 0u ? mine : 1u; nx = cnt > 0u ? cnt : 1u;
}
__device__ __forceinline__ void xcd_barrier(const XcdBarrier& b) {
    asm volatile("s_waitcnt vmcnt(0)" ::: "memory");
    __syncthreads();
    if (threadIdx.x == 0) {
        unsigned* bar = b.bar;
        __builtin_amdgcn_s_waitcnt(0);
        unsigned nloc = b.st[0], nx = b.st[1];
        if (nloc == 0u) { xcd_barrier_complete(bar, b.x, nloc, nx); b.st[0] = nloc; b.st[1] = nx; }
        const unsigned old = xb_add(&bar[XB_XSUB(b.x)], 1u);
        const unsigned gen = old / nloc;
        if (old + 1u == (gen + 1u) * nloc) {
            __builtin_amdgcn_fence(__ATOMIC_RELEASE, "agent");
            asm volatile("s_waitcnt vmcnt(0)" ::: "memory");
            const unsigned og = xb_add(&bar[XB_TOP], 1u);
            const unsigned tg = og / nx;
            if (og + 1u == (tg + 1u) * nx) xb_add(&bar[XB_TOPGEN], 1u);
            else XB_SPIN(xb_ld(&bar[XB_TOPGEN]) == tg, bar);
            __builtin_amdgcn_fence(__ATOMIC_ACQUIRE, "agent");
            xb_add(&bar[XB_XGEN(b.x)], 1u);
            asm volatile("s_waitcnt vmcnt(0)" ::: "memory");
        } else {
            XB_SPIN(xb_ld(&bar[XB_XGEN(b.x)]) == gen, bar);
            __builtin_amdgcn_fence(__ATOMIC_ACQUIRE, "agent");
            asm volatile("s_waitcnt vmcnt(0)" ::: "memory");
        }
    }
    __syncthreads();
}

struct Args { const float* in[18]; float* out; unsigned char* ws; int ph_lo, ph_hi; };
__device__ __forceinline__ const float* inp(int k) {
    const __attribute__((address_space(4))) Args* ap = (const __attribute__((address_space(4))) Args*)__builtin_amdgcn_kernarg_segment_ptr();
    asm volatile("" : "+s"(ap));
    return ap->in[k];
}
struct Frame {
    LAS unsigned char* lds;
    int tid, lane, wave, vcu, G;
    unsigned long long tacc, t0;
    bool probe;
    float* out;
    unsigned char* ws;
};
#define TS_BEGIN(ID) do { if (MK_STAMP == (ID)) F.t0 = __builtin_amdgcn_s_memrealtime(); } while (0)
#define TS_END(ID) do { if (MK_STAMP == (ID)) F.tacc += __builtin_amdgcn_s_memrealtime() - F.t0; } while (0)
__device__ __forceinline__ float wave_sum(float v) {
#pragma unroll
    for (int o = 1; o < 64; o <<= 1) v += __shfl_xor(v, o);
    return v;
}

namespace pg8 {
struct EpiAll {
    static constexpr bool PERM = true, AFTER_DRAIN = false;
    int mode;
    unsigned char* ws;
    float* xout;
    bool probe;
    PG8_LAS float* ex;
    __device__ __forceinline__ void operator()(const f32x4 (&acc)[2][2][4][2], const Unit& u, int wr, int wc, int fr, int fq, int ui) const {
        const PG8_LAS float* const rst = ex + 2560 + ui * 256 + wr * 64 + fr;
        const int row0 = u.pm * BM + wr * 64 + fr;
        bf16_t* const o0 = (bf16_t*)(ws + (mode == 1 ? WS_S6 : WS_S1)); bf16_t* const o1 = (bf16_t*)(ws + WS_S2); bf16_t* const o2 = (bf16_t*)(ws + WS_S0); bf16_t* const o3 = (bf16_t*)xout;
        const float* const rs = (const float*)(ws + (mode == 0 ? WS_RS0 : WS_SSQ1)); float* const ssq = (float*)(ws + WS_SSQ1);
        if (mode == 2 && ((u.pn >> 2) == 0 || (u.pn >> 2) == 2)) {
            const bool isK = (u.pn >> 2) == 0;
            const float* G = isK ? inp(13) : inp(16); const float osc = isK ? 1.0f : QSCALE;
            const int i0 = 16 * wc + 4 * fq;
            const f32x4 glo = *(const f32x4*)(G + i0), ghi = *(const f32x4*)(G + 64 + i0);
            const float* RC = (const float*)(ws + WS_ROPE); const float* RSn = RC + (size_t)SEQ * 64;
            bf16_t* base = isK ? o0 : o2; const int col0 = (u.pn & 3) * BM + wc * 32 + 8 * fq;
            PG8_LAS float* SS = ex; PG8_LAS float* KM = ex + 2048;
            float rsv[8];
#pragma unroll
            for (int i = 0; i < 8; ++i) rsv[i] = rst[(i >> 2) * 128 + (i & 3) * 16];
#pragma unroll
            for (int ai = 0; ai < 2; ++ai)
#pragma unroll
                for (int m = 0; m < 4; ++m) { const float sc = rsv[ai * 4 + m];
#pragma unroll
                    for (int bj = 0; bj < 2; ++bj) { const f32x4 v0 = acc[ai][bj][m][0] * sc, v1 = acc[ai][bj][m][1] * sc;
                        float ss = ((v0[0] * v0[0] + v0[1] * v0[1]) + (v0[2] * v0[2] + v0[3] * v0[3])) + ((v1[0] * v1[0] + v1[1] * v1[1]) + (v1[2] * v1[2] + v1[3] * v1[3]));
                        ss += __shfl_xor(ss, 16); ss += __shfl_xor(ss, 32);
                        if (fq == 0) SS[((wr * 128 + ai * 64 + m * 16 + fr) * 2 + bj) * 4 + wc] = ss; } }
            asm volatile("s_waitcnt lgkmcnt(0)" ::: "memory"); __builtin_amdgcn_s_barrier(); asm volatile("" ::: "memory");
            float cs[2][8];
#pragma unroll
            for (int bj = 0; bj < 2; ++bj)
#pragma unroll
                for (int e = 0; e < 8; ++e) cs[bj][e] = 0.f;
#pragma unroll
            for (int ai = 0; ai < 2; ++ai) {
                f32x4 csv[4], snv[4];
#pragma unroll
                for (int i = 0; i < 4; ++i) { const int pos = (row0 + ai * HALF + i * 16) & (SEQ - 1); csv[i] = *(const f32x4*)(RC + (size_t)pos * 64 + i0); snv[i] = *(const f32x4*)(RSn + (size_t)pos * 64 + i0); }
#pragma unroll
                for (int m = 0; m < 4; ++m) { const int row = row0 + ai * HALF + m * 16;
                    const f32x4 cs4 = csv[m], sn4 = snv[m];
                    bf16_t* rowp = base + (size_t)row * DM + col0;
#pragma unroll
                    for (int bj = 0; bj < 2; ++bj) { const f32x4 pt = *(const PG8_LAS f32x4*)&SS[((wr * 128 + ai * 64 + m * 16 + fr) * 2 + bj) * 4];
                        const float tot = (pt[0] + pt[1]) + (pt[2] + pt[3]);
                        const float rinv = (1.0f / sqrtf(tot * (1.0f / HD) + EPS)) * rsv[ai * 4 + m];
                        f32x4 o1, o2;
#pragma unroll
                        for (int e = 0; e < 4; ++e) { const float x1 = acc[ai][bj][m][0][e] * rinv * glo[e], x2 = acc[ai][bj][m][1][e] * rinv * ghi[e];
                            o1[e] = (x1 * cs4[e] - x2 * sn4[e]) * osc; o2[e] = (x2 * cs4[e] + x1 * sn4[e]) * osc; cs[bj][e] += o1[e]; cs[bj][4 + e] += o2[e]; }
                        u32x4 w; w.x = cvt_pk_bf16(o1[0], o1[1]); w.y = cvt_pk_bf16(o1[2], o1[3]); w.z = cvt_pk_bf16(o2[0], o2[1]); w.w = cvt_pk_bf16(o2[2], o2[3]);
                        *(u32x4*)(rowp + bj * HALF) = w; } }
            }
            if (isK) {
#pragma unroll
                for (int bj = 0; bj < 2; ++bj)
#pragma unroll
                    for (int e = 0; e < 8; ++e) { float v = cs[bj][e]; v += __shfl_xor(v, 1); v += __shfl_xor(v, 2); v += __shfl_xor(v, 4); v += __shfl_xor(v, 8); cs[bj][e] = v; }
                if (fr == 0) {
#pragma unroll
                    for (int bj = 0; bj < 2; ++bj)
#pragma unroll
                        for (int e = 0; e < 8; ++e) KM[wr * 256 + bj * 128 + 32 * wc + 8 * fq + e] = cs[bj][e]; }
                asm volatile("s_waitcnt lgkmcnt(0)" ::: "memory"); __builtin_amdgcn_s_barrier(); asm volatile("" ::: "memory");
                if (wr == 0 && fr == 0) { float* KMEAN = (float*)(ws + WS_KMEAN);
#pragma unroll
                    for (int bj = 0; bj < 2; ++bj) { const int hh = (u.pn & 3) * 2 + bj; float* kp = KMEAN + ((size_t)((u.pm >> 6) * NH + hh) * NBLK + (u.pm & 63)) * HD + 32 * wc + 8 * fq;
                        const int c = bj * 128 + 32 * wc + 8 * fq;
#pragma unroll
                        for (int e = 0; e < 8; ++e) kp[e] = (KM[c + e] + KM[256 + c + e]) * (1.0f / BLK); } }
            }
        } else if (mode == 0 || mode == 2) {
            const int tt = u.pn >> 2; const bool act = (mode == 0) ? (tt == 1) : (tt == 3);
            bf16_t* base = tt == 0 ? o0 : (tt == 1 ? o1 : (tt == 2 ? o2 : o3)); const int col0 = (u.pn & 3) * BM + wc * 32 + 8 * fq;
            float sv[8];
#pragma unroll
            for (int i = 0; i < 8; ++i) sv[i] = rst[(i >> 2) * 128 + (i & 3) * 16];
#pragma unroll
            for (int ai = 0; ai < 2; ++ai)
#pragma unroll
                for (int m = 0; m < 4; ++m) { const int row = row0 + ai * HALF + m * 16; const float s = sv[ai * 4 + m];
                    bf16_t* rowp = base + (size_t)row * DM + col0;
#pragma unroll
                    for (int bj = 0; bj < 2; ++bj) { f32x4 v0 = acc[ai][bj][m][0] * s, v1 = acc[ai][bj][m][1] * s;
                        if (act) {
#pragma unroll
                            for (int j = 0; j < 4; ++j) { v0[j] = siluf_(v0[j]); v1[j] = siluf_(v1[j]); } }
                        u32x4 w; w.x = cvt_pk_bf16(v0[0], v0[1]); w.y = cvt_pk_bf16(v0[2], v0[3]); w.z = cvt_pk_bf16(v1[0], v1[1]); w.w = cvt_pk_bf16(v1[2], v1[3]);
                        *(u32x4*)(rowp + bj * HALF) = w; } }
        } else if (mode == 1) {
            const bf16_t* const xin = (const bf16_t*)(ws + WS_S0);
            const int col0 = u.pn * BM + wc * 32 + 8 * fq;
#pragma unroll
            for (int ai = 0; ai < 2; ++ai) {
                f32x4 xv[4][2][2];
#pragma unroll
                for (int m = 0; m < 4; ++m) { const size_t off = (size_t)(row0 + ai * HALF + m * 16) * DM + col0;
#pragma unroll
                    for (int bj = 0; bj < 2; ++bj) { const u32x4 x4 = __builtin_nontemporal_load((const u32x4*)(xin + off + bj * HALF));
                        xv[m][bj][0] = (f32x4){__builtin_bit_cast(float, x4.x << 16), __builtin_bit_cast(float, x4.x & 0xffff0000u), __builtin_bit_cast(float, x4.y << 16), __builtin_bit_cast(float, x4.y & 0xffff0000u)};
                        xv[m][bj][1] = (f32x4){__builtin_bit_cast(float, x4.z << 16), __builtin_bit_cast(float, x4.z & 0xffff0000u), __builtin_bit_cast(float, x4.w << 16), __builtin_bit_cast(float, x4.w & 0xffff0000u)}; } }
#pragma unroll
                for (int m = 0; m < 4; ++m) { const int row = row0 + ai * HALF + m * 16; const size_t off = (size_t)row * DM + col0; float ss = 0.f;
#pragma unroll
                    for (int bj = 0; bj < 2; ++bj) { const f32x4 v0 = acc[ai][bj][m][0] + xv[m][bj][0], v1 = acc[ai][bj][m][1] + xv[m][bj][1];
                        ss += ((v0[0] * v0[0] + v0[1] * v0[1]) + (v0[2] * v0[2] + v0[3] * v0[3])) + ((v1[0] * v1[0] + v1[1] * v1[1]) + (v1[2] * v1[2] + v1[3] * v1[3]));
                        u32x4 w; w.x = cvt_pk_bf16(v0[0], v0[1]); w.y = cvt_pk_bf16(v0[2], v0[3]); w.z = cvt_pk_bf16(v1[0], v1[1]); w.w = cvt_pk_bf16(v1[2], v1[3]);
                        *(u32x4*)(o0 + off + bj * HALF) = w; }
                    ss += __shfl_xor(ss, 16); ss += __shfl_xor(ss, 32);
                    if (fq == 0) ssq[(size_t)row * 16 + u.pn * 4 + wc] = ss; }
            }
        } else {
            const int col0 = u.pn * BM + wc * 32 + 8 * fq;
            u32x4 xr[8][2];
#pragma unroll
            for (int i = 0; i < 8; ++i) { const size_t off = (size_t)(row0 + (i >> 2) * HALF + (i & 3) * 16) * DM + col0;
                xr[i][0] = __builtin_nontemporal_load((const u32x4*)((const bf16_t*)(ws + WS_S6) + off)); xr[i][1] = __builtin_nontemporal_load((const u32x4*)((const bf16_t*)(ws + WS_S6) + off + HALF)); }
#pragma unroll
            for (int ai = 0; ai < 2; ++ai)
#pragma unroll
                for (int m = 0; m < 4; ++m) { const size_t off = (size_t)(row0 + ai * HALF + m * 16) * DM + col0;
#pragma unroll
                    for (int bj = 0; bj < 2; ++bj) { float* p = xout + off + bj * HALF; const u32x4 x4 = xr[ai * 4 + m][bj];
                        const f32x4 xa = {__builtin_bit_cast(float, x4.x << 16), __builtin_bit_cast(float, x4.x & 0xffff0000u), __builtin_bit_cast(float, x4.y << 16), __builtin_bit_cast(float, x4.y & 0xffff0000u)};
                        const f32x4 xb = {__builtin_bit_cast(float, x4.z << 16), __builtin_bit_cast(float, x4.z & 0xffff0000u), __builtin_bit_cast(float, x4.w << 16), __builtin_bit_cast(float, x4.w & 0xffff0000u)};
                        const f32x4 v0 = acc[ai][bj][m][0] + xa, v1 = acc[ai][bj][m][1] + xb; const bool lower = (fr & 8) == 0;
                        const f32x4 snd = lower ? v1 : v0; f32x4 rcv;
#pragma unroll
                        for (int e = 0; e < 4; ++e) rcv[e] = __shfl_xor(snd[e], 8);
                        const f32x4 s1 = lower ? v0 : rcv, s2 = lower ? rcv : v1;
                        float* pr = xout + (size_t)(u.pm * BM + wr * 64 + ai * HALF + m * 16 + (fr & 7)) * DM + u.pn * BM + bj * HALF + wc * 32 + 8 * fq + (lower ? 0 : 4);
                        __builtin_nontemporal_store(s1, (f32x4*)pr); __builtin_nontemporal_store(s2, (f32x4*)(pr + 8 * DM)); (void)p; } }
        }
    }
};
}

__device__ __forceinline__ int fperm(int p) { return ((p >> 2) & 1) * 64 + (p >> 5) * 16 + ((p >> 3) & 3) * 4 + (p & 3); }
template <int MODE  >
__device__ __forceinline__ void p0_transpose_item(const float* W, int ldw, int Kd, bf16* WT, int drow0, const float* gain, LAS float* scr, int k0, int n0, int lane) {
    const int g = lane & 7, kr = lane >> 3;
    const int nn = n0 + 4 * g;
    const int sc = (MODE == 1 && nn < 1024) ? ((nn & ~127) + fperm(nn & 127)) : nn;
    f32x4 v[8];
#pragma unroll
    for (int i = 0; i < 8; ++i) v[i] = *(const f32x4*)(W + (size_t)(k0 + kr + 8 * i) * ldw + sc);
#pragma unroll
    for (int i = 0; i < 8; ++i) { const int kk = kr + 8 * i; const float gm = gain ? gain[k0 + kk] : 1.0f;
        scr[kk * 33 + 4 * g + 0] = v[i][0] * gm; scr[kk * 33 + 4 * g + 1] = v[i][1] * gm; scr[kk * 33 + 4 * g + 2] = v[i][2] * gm; scr[kk * 33 + 4 * g + 3] = v[i][3] * gm; }
    LDS_WAIT(); asm volatile("" ::: "memory");
    const int c = lane & 7;
#pragma unroll
    for (int j = 0; j < 4; ++j) { const int n = (lane >> 3) + 8 * j; const LAS float* sp = scr + (8 * c) * 33 + n;
        v4u o; o.x = pk2(sp[0 * 33], sp[1 * 33]); o.y = pk2(sp[2 * 33], sp[3 * 33]); o.z = pk2(sp[4 * 33], sp[5 * 33]); o.w = pk2(sp[6 * 33], sp[7 * 33]);
        *(v4u*)(WT + (size_t)(drow0 + n0 + n) * Kd + k0 + 8 * c) = o; }
    LDS_WAIT(); asm volatile("" ::: "memory");
}
__device__ __forceinline__ void sincos_acc(float angf, float& s, float& c) {
    const double a = (double)angf;
    const double k = __builtin_rint(a * 0.63661977236758134308);
    const double y = __builtin_fma(-k, 1.57079632679489661923, a) - k * 6.123233995736766e-17;
    const double y2 = y * y;
    double sp = -1.0 / 1307674368000.0; sp = sp * y2 + 1.0 / 6227020800.0; sp = sp * y2 - 1.0 / 39916800.0; sp = sp * y2 + 1.0 / 362880.0; sp = sp * y2 - 1.0 / 5040.0; sp = sp * y2 + 1.0 / 120.0; sp = sp * y2 - 1.0 / 6.0; sp = sp * y2 + 1.0;
    const double sy = sp * y;
    double cp = 1.0 / 20922789888000.0; cp = cp * y2 - 1.0 / 87178291200.0; cp = cp * y2 + 1.0 / 479001600.0; cp = cp * y2 - 1.0 / 3628800.0; cp = cp * y2 + 1.0 / 40320.0; cp = cp * y2 - 1.0 / 720.0; cp = cp * y2 + 1.0 / 24.0; cp = cp * y2 - 0.5; cp = cp * y2 + 1.0;
    const int q = ((int)k) & 3;
    const double ss = (q == 0) ? sy : (q == 1) ? cp : (q == 2) ? -sy : -cp;
    const double cc = (q == 0) ? cp : (q == 1) ? -sy : (q == 2) ? -cp : sy;
    s = (float)ss; c = (float)cc;
}
__device__ __forceinline__ void p0_prologue(Frame& F) {
    static constexpr float ROPE_INV[64] = {
        1.000000000e+00f, 8.659643531e-01f, 7.498942018e-01f, 6.493816376e-01f, 5.623413324e-01f, 4.869675338e-01f, 4.216965139e-01f, 3.651741147e-01f, 3.162277639e-01f, 2.738419771e-01f, 2.371373773e-01f, 2.053525001e-01f, 1.778279394e-01f, 1.539926529e-01f, 1.333521456e-01f, 1.154781953e-01f,
        1.000000015e-01f, 8.659642935e-02f, 7.498942316e-02f, 6.493816525e-02f, 5.623413250e-02f, 4.869675264e-02f, 4.216964915e-02f, 3.651741147e-02f, 3.162277490e-02f, 2.738419548e-02f, 2.371373773e-02f, 2.053525113e-02f, 1.778279431e-02f, 1.539926510e-02f, 1.333521400e-02f, 1.154781971e-02f,
        9.999999776e-03f, 8.659643121e-03f, 7.498942316e-03f, 6.493816152e-03f, 5.623413250e-03f, 4.869675264e-03f, 4.216964822e-03f, 3.651741194e-03f, 3.162277630e-03f, 2.738419687e-03f, 2.371373819e-03f, 2.053525066e-03f, 1.778279431e-03f, 1.539926510e-03f, 1.333521446e-03f, 1.154782018e-03f,
        1.000000047e-03f, 8.659643354e-04f, 7.498941850e-04f, 6.493816036e-04f, 5.623413017e-04f, 4.869675322e-04f, 4.216965172e-04f, 3.651741135e-04f, 3.162277571e-04f, 2.738419571e-04f, 2.371373703e-04f, 2.053525095e-04f, 1.778279402e-04f, 1.539926598e-04f, 1.333521504e-04f, 1.154782003e-04f};
    LAS float* scr = (LAS float*)(F.lds + F.wave * 16384);
    const int gw = F.vcu * 8 + F.wave, NGW = F.G * 8;
    bf16* WAIN = (bf16*)(F.ws + WS_WAIN); bf16* WAOUT = (bf16*)(F.ws + WS_WAOUT); bf16* WB1 = (bf16*)(F.ws + WS_WB1); bf16* WBOUT = (bf16*)(F.ws + WS_WBOUT); bf16* WRG = (bf16*)(F.ws + WS_WRG);
    constexpr int I0 = 16 * 64, I1 = 16 * 32, I2 = 16 * 64, I3 = 16 * 64, I4 = 16 * 32, I5 = 16 * 8;
    constexpr int NITEMS = I0 + I1 + I2 + I3 + I4 + I5;
#define P0_ITEM(IT) do { int r = (IT);\
        if (r < I0) { p0_transpose_item<0>(inp(2), 2048, DM, WAIN, 0, inp(1), scr, (r / 64) * 64, (r % 64) * 32, F.lane); break; } r -= I0;\
        if (r < I1) { p0_transpose_item<0>(inp(10), 1024, DM, WAOUT, 0, nullptr, scr, (r / 32) * 64, (r % 32) * 32, F.lane); break; } r -= I1;\
        if (r < I2) { p0_transpose_item<1>(inp(12), 2048, DM, WB1, 0, inp(11), scr, (r / 64) * 64, (r % 64) * 32, F.lane); break; } r -= I2;\
        if (r < I3) { p0_transpose_item<1>(inp(15), 2048, DM, WB1, 2048, inp(14), scr, (r / 64) * 64, (r % 64) * 32, F.lane); break; } r -= I3;\
        if (r < I4) { p0_transpose_item<0>(inp(17), 1024, DM, WBOUT, 0, nullptr, scr, (r / 32) * 64, (r % 32) * 32, F.lane); break; } r -= I4;\
        { const int mat = r >> 3, sub = r & 7, n = mat >> 1, which = mat & 1;   \
          const float* W = (which ? inp(7) : inp(5)) + (size_t)n * 128 * 128;\
          p0_transpose_item<0>(W, 128, 128, WRG, n * 256 + which * 128, nullptr, scr, (sub >> 2) * 64, (sub & 3) * 32, F.lane); } } while (0)
    bf16* XB = (bf16*)(F.ws + WS_S0); float* RS0 = (float*)(F.ws + WS_RS0);
    int item = gw;
    for (int m0 = gw * 8; m0 < T; m0 += NGW * 8) {
        const float* xin = inp(0);
        f32x4 v[8][4];
#pragma unroll
        for (int r = 0; r < 8; ++r) { const f32x4* xr = (const f32x4*)(xin + (size_t)(m0 + r) * DM) + F.lane;
#pragma unroll
            for (int j = 0; j < 4; ++j) v[r][j] = __builtin_nontemporal_load(xr + 64 * j); }
        if (item < NITEMS) { P0_ITEM(item); item += NGW; }
#pragma unroll
        for (int r = 0; r < 8; ++r) { float s = 0.f;
#pragma unroll
            for (int j = 0; j < 4; ++j) s += (v[r][j][0] * v[r][j][0] + v[r][j][1] * v[r][j][1]) + (v[r][j][2] * v[r][j][2] + v[r][j][3] * v[r][j][3]);
            s = wave_sum(s);
            if (F.lane == 0) RS0[m0 + r] = 1.0f / sqrtf(s * (1.0f / DM) + EPS);
            v2u* o8 = (v2u*)(XB + (size_t)(m0 + r) * DM) + F.lane;
#pragma unroll
            for (int j = 0; j < 4; ++j) { v2u w; w.x = pk2(v[r][j][0], v[r][j][1]); w.y = pk2(v[r][j][2], v[r][j][3]); o8[64 * j] = w; } }
    }
    for (; item < NITEMS; item += NGW) P0_ITEM(item);
#undef P0_ITEM
    float* RC = (float*)(F.ws + WS_ROPE); float* RSn = RC + (size_t)SEQ * 64;
    for (int idx = gw * 64 + F.lane; idx < SEQ * 64; idx += NGW * 64) {
        const int pos = idx >> 6, i = idx & 63;
        const float inv = ROPE_INV[i];
        const float ang = (float)pos * inv; float s, c; sincos_acc(ang, s, c);
        RC[idx] = c; RSn[idx] = s;
    }
}

constexpr int XB_PITCH = 272;
constexpr int XB_TILE = 256 * XB_PITCH;
__device__ __forceinline__ int xb_addr(int tok, int byteoff) { return tok * XB_PITCH + ((((byteoff >> 4) ^ (((tok >> 6) & 3) << 2)) << 4) | (byteoff & 15)); }
__device__ __forceinline__ unsigned pk_half2(float lo, float hi) { const _Float16 a = (_Float16)lo, b = (_Float16)hi; return (unsigned)__builtin_bit_cast(unsigned short, a) | ((unsigned)__builtin_bit_cast(unsigned short, b) << 16); }
__device__ __forceinline__ float half_lo(unsigned w) { return (float)__builtin_bit_cast(_Float16, (unsigned short)(w & 0xffffu)); }
__device__ __forceinline__ float half_hi(unsigned w) { return (float)__builtin_bit_cast(_Float16, (unsigned short)(w >> 16)); }
constexpr float LA_SCALE = 256.0f;
__device__ __forceinline__ void scan_load_raw(Frame& F, int b, int c, int n, v4u (&raw)[11]) {
    const bf16* UX = (const bf16*)(F.ws + WS_S1); const int cg = F.tid & 15, tr = F.tid >> 4, chb = n * 128 + cg * 8; const size_t rowbase = (size_t)b * SEQ + c * BLK;
#pragma unroll
    for (int i = 0; i < 11; ++i) { const int t = 8 * tr + i - 3; const bool ok = (c > 0) || (t >= 0);
        raw[i] = ok ? __builtin_nontemporal_load((const v4u*)(UX + (size_t)((long)rowbase + t) * DM + chb)) : (v4u){0u, 0u, 0u, 0u}; }
}
__device__ __forceinline__ void scan_unit(Frame& F, int b, int c, int n, v4u (&raw)[11], int nb, int nc, int nn) {
    LAS unsigned char* XBt = F.lds;
    unsigned* LB = (unsigned*)(F.ws + WS_S3);
    float* SUMA = (float*)(F.ws + WS_SUMA); float* SUMB = (float*)(F.ws + WS_SUMB); float* SEGA = (float*)(F.ws + WS_SEGA); float* SEGB = (float*)(F.ws + WS_SEGB);
    const int t0 = c * BLK; const size_t rowbase = (size_t)b * SEQ + t0;
    TS_BEGIN(1);
    {
        const int cg = F.tid & 15, tr = F.tid >> 4, chb = n * 128 + cg * 8;
        const float* cw = inp(3); const float* cb = inp(4);
        float w[4][8], bia[8];
#pragma unroll
        for (int k = 0; k < 4; ++k) { const f32x4 a = *(const f32x4*)(cw + k * DM + chb), bb = *(const f32x4*)(cw + k * DM + chb + 4);
            w[k][0] = a[0]; w[k][1] = a[1]; w[k][2] = a[2]; w[k][3] = a[3]; w[k][4] = bb[0]; w[k][5] = bb[1]; w[k][6] = bb[2]; w[k][7] = bb[3]; }
        { const f32x4 a = *(const f32x4*)(cb + chb), bb = *(const f32x4*)(cb + chb + 4); bia[0] = a[0]; bia[1] = a[1]; bia[2] = a[2]; bia[3] = a[3]; bia[4] = bb[0]; bia[5] = bb[1]; bia[6] = bb[2]; bia[7] = bb[3]; }
#pragma unroll
        for (int i = 0; i < 8; ++i) { float o[8];
#pragma unroll
            for (int e = 0; e < 8; ++e) o[e] = bia[e];
#pragma unroll
            for (int k = 0; k < 4; ++k) { const v4u r = raw[i + k];
                o[0] += w[k][0] * bflo(r.x); o[1] += w[k][1] * bfhi(r.x); o[2] += w[k][2] * bflo(r.y); o[3] += w[k][3] * bfhi(r.y);
                o[4] += w[k][4] * bflo(r.z); o[5] += w[k][5] * bfhi(r.z); o[6] += w[k][6] * bflo(r.w); o[7] += w[k][7] * bfhi(r.w); }
            v4u pk; pk.x = pk2(o[0], o[1]); pk.y = pk2(o[2], o[3]); pk.z = pk2(o[4], o[5]); pk.w = pk2(o[6], o[7]);
            *(LAS v4u*)(XBt + xb_addr(8 * tr + i, cg * 16)) = pk; }
    }
    __syncthreads();
    if (nc >= 0) scan_load_raw(F, nb, nc, nn, raw);
    TS_END(1); TS_BEGIN(2);
    {
        const int w = F.wave, cl = F.lane & 15, q = F.lane >> 4;
        const bf16* WRG = (const bf16*)(F.ws + WS_WRG);
        bf16x8 Br[4], Bi[4];
#pragma unroll
        for (int ks = 0; ks < 4; ++ks) { Br[ks] = *(const bf16x8*)(WRG + (size_t)(n * 256 + 16 * w + cl) * 128 + 32 * ks + 8 * q);
                                         Bi[ks] = *(const bf16x8*)(WRG + (size_t)(n * 256 + 128 + 16 * w + cl) * 128 + 32 * ks + 8 * q); }
        const int ch = n * 128 + 16 * w + cl;
        const float rb = inp(6)[ch] * -1.4426950408889634f, ib = inp(8)[ch] * -1.4426950408889634f, lam = inp(9)[ch];
        const float z = -lam; const float sp = fmaxf(z, 0.f) + log1pf(expf(-fabsf(z)));
        const float c8 = -8.0f * sp, c8l = c8 * 1.4426950408889634f;
        float Arun = 1.f, h = 0.f;
        const int arow = 64 * (cl >> 2) + (cl & 3);
        int aoffs[4];
#pragma unroll
        for (int ks = 0; ks < 4; ++ks) aoffs[ks] = xb_addr(arow, (32 * ks + 8 * q) * 2);
        const int eoff = xb_addr(64 * q, (16 * w + cl) * 2);
        unsigned* lbp = LB + (rowbase + 64 * q) * DM + ch;
#pragma unroll 2
        for (int mt = 0; mt < 16; ++mt) {
            pg8::f32x4 accR = {0.f, 0.f, 0.f, 0.f}, accI = {0.f, 0.f, 0.f, 0.f};
#pragma unroll
            for (int ks = 0; ks < 4; ++ks) { const bf16x8 a = *(const LAS bf16x8*)(XBt + aoffs[ks] + 4 * mt * XB_PITCH);
                accR = __builtin_amdgcn_mfma_f32_16x16x32_bf16(a, Br[ks], accR, 0, 0, 0);
                accI = __builtin_amdgcn_mfma_f32_16x16x32_bf16(a, Bi[ks], accI, 0, 0, 0); }
            typedef float f32x2 __attribute__((ext_vector_type(2)));
#pragma unroll
            for (int rp = 0; rp < 4; rp += 2) {
                const int eo = eoff + (4 * mt + rp) * XB_PITCH;
                const f32x2 xv = {bf1(*(const LAS unsigned short*)(XBt + eo)), bf1(*(const LAS unsigned short*)(XBt + eo + XB_PITCH))};
                const f32x2 zr = (f32x2){accR[rp], accR[rp + 1]} * -1.4426950408889634f + rb, zi = (f32x2){accI[rp], accI[rp + 1]} * -1.4426950408889634f + ib;
                const f32x2 er = {fast_exp2(zr[0]), fast_exp2(zr[1])}, ei = {fast_exp2(zi[0]), fast_exp2(zi[1])};
                const f32x2 dr = er + 1.0f, di = ei + 1.0f;
                const f32x2 rg = {__builtin_amdgcn_rcpf(dr[0]), __builtin_amdgcn_rcpf(dr[1])}, ig = {__builtin_amdgcn_rcpf(di[0]), __builtin_amdgcn_rcpf(di[1])};
                const f32x2 la2 = rg * c8l;
                const f32x2 av = {fast_exp2(la2[0]), fast_exp2(la2[1])};
                const f32x2 x2 = rg * (2.f * c8);
                f32x2 pz = x2 * (1.0f / 120.0f) + (1.0f / 24.0f); pz = pz * x2 + (1.0f / 6.0f); pz = pz * x2 + 0.5f; pz = pz * x2 + 1.0f;
                const f32x2 ser = -x2 * pz, dir = 1.0f - av * av;
                const f32x2 em1 = {fminf(ser[0], dir[0]), fminf(ser[1], dir[1])};
                const f32x2 sq = {__builtin_amdgcn_sqrtf(em1[0]), __builtin_amdgcn_sqrtf(em1[1])};
                const f32x2 bt = sq * ig * xv; const f32x2 las = la2 * LA_SCALE;
                h = av[0] * h + bt[0]; lbp[(size_t)(4 * mt + rp) * DM] = pk_half2(las[0], bt[0]);
                h = av[1] * h + bt[1]; lbp[(size_t)(4 * mt + rp + 1) * DM] = pk_half2(las[1], bt[1]);
                Arun *= av[0] * av[1]; }
        }
        SEGA[(size_t)(b * 256 + 4 * c + q) * DM + ch] = Arun; SEGB[(size_t)(b * 256 + 4 * c + q) * DM + ch] = h;
        float Ac = 1.f, Bc = 0.f;
#pragma unroll
        for (int k = 0; k < 4; ++k) { const float Ak = __shfl(Arun, cl + 16 * k), Bk = __shfl(h, cl + 16 * k); Bc = Ak * Bc + Bk; Ac *= Ak; }
        if (q == 0) { SUMA[(size_t)(b * 64 + c) * DM + ch] = Ac; SUMB[(size_t)(b * 64 + c) * DM + ch] = Bc; }
    }
    __syncthreads();
    TS_END(2);
}
__device__ __forceinline__ void scan_apply_unit(Frame& F, int b, int seg) {
    const unsigned* LB = (const unsigned*)(F.ws + WS_S3); const bf16* SG = (const bf16*)(F.ws + WS_S2); bf16* Y = (bf16*)(F.ws + WS_S1);
    const float* SUMA = (const float*)(F.ws + WS_SUMA); const float* SUMB = (const float*)(F.ws + WS_SUMB); const float* SEGA = (const float*)(F.ws + WS_SEGA); const float* SEGB = (const float*)(F.ws + WS_SEGB);
    typedef float f32x2 __attribute__((ext_vector_type(2)));
    const int ch = 2 * F.tid, c = seg >> 2, qq = seg & 3;
    float h0 = 0.f, h1 = 0.f;
    TS_BEGIN(11);
    for (int cc0 = 0; cc0 < c; cc0 += 8) {
        f32x2 A[8], Bv[8];
#pragma unroll
        for (int i = 0; i < 8; ++i) { const bool ok = cc0 + i < c; const size_t o = (size_t)(b * 64 + cc0 + i) * DM + ch;
            A[i] = ok ? *(const f32x2*)(SUMA + o) : (f32x2){1.f, 1.f}; Bv[i] = ok ? *(const f32x2*)(SUMB + o) : (f32x2){0.f, 0.f}; }
#pragma unroll
        for (int i = 0; i < 8; ++i) { h0 = A[i][0] * h0 + Bv[i][0]; h1 = A[i][1] * h1 + Bv[i][1]; }
    }
    {   f32x2 A[3], Bv[3];
#pragma unroll
        for (int i = 0; i < 3; ++i) { const bool ok = i < qq; const size_t o = (size_t)(b * 256 + 4 * c + i) * DM + ch;
            A[i] = ok ? *(const f32x2*)(SEGA + o) : (f32x2){1.f, 1.f}; Bv[i] = ok ? *(const f32x2*)(SEGB + o) : (f32x2){0.f, 0.f}; }
#pragma unroll
        for (int i = 0; i < 3; ++i) { h0 = A[i][0] * h0 + Bv[i][0]; h1 = A[i][1] * h1 + Bv[i][1]; } }
    TS_END(11); TS_BEGIN(12);
    const size_t row0 = (size_t)b * SEQ + (size_t)seg * 64;
#pragma unroll 1
    for (int t0 = 0; t0 < 64; t0 += 16) {
        v2u lb[16]; unsigned sg[16];
#pragma unroll
        for (int i = 0; i < 16; ++i) { const size_t o = (row0 + t0 + i) * DM + ch; lb[i] = __builtin_nontemporal_load((const v2u*)(LB + o)); sg[i] = __builtin_nontemporal_load((const unsigned*)(SG + o)); }
#pragma unroll
        for (int i = 0; i < 16; ++i) {
            h0 = fast_exp2(half_lo(lb[i].x) * (1.0f / LA_SCALE)) * h0 + half_hi(lb[i].x);
            h1 = fast_exp2(half_lo(lb[i].y) * (1.0f / LA_SCALE)) * h1 + half_hi(lb[i].y);
            *(unsigned*)(Y + (row0 + t0 + i) * DM + ch) = pk2(h0 * bflo(sg[i]), h1 * bfhi(sg[i])); }
    }
    TS_END(12);
}

__device__ __forceinline__ void fix_unit(Frame& F, int b, int blk, int h, int which  ) {
    bf16* BUF = (bf16*)(F.ws + (which ? WS_S0 : WS_S1));
    const float* G = which ? inp(16) : inp(13);
    const float* RC = (const float*)(F.ws + WS_ROPE); const float* RSn = RC + (size_t)SEQ * 64;
    LAS float* red = (LAS float*)F.lds;
    const int k16 = F.tid & 15, ts = F.tid >> 4;
    float g[8];
    { const f32x4 a = *(const f32x4*)(G + 4 * k16), bb = *(const f32x4*)(G + 64 + 4 * k16); g[0] = a[0]; g[1] = a[1]; g[2] = a[2]; g[3] = a[3]; g[4] = bb[0]; g[5] = bb[1]; g[6] = bb[2]; g[7] = bb[3]; }
    const float osc = which ? QSCALE : 1.0f;
    float km[8] = {0.f, 0.f, 0.f, 0.f, 0.f, 0.f, 0.f, 0.f};
#pragma unroll 2
    for (int it = 0; it < 8; ++it) {
        const int tl = ts + 32 * it, pos = blk * BLK + tl; const size_t row = (size_t)b * SEQ + pos;
        bf16* p = BUF + row * DM + h * 128 + 8 * k16;
        const v4u raw = *(const v4u*)p;
        float v[8] = {bflo(raw.x), bfhi(raw.x), bflo(raw.y), bfhi(raw.y), bflo(raw.z), bfhi(raw.z), bflo(raw.w), bfhi(raw.w)};
        float ss = 0.f;
#pragma unroll
        for (int e = 0; e < 8; ++e) ss += v[e] * v[e];
        ss += __shfl_xor(ss, 1); ss += __shfl_xor(ss, 2); ss += __shfl_xor(ss, 4); ss += __shfl_xor(ss, 8);
        const float rinv = 1.0f / sqrtf(ss * (1.0f / HD) + EPS);
        const f32x4 cs = *(const f32x4*)(RC + (size_t)pos * 64 + 4 * k16), sn = *(const f32x4*)(RSn + (size_t)pos * 64 + 4 * k16);
        float o[8];
#pragma unroll
        for (int e = 0; e < 4; ++e) { const float x1 = v[e] * rinv * g[e], x2 = v[4 + e] * rinv * g[4 + e];
            o[e] = (x1 * cs[e] - x2 * sn[e]) * osc; o[4 + e] = (x2 * cs[e] + x1 * sn[e]) * osc; }
#pragma unroll
        for (int e = 0; e < 8; ++e) km[e] += o[e];
        v4u w; w.x = pk2(o[0], o[1]); w.y = pk2(o[2], o[3]); w.z = pk2(o[4], o[5]); w.w = pk2(o[6], o[7]);
        if (F.probe) *(v4u*)(F.ws + 48 * MiB + (((size_t)(p - BUF) * 2) & (8 * MiB - 1))) = w; else *(v4u*)p = w;
    }
    if (which == 0) {
#pragma unroll
        for (int e = 0; e < 8; ++e) red[ts * 128 + 8 * k16 + e] = km[e];
        __syncthreads();
        if (F.tid < 128) { float s = 0.f;
#pragma unroll 8
            for (int j = 0; j < 32; ++j) s += red[j * 128 + F.tid];
            ((float*)(F.ws + WS_KMEAN))[((size_t)(b * NH + h) * NBLK + blk) * HD + F.tid] = s * (1.0f / BLK); }
        __syncthreads();
    }
}

#define KSWZ(row, colB) ((row) * 256 + ((colB) ^ (((row) & 7) << 4)))
__device__ __forceinline__ int crow(int r, int hi) { return (r & 3) + 8 * (r >> 2) + 4 * hi; }
__device__ __forceinline__ int v_st(int k, int c) { const int kk = (k & ~0xC) | ((k & 4) << 1) | ((k & 8) >> 1); return ((kk >> 3) * 4 + (c >> 5)) * 512 + ((kk & 7) * 32 + (c & 31)) * 2; }
__device__ __forceinline__ int v_rd_base(int lane) { return ((lane & 3) << 3) | (((lane >> 2) & 3) << 6) | (((lane >> 4) & 1) << 5) | (((lane >> 5) & 1) << 8); }
constexpr int v_rd_off(int d0, int ks, int half) { return d0 * 512 + ks * 4096 + half * 2048; }
template <int OFF> __device__ __forceinline__ s16x4 tr_read(int vb) {
    s16x4 r; asm volatile("ds_read_b64_tr_b16 %0, %1 offset:%2" : "=&v"(r) : "v"(vb), "i"(OFF) : "memory"); return r;
}
__device__ __forceinline__ void qkt_acc(f32x16& p0, f32x16& p1, const LAS unsigned char* Ks, const bf16x8 (&qr)[8], int r32, int hi) {
    bf16x8 b0[8], b1[8];
#pragma unroll
    for (int d0 = 0; d0 < 8; ++d0) { const int cb = (d0 * 16 + hi * 8) * 2;
        b0[d0] = *(const LAS bf16x8*)(Ks + KSWZ(r32, cb)); b1[d0] = *(const LAS bf16x8*)(Ks + KSWZ(32 + r32, cb)); }
#pragma unroll
    for (int d0 = 0; d0 < 8; ++d0) {
        p0 = __builtin_amdgcn_mfma_f32_32x32x16_bf16(b0[d0], qr[d0], p0, 0, 0, 0);
        p1 = __builtin_amdgcn_mfma_f32_32x32x16_bf16(b1[d0], qr[d0], p1, 0, 0, 0); }
}
template <int D0> __device__ __forceinline__ void pv_one(f32x16& od, int vb, bf16x8 pa0, bf16x8 pa1, bf16x8 pa2, bf16x8 pa3) {
    const s16x4 l0 = tr_read<v_rd_off(D0, 0, 0)>(vb), h0 = tr_read<v_rd_off(D0, 0, 1)>(vb), l1 = tr_read<v_rd_off(D0, 1, 0)>(vb), h1 = tr_read<v_rd_off(D0, 1, 1)>(vb);
    const s16x4 l2 = tr_read<v_rd_off(D0, 2, 0)>(vb), h2 = tr_read<v_rd_off(D0, 2, 1)>(vb), l3 = tr_read<v_rd_off(D0, 3, 0)>(vb), h3 = tr_read<v_rd_off(D0, 3, 1)>(vb);
    asm volatile("s_waitcnt lgkmcnt(0)" ::: "memory"); SBAR();
#define PKV(L, H) (bf16x8){L[0], L[1], L[2], L[3], H[0], H[1], H[2], H[3]}
    od = __builtin_amdgcn_mfma_f32_32x32x16_bf16(PKV(l0, h0), pa0, od, 0, 0, 0);
    od = __builtin_amdgcn_mfma_f32_32x32x16_bf16(PKV(l1, h1), pa1, od, 0, 0, 0);
    od = __builtin_amdgcn_mfma_f32_32x32x16_bf16(PKV(l2, h2), pa2, od, 0, 0, 0);
    od = __builtin_amdgcn_mfma_f32_32x32x16_bf16(PKV(l3, h3), pa3, od, 0, 0, 0);
#undef PKV
}
constexpr float THR2 = 8.0f;
template <bool DIAG>
__device__ __forceinline__ void attn_subtile(f32x16 (&o)[4], float& m, float& l, const LAS unsigned char* Ks, int vb, const bf16x8 (&qr)[8], int r32, int hi, int kb0, int qidx) {
    const bool fresh = m <= -1e29f;
    const float mref = fresh ? 0.f : m, nm = -mref;
    f32x16 p0, p1;
#pragma unroll
    for (int r = 0; r < 16; ++r) { p0[r] = nm; p1[r] = nm; }
    qkt_acc(p0, p1, Ks, qr, r32, hi);
    if (DIAG) {
#pragma unroll
        for (int r = 0; r < 16; ++r) { const int kk = kb0 + crow(r, hi); if (kk > qidx) p0[r] = -1e30f; if (kk + 32 > qidx) p1[r] = -1e30f; }
    }
    float pmax = p0[0];
#pragma unroll
    for (int r = 1; r < 16; ++r) pmax = fmaxf(pmax, p0[r]);
#pragma unroll
    for (int r = 0; r < 16; ++r) pmax = fmaxf(pmax, p1[r]);
    { auto rr = __builtin_amdgcn_permlane32_swap(__float_as_uint(pmax), __float_as_uint(pmax), false, false);
      pmax = fmaxf(__uint_as_float(rr[0]), __uint_as_float(rr[1])); }
    const bool need = fresh || (pmax > THR2);
    if (__any(need)) {
        const float d = need ? pmax : 0.f;
        const float alpha = fresh ? 0.f : fast_exp2(-d);
        m = mref + d; l *= alpha;
#pragma unroll
        for (int r = 0; r < 16; ++r) { p0[r] -= d; p1[r] -= d; }
#pragma unroll
        for (int dd = 0; dd < 4; ++dd)
#pragma unroll
            for (int r = 0; r < 16; ++r) o[dd][r] *= alpha;
    }
    float ps = 0.f;
#pragma unroll
    for (int r = 0; r < 16; ++r) { p0[r] = fast_exp2(p0[r]); ps += p0[r]; }
#pragma unroll
    for (int r = 0; r < 16; ++r) { p1[r] = fast_exp2(p1[r]); ps += p1[r]; }
    { auto rr = __builtin_amdgcn_permlane32_swap(__float_as_uint(ps), __float_as_uint(ps), false, false);
      ps = __uint_as_float(rr[0]) + __uint_as_float(rr[1]); }
    l += ps;
    bf16x8 pa0, pa1, pa2, pa3;
#define PK4(P, BASE, OUT) do { unsigned a0 = pk2(P[BASE + 0], P[BASE + 1]), a1 = pk2(P[BASE + 2], P[BASE + 3]);   \
    unsigned b0 = pk2(P[BASE + 4], P[BASE + 5]), b1 = pk2(P[BASE + 6], P[BASE + 7]);                              \
    auto r0 = __builtin_amdgcn_permlane32_swap(a0, b0, false, false); auto r1 = __builtin_amdgcn_permlane32_swap(a1, b1, false, false); \
    v4u w = {r0[0], r1[0], r0[1], r1[1]}; OUT = __builtin_bit_cast(bf16x8, w); } while (0)
    PK4(p0, 0, pa0); PK4(p0, 8, pa1); PK4(p1, 0, pa2); PK4(p1, 8, pa3);
#undef PK4
    pv_one<0>(o[0], vb, pa0, pa1, pa2, pa3); pv_one<1>(o[1], vb, pa0, pa1, pa2, pa3); pv_one<2>(o[2], vb, pa0, pa1, pa2, pa3); pv_one<3>(o[3], vb, pa0, pa1, pa2, pa3);
}
__device__ __forceinline__ void row_store_T(unsigned char* rowp, const f32x16 (&o)[4], float sc, int hi, bool pred) {
#pragma unroll
    for (int j = 0; j < 8; ++j) { const int d0 = j >> 1, g0 = (j & 1) * 2;
        unsigned ax = pk2(o[d0][4 * g0 + 0] * sc, o[d0][4 * g0 + 1] * sc), ay = pk2(o[d0][4 * g0 + 2] * sc, o[d0][4 * g0 + 3] * sc);
        unsigned bx = pk2(o[d0][4 * g0 + 4] * sc, o[d0][4 * g0 + 5] * sc), by = pk2(o[d0][4 * g0 + 6] * sc, o[d0][4 * g0 + 7] * sc);
        auto r0 = __builtin_amdgcn_permlane32_swap(ax, bx, false, false); auto r1 = __builtin_amdgcn_permlane32_swap(ay, by, false, false);
        const v4u w = {r0[0], r1[0], r0[1], r1[1]};
        if (pred) *(v4u*)(rowp + 32 * j + 16 * hi) = w; }
}
__device__ __forceinline__ void row_load_T(const unsigned char* rowp, f32x16 (&v)[4], int hi) {
    v4u w[8];
#pragma unroll
    for (int j = 0; j < 8; ++j) w[j] = *(const v4u*)(rowp + 32 * j + 16 * hi);
#pragma unroll
    for (int j = 0; j < 8; ++j) { const int d0 = j >> 1, g0 = (j & 1) * 2;
        auto r0 = __builtin_amdgcn_permlane32_swap(w[j].x, w[j].z, false, false); auto r1 = __builtin_amdgcn_permlane32_swap(w[j].y, w[j].w, false, false);
        const unsigned ax = r0[0], bx = r0[1], ay = r1[0], by = r1[1];
        v[d0][4 * g0 + 0] = bflo(ax); v[d0][4 * g0 + 1] = bfhi(ax); v[d0][4 * g0 + 2] = bflo(ay); v[d0][4 * g0 + 3] = bfhi(ay);
        v[d0][4 * g0 + 4] = bflo(bx); v[d0][4 * g0 + 5] = bfhi(bx); v[d0][4 * g0 + 6] = bflo(by); v[d0][4 * g0 + 7] = bfhi(by); }
}
constexpr int KIMG = 0, VIMG = 65536, ATT_AUX = 131072;
__device__ __forceinline__ void load_kv_block(Frame& F, int b, int h, int j) {
    const bf16* KB = (const bf16*)(F.ws + WS_S1); const bf16* VB = (const bf16*)(F.ws + WS_S2);
    const size_t base = ((size_t)b * SEQ + (size_t)j * BLK) * DM + h * 128;
    v4u kr[8], vr[8];
#pragma unroll
    for (int it = 0; it < 8; ++it) { const int id = F.tid + 512 * it, row = id >> 4, c = id & 15;
        kr[it] = *(const v4u*)(KB + base + (size_t)row * DM + c * 8); vr[it] = *(const v4u*)(VB + base + (size_t)row * DM + c * 8); }
#pragma unroll
    for (int it = 0; it < 8; ++it) { const int id = F.tid + 512 * it, row = id >> 4, c = id & 15;
        *(LAS v4u*)(F.lds + KIMG + (row >> 6) * 16384 + KSWZ(row & 63, c * 16)) = kr[it];
        *(LAS v4u*)(F.lds + VIMG + (row >> 6) * 16384 + v_st(row & 63, c * 8)) = vr[it]; }
}

__device__ __forceinline__ void select_loads(Frame& F, int b, int h, int qb, f32x4 (&km)[4], bf16x8 (&qr)[8]) {
    const float* KM = (const float*)(F.ws + WS_KMEAN) + (size_t)(b * NH + h) * NBLK * HD;
    const bf16* QB = (const bf16*)(F.ws + WS_S0);
    const int r32 = F.lane & 31, hi = F.lane >> 5, ql = 32 * F.wave + r32;
    const size_t tok = (size_t)b * SEQ + qb * BLK + ql;
#pragma unroll
    for (int d0 = 0; d0 < 8; ++d0) qr[d0] = *(const bf16x8*)(QB + tok * DM + h * 128 + d0 * 16 + hi * 8);
#pragma unroll
    for (int it = 0; it < 2; ++it) { const int id = F.tid + 512 * it, row = id >> 4, c = id & 15;
        km[2 * it] = *(const f32x4*)(KM + row * HD + c * 8); km[2 * it + 1] = *(const f32x4*)(KM + row * HD + c * 8 + 4); }
}
__device__ __forceinline__ void select_unit(Frame& F, int b, int h, int qb, f32x4 (&km)[4], bf16x8 (&qr)[8], int nb, int nh, int nqb) {
    LAS unsigned char* KH = F.lds; LAS unsigned char* KL = F.lds + 16384;
    LAS int* cnt = (LAS int*)(F.lds + 32768); LAS int* cursor = cnt + 64; LAS int* offs = cnt + 128; LAS unsigned short* ent = (LAS unsigned short*)(F.lds + 32768 + 1024);
    unsigned short* ENT = (unsigned short*)(F.ws + WS_ENT) + (size_t)((b * NH + h) * NBLK + qb) * 768;
    unsigned short* OFFS = (unsigned short*)(F.ws + WS_OFFS) + (size_t)((b * NH + h) * NBLK + qb) * OFFS_PITCH;
    unsigned* NTOT = (unsigned*)(F.ws + WS_CTL) + CW_NTOT + (b * NH + h) * NBLK;
    TS_BEGIN(70);
#pragma unroll
    for (int it = 0; it < 2; ++it) { const int id = F.tid + 512 * it, row = id >> 4, c = id & 15;
        const f32x4 a = km[2 * it], bb = km[2 * it + 1];
        float v[8] = {a[0], a[1], a[2], a[3], bb[0], bb[1], bb[2], bb[3]}; unsigned hw[8]; float lo[8];
#pragma unroll
        for (int e = 0; e < 8; ++e) { if (row >= qb) v[e] = 0.f; hw[e] = f2bf(v[e]); lo[e] = v[e] - __builtin_bit_cast(float, hw[e] << 16); }
        v4u wh = {hw[0] | (hw[1] << 16), hw[2] | (hw[3] << 16), hw[4] | (hw[5] << 16), hw[6] | (hw[7] << 16)};
        v4u wl = {pk2(lo[0], lo[1]), pk2(lo[2], lo[3]), pk2(lo[4], lo[5]), pk2(lo[6], lo[7])};
        *(LAS v4u*)(KH + KSWZ(row, c * 16)) = wh; *(LAS v4u*)(KL + KSWZ(row, c * 16)) = wl; }
    if (F.tid < 64) cnt[F.tid] = 0;
    __syncthreads();
    TS_END(70); TS_BEGIN(71);
    const int r32 = F.lane & 31, hi = F.lane >> 5, ql = 32 * F.wave + r32;
    f32x16 p0 = {}, p1 = {};
    qkt_acc(p0, p1, KH, qr, r32, hi); qkt_acc(p0, p1, KL, qr, r32, hi);
    if (nqb >= 0) select_loads(F, nb, nh, nqb, km, qr);
    unsigned key[32];
#pragma unroll
    for (int r = 0; r < 16; ++r) { const int j0 = crow(r, hi), j1 = 32 + crow(r, hi);
        const unsigned b0 = __float_as_uint(p0[r]), b1 = __float_as_uint(p1[r]);
        const unsigned u0 = b0 ^ (((int)b0 >> 31) | 0x80000000u), u1 = b1 ^ (((int)b1 >> 31) | 0x80000000u);
        key[r] = j0 < qb ? ((u0 & ~63u) | (unsigned)(63 - j0)) : 0u; key[16 + r] = j1 < qb ? ((u1 & ~63u) | (unsigned)(63 - j1)) : 0u; }
    unsigned tk[3];
#pragma unroll
    for (int pass = 0; pass < 3; ++pass) { unsigned bk = key[0];
#pragma unroll
        for (int r = 1; r < 32; ++r) bk = bk > key[r] ? bk : key[r];
        tk[pass] = bk;
#pragma unroll
        for (int r = 0; r < 32; ++r) key[r] = (key[r] == bk) ? 0u : key[r]; }
    unsigned mk[6];
#pragma unroll
    for (int k = 0; k < 3; ++k) { mk[k] = tk[k]; mk[3 + k] = (unsigned)__shfl_xor((int)tk[k], 32); }
    unsigned fk[3];
#pragma unroll
    for (int pass = 0; pass < 3; ++pass) { unsigned bk = mk[0];
#pragma unroll
        for (int r = 1; r < 6; ++r) bk = bk > mk[r] ? bk : mk[r];
        fk[pass] = bk;
#pragma unroll
        for (int r = 0; r < 6; ++r) mk[r] = (mk[r] == bk) ? 0u : mk[r]; }
    const int i1 = 63 - (int)(fk[0] & 63u), i2 = 63 - (int)(fk[1] & 63u), i3 = 63 - (int)(fk[2] & 63u);
    TS_END(71); TS_BEGIN(72);
    const int nv = qb < 3 ? qb : 3;
    const int js[3] = {i1, i2, i3};
    if (hi == 0) {
#pragma unroll
        for (int s = 0; s < 3; ++s) if (s < nv) __hip_atomic_fetch_add(&cnt[js[s]], 1, __ATOMIC_RELAXED, __HIP_MEMORY_SCOPE_WORKGROUP);
    }
    __syncthreads();
    if (F.wave == 0) {
        const int c = cnt[F.lane]; int incl = c;
#pragma unroll
        for (int o = 1; o < 64; o <<= 1) { const int t = __shfl_up(incl, o); if (F.lane >= o) incl += t; }
        offs[F.lane + 1] = incl; cursor[F.lane] = incl - c; if (F.lane == 0) offs[0] = 0;
        OFFS[F.lane + 1] = (unsigned short)incl; if (F.lane == 0) OFFS[0] = 0;
        if (F.lane < qb && c > 0 && !F.probe) atomicAdd(&NTOT[F.lane], (unsigned)c);
    }
    __syncthreads();
    if (hi == 0) {
#pragma unroll
        for (int s = 0; s < 3; ++s) if (s < nv) { const int idx = __hip_atomic_fetch_add(&cursor[js[s]], 1, __ATOMIC_RELAXED, __HIP_MEMORY_SCOPE_WORKGROUP); ent[idx] = (unsigned short)(ql | (s << 8)); }
    }
    __syncthreads();
    const int tot = offs[64];
    for (int i = F.tid; i < tot; i += 512) ENT[i] = ent[i];
    __syncthreads();
    TS_END(72);
}

constexpr int P8_MAXSTEPS = 18;
constexpr int P8_OVH = 3;
constexpr size_t OWNP_OFF = 64 * MiB;
__device__ __forceinline__ void gathered_attention(Frame& F) {
    LAS int* PFX = (LAS int*)(F.lds + ATT_AUX); LAS int* NT = PFX + 1024; LAS int* wtot = NT + 1024;
    LAS int* ctr = wtot + 16; LAS int* qinfo = (LAS int*)(F.lds + ATT_AUX + 9216);
    const unsigned* NTOT = (const unsigned*)(F.ws + WS_CTL) + CW_NTOT;
    const bf16* QB = (const bf16*)(F.ws + WS_S0);
    unsigned char* PART = F.ws + WS_S3; unsigned char* OWNP = (unsigned char*)F.out + OWNP_OFF; float* LSE = (float*)(F.ws + WS_LSE);
    {
        const int n0 = (int)NTOT[2 * F.tid], n1 = (int)NTOT[2 * F.tid + 1]; const int s0 = ((n0 + 255) >> 8) + 1, s1 = ((n1 + 255) >> 8) + 1;
        const int e0 = 4 * s0 + P8_OVH, e1 = 4 * s1 + P8_OVH;
        NT[2 * F.tid] = n0; NT[2 * F.tid + 1] = n1;
        int incl = e0 + e1;
#pragma unroll
        for (int o = 1; o < 64; o <<= 1) { const int t = __shfl_up(incl, o); if (F.lane >= o) incl += t; }
        if (F.lane == 63) wtot[F.wave] = incl;
        __syncthreads();
        int off = 0;
#pragma unroll
        for (int w = 0; w < 8; ++w) off += (w < F.wave) ? wtot[w] : 0;
        PFX[2 * F.tid + 1] = off + incl; PFX[2 * F.tid] = off + incl - e1;
        __syncthreads();
    }
    const int V_tot = PFX[1023];
    const int v_lo = (int)(((long)F.vcu * V_tot) / F.G), v_hi = (int)(((long)(F.vcu + 1) * V_tot) / F.G);
    const int r32 = F.lane & 31, hi = F.lane >> 5;
    const int vbase = (int)(uintptr_t)(F.lds + VIMG) + v_rd_base(F.lane);
    int u; { int lo = 0, hi_ = 1023; while (lo < hi_) { const int mid = (lo + hi_) >> 1; if (PFX[mid] > v_lo) hi_ = mid; else lo = mid + 1; } u = lo; }
    int done = 0;
    while (u < 1024) {
        const int base = u ? PFX[u - 1] : 0; if (base >= v_hi) break;
        const int n = NT[u]; const int ns_g = (n + 255) >> 8, ns_u = ns_g + 1;
        int k_lo = (v_lo - base - P8_OVH + 3) >> 2; if (v_lo - base - P8_OVH + 3 < 0) k_lo = 0;
        int k_hi = (v_hi - base - P8_OVH + 3) >> 2; if (v_hi - base - P8_OVH + 3 < 0) k_hi = 0; if (k_hi > ns_u) k_hi = ns_u;
        k_lo += done;
        if (k_lo >= k_hi) { ++u; done = 0; continue; }
        int nsteps = k_hi - k_lo; bool more = false; if (nsteps > P8_MAXSTEPS) { nsteps = P8_MAXSTEPS; more = true; }
        const int ub = u >> 9, uh = (u >> 6) & 7, uj = u & 63;
        const bool own = (k_lo + nsteps == ns_u);
        const int ngs = nsteps - (own ? 1 : 0);
        TS_BEGIN(5);
        __syncthreads();
        {
            const bf16* KB = (const bf16*)(F.ws + WS_S1); const bf16* VB = (const bf16*)(F.ws + WS_S2);
            const size_t kvbase = ((size_t)ub * SEQ + (size_t)uj * BLK) * DM + uh * 128;
            v4u kr[8], vr[8];
#pragma unroll
            for (int it = 0; it < 8; ++it) { const int id = F.tid + 512 * it, row = id >> 4, c = id & 15;
                kr[it] = __builtin_nontemporal_load((const v4u*)(KB + kvbase + (size_t)row * DM + c * 8)); vr[it] = __builtin_nontemporal_load((const v4u*)(VB + kvbase + (size_t)row * DM + c * 8)); }
            int o0 = 0, o1 = 0;
            { const int qb = F.lane; if (qb > uj) { const unsigned short* OF = (const unsigned short*)(F.ws + WS_OFFS) + (size_t)((ub * NH + uh) * NBLK + qb) * OFFS_PITCH; o0 = OF[uj]; o1 = OF[uj + 1]; } }
            int cum = o1 - o0;
#pragma unroll
            for (int o = 1; o < 64; o <<= 1) { const int t = __shfl_up(cum, o); if (F.lane >= o) cum += t; }
            int e_end = 256 * (k_lo + ngs); if (e_end > n) e_end = n;
            const int nent = ngs > 0 ? e_end - 256 * k_lo : 0;
            for (int i0 = 0; i0 < ngs * 256; i0 += 512) { const int i = i0 + F.tid;
                int info = -1; const int e = 256 * k_lo + i; const bool ok = i < nent;
                int a = 0, c = 63;
#pragma unroll
                for (int it = 0; it < 6; ++it) { const int mid = (a + c) >> 1; const int cm = __shfl(cum, mid); if (cm > e) c = mid; else a = mid + 1; }
                const int qb = a; const int cprev = __shfl(cum, qb > 0 ? qb - 1 : 0); const int so = __shfl(o0, qb);
                if (ok) { const int idx = e - (qb ? cprev : 0);
                    const unsigned short en = ((const unsigned short*)(F.ws + WS_ENT))[(size_t)((ub * NH + uh) * NBLK + qb) * 768 + so + idx];
                    info = (qb * BLK + (en & 255)) | ((en >> 8) << 16); }
                if (i < ngs * 256) qinfo[i] = info; }
            if (own && F.tid < 256) qinfo[ngs * 256 + F.tid] = (uj * BLK + F.tid) | (3 << 16);
            if (F.tid == 0) ctr[0] = 0;
#pragma unroll
            for (int it = 0; it < 8; ++it) { const int id = F.tid + 512 * it, row = id >> 4, c = id & 15;
                *(LAS v4u*)(F.lds + KIMG + (row >> 6) * 16384 + KSWZ(row & 63, c * 16)) = kr[it];
                *(LAS v4u*)(F.lds + VIMG + (row >> 6) * 16384 + v_st(row & 63, c * 8)) = vr[it]; }
            __syncthreads();
            TS_END(5); TS_BEGIN(6);
            const int ntg = (nent + 31) >> 5;
            const int ntiles = ntg + (own ? 8 : 0);
            bf16x8 qa[8]; int ta;
#define P8_GRAB(T) do { int _t = 0; if (F.lane == 0) _t = __hip_atomic_fetch_add(ctr, 1, __ATOMIC_RELAXED, __HIP_MEMORY_SCOPE_WORKGROUP); T = __builtin_amdgcn_readfirstlane(_t); } while (0)
            P8_GRAB(ta);
            while (ta < ntiles) {
                const bool ownt = ta >= ntg; const int ot = ownt ? 7 - (ta - ntg) : 0;
                const int info = qinfo[ownt ? (ngs * 256 + 32 * ot + r32) : (32 * ta + r32)];
                const bool valid = info >= 0; const int pos = valid ? (info & 0xffff) : 0, slot = valid ? ((info >> 16) & 3) : 0; const size_t tok = (size_t)ub * SEQ + pos;
                { const bf16* qp = QB + tok * DM + uh * 128 + hi * 8;
#pragma unroll
                  for (int d0 = 0; d0 < 8; ++d0) qa[d0] = *(const bf16x8*)(qp + d0 * 16); }
                f32x16 o[4] = {}; float m = -1e30f, l = 0.f;
                const int tlast = ownt ? (ot >> 1) : 3;
                const int tfull = ownt ? tlast : 4;
#pragma unroll 1
                for (int t = 0; t < tfull; ++t) attn_subtile<false>(o, m, l, F.lds + KIMG + t * 16384, vbase + t * 16384, qa, r32, hi, 0, 0);
                if (ownt) attn_subtile<true>(o, m, l, F.lds + KIMG + tlast * 16384, vbase + tlast * 16384, qa, r32, hi, 64 * tlast, 32 * ot + r32);
                const float il = __builtin_amdgcn_rcpf(l);
                unsigned char* orow = ownt ? (OWNP + (tok * NH + uh) * 256) : (PART + ((tok * NH + uh) * 3 + slot) * 256);
                row_store_T(orow, o, il, hi, valid);
                if (valid && hi == 0) LSE[(tok * NH + uh) * 4 + slot] = m + __builtin_amdgcn_logf(l);
                P8_GRAB(ta);
            }
#undef P8_GRAB
            TS_END(6);
        }
        if (more) done += nsteps; else { ++u; done = 0; }
    }
    __syncthreads();
}

__device__ __forceinline__ void combine_phase(Frame& F) {
    const unsigned char* PART = F.ws + WS_S3; const unsigned char* OWNP = (const unsigned char*)F.out + OWNP_OFF; const float* LSE = (const float*)(F.ws + WS_LSE);
    const bf16* SG2 = (const bf16*)F.out; bf16* O = (bf16*)(F.ws + WS_S0);
    const long NIT = (long)T * NH * 16;
    for (long it = (long)F.vcu * 512 + F.tid; it < NIT; it += (long)F.G * 512) {
        const int c16 = (int)(it & 15); const long th = it >> 4;
        const int h = (int)(th & 7); const long tok = th >> 3; const int qb = (int)((tok & (SEQ - 1)) >> 8); const int nv = qb < 3 ? qb : 3;
        const f32x4 L4 = *(const f32x4*)(LSE + th * 4);
        const v4u po = __builtin_nontemporal_load((const v4u*)(OWNP + th * 256 + c16 * 16));
        v4u p0 = {0u, 0u, 0u, 0u}, p1 = p0, p2 = p0;
        if (nv > 0) p0 = __builtin_nontemporal_load((const v4u*)(PART + (th * 3 + 0) * 256 + c16 * 16));
        if (nv > 1) p1 = __builtin_nontemporal_load((const v4u*)(PART + (th * 3 + 1) * 256 + c16 * 16));
        if (nv > 2) p2 = __builtin_nontemporal_load((const v4u*)(PART + (th * 3 + 2) * 256 + c16 * 16));
        const v4u g = __builtin_nontemporal_load((const v4u*)(SG2 + tok * DM + h * 128 + c16 * 8));
        const float l0 = nv > 0 ? L4[0] : -1e30f, l1 = nv > 1 ? L4[1] : -1e30f, l2 = nv > 2 ? L4[2] : -1e30f, l3 = L4[3];
        const float M = fmaxf(fmaxf(l0, l1), fmaxf(l2, l3));
        const float w0 = fast_exp2(l0 - M), w1 = fast_exp2(l1 - M), w2 = fast_exp2(l2 - M), w3 = fast_exp2(l3 - M);
        const float inv = __builtin_amdgcn_rcpf((w0 + w1) + (w2 + w3));
        unsigned ow[4];
#pragma unroll
        for (int k = 0; k < 4; ++k) {
            const float a = (w0 * bflo(p0[k]) + w1 * bflo(p1[k])) + (w2 * bflo(p2[k]) + w3 * bflo(po[k]));
            const float bq = (w0 * bfhi(p0[k]) + w1 * bfhi(p1[k])) + (w2 * bfhi(p2[k]) + w3 * bfhi(po[k]));
            ow[k] = pk2(a * inv * bflo(g[k]), bq * inv * bfhi(g[k])); }
        const v4u ov = {ow[0], ow[1], ow[2], ow[3]};
        *(v4u*)(O + tok * DM + h * 128 + c16 * 8) = ov;
    }
}

constexpr int N_PHASES = 11;
__global__ void __launch_bounds__(512, 2) hawk_moba_fwd(Args args) {
    extern __shared__ __attribute__((aligned(16))) unsigned char lds_raw[];
    Frame F;
    F.lds = (LAS unsigned char*)lds_raw;
    F.tid = threadIdx.x; F.lane = F.tid & 63; F.wave = __builtin_amdgcn_readfirstlane(F.tid >> 6);
    F.G = gridDim.x; { const int bx = blockIdx.x; F.vcu = (F.G % 8 == 0) ? (bx % 8) * (F.G / 8) + bx / 8 : bx; }
    F.out = args.out; F.ws = args.ws; F.probe = false; F.tacc = 0ull; F.t0 = 0ull;
    volatile LAS unsigned* MISC = (volatile LAS unsigned*)(F.lds + MISC_OFF);
    if (F.tid < 64) MISC[F.tid] = 0u;
    __syncthreads();
    unsigned* ctl = (unsigned*)(F.ws + WS_CTL);
    XcdBarrier bar; bar.bar = ctl + CW_BAR; bar.x = 0; bar.st = nullptr;
    const int lo = args.ph_lo, hi = args.ph_hi;
    if (hi - lo > 1) bar = xcd_barrier_post(ctl + CW_BAR, MISC + 8);
#define IN(k) (lo <= (k) && (k) < hi)
#define SEAM(k) do { if (IN(k) && IN((k) + 1)) { TS_BEGIN(100 + (k)); xcd_barrier(bar); TS_END(100 + (k)); } } while (0)

#define RUN_GEMM(MODE, AOFF, BOFF, NN) do { \
        if ((MODE) == 0 || (MODE) == 2) {     \
            LAS float* rst = (LAS float*)(F.lds + pg8::STAGE_BYTES) + 2560; pg8::Unit uu; pg8::StaticOrder S0; S0.init(T, (NN), F.G, (int)blockIdx.x); \
            _Pragma("unroll") for (int i = 0; i < 8; ++i) { const bool okk = S0.next(i, uu); if (okk && F.tid < 256) { const int row = uu.pm * 256 + F.tid; float sc; \
                if ((MODE) == 0) sc = ((const float*)(F.ws + WS_RS0))[row]; \
                else { const f32x4* sp = (const f32x4*)((const float*)(F.ws + WS_SSQ1) + (size_t)row * 16); const f32x4 t4 = (sp[0] + sp[1]) + (sp[2] + sp[3]); sc = 1.0f / sqrtf(((t4[0] + t4[1]) + (t4[2] + t4[3])) * (1.0f / DM) + EPS); } \
                rst[i * 256 + F.tid] = sc; } } \
            __syncthreads(); } \
        { pg8::Gemm g{(const pg8::bf16_t*)(F.ws + (AOFF)), (const pg8::bf16_t*)(F.ws + (BOFF)), T, (NN), DM}; \
          pg8::EpiAll E{(MODE), F.ws, F.out, F.probe, (LAS float*)(F.lds + pg8::STAGE_BYTES)}; pg8::StaticOrder S; S.init(T, (NN), F.G, (int)blockIdx.x); \
          pg8::gemm_phase<pg8::EpiAll, pg8::StaticOrder, true, true>(F.lds, g, S, E, F.tacc); } } while (0)
    TS_BEGIN(200 + 0); if (IN(0)) { for (int rep = 0; rep < (MK_REPEAT == 0 ? 2 : 1); ++rep) { if (rep) xcd_barrier(bar); p0_prologue(F); } } TS_END(200 + 0); SEAM(0);
    TS_BEGIN(200 + 1); if (IN(1)) { RUN_GEMM(0, WS_S0, WS_WAIN, 2048); } TS_END(200 + 1); SEAM(1);
#if MK_REPEAT == 1
    TS_BEGIN(200 + 1); if (IN(1)) { RUN_GEMM(0, WS_S0, WS_WAIN, 2048); } TS_END(200 + 1); SEAM(1);
#endif
    TS_BEGIN(200 + 2); if (IN(2)) { for (int rep = 0; rep < (MK_REPEAT == 2 ? 2 : 1); ++rep) { if (rep) xcd_barrier(bar); { v4u raw[11]; int u = F.vcu; if (u < 1024) scan_load_raw(F, u >> 9, (u >> 3) & 63, u & 7, raw); for (; u < 1024; u += F.G) { const int un = u + F.G; const bool hn = un < 1024; scan_unit(F, u >> 9, (u >> 3) & 63, u & 7, raw, hn ? (un >> 9) : 0, hn ? ((un >> 3) & 63) : -1, hn ? (un & 7) : 0); } } } } TS_END(200 + 2); SEAM(2);
    TS_BEGIN(200 + 3); if (IN(3)) { for (int rep = 0; rep < (MK_REPEAT == 3 ? 2 : 1); ++rep) { if (rep) xcd_barrier(bar); for (int u = F.vcu; u < 512; u += F.G) scan_apply_unit(F, u >> 8, u & 255); } } TS_END(200 + 3); SEAM(3);
    TS_BEGIN(200 + 4); if (IN(4)) { RUN_GEMM(1, WS_S1, WS_WAOUT, DM); } TS_END(200 + 4); SEAM(4);
#if MK_REPEAT == 4
    TS_BEGIN(200 + 4); if (IN(4)) { RUN_GEMM(1, WS_S1, WS_WAOUT, DM); } TS_END(200 + 4); SEAM(4);
#endif
    TS_BEGIN(200 + 5); if (IN(5)) { RUN_GEMM(2, WS_S6, WS_WB1, 4096); } TS_END(200 + 5); SEAM(5);
#if MK_REPEAT == 5
    TS_BEGIN(200 + 5); if (IN(5)) { RUN_GEMM(2, WS_S6, WS_WB1, 4096); } TS_END(200 + 5); SEAM(5);
#endif
    TS_BEGIN(200 + 7); if (IN(7)) { for (int rep = 0; rep < (MK_REPEAT == 7 ? 2 : 1); ++rep) { if (rep) xcd_barrier(bar); F.probe = (MK_REPEAT == 7 && rep == 0); { f32x4 km[4]; bf16x8 qr[8]; int u = F.vcu; while (u < 1024 && (u & 63) == 0) u += F.G;     if (u < 1024) select_loads(F, u >> 9, (u >> 6) & 7, u & 63, km, qr); while (u < 1024) { int un = u + F.G; while (un < 1024 && (un & 63) == 0) un += F.G; const bool hn = un < 1024; select_unit(F, u >> 9, (u >> 6) & 7, u & 63, km, qr, hn ? (un >> 9) : 0, hn ? ((un >> 6) & 7) : 0, hn ? (un & 63) : -1); u = un; } } } } TS_END(200 + 7); SEAM(7);
    TS_BEGIN(200 + 8); if (IN(8)) { for (int rep = 0; rep < (MK_REPEAT == 8 ? 2 : 1); ++rep) { if (rep) xcd_barrier(bar); gathered_attention(F); } } TS_END(200 + 8); SEAM(8);
    TS_BEGIN(200 + 9); if (IN(9)) { for (int rep = 0; rep < (MK_REPEAT == 9 ? 2 : 1); ++rep) { if (rep) xcd_barrier(bar); F.probe = (MK_REPEAT == 9 && rep == 0); combine_phase(F); } } TS_END(200 + 9); SEAM(9);
#if MK_REPEAT == 20
    if (hi - lo > 1) { for (int i = 0; i < 10; ++i) xcd_barrier(bar); }
#endif
#if MK_REPEAT == 10
    if (IN(10)) { F.probe = true; RUN_GEMM(3, WS_S0, WS_WBOUT, DM); F.probe = false; xcd_barrier(bar); }
#endif
    TS_BEGIN(210); if (IN(10)) { RUN_GEMM(3, WS_S0, WS_WBOUT, DM); }
#undef RUN_GEMM
#undef IN
#undef SEAM
    if (MK_STAMP != 0) {
        unsigned long long* mx = (unsigned long long*)(ctl + 32768);
        if (F.tid == 0) atomicMax(mx, F.tacc);
        xcd_barrier(bar);
        if (blockIdx.x == 0 && F.tid == 0) { const unsigned long long tw = __hip_atomic_load(mx, __ATOMIC_RELAXED, __HIP_MEMORY_SCOPE_AGENT);
            const unsigned long long t0 = __builtin_amdgcn_s_memrealtime(); while (__builtin_amdgcn_s_memrealtime() - t0 < tw) __builtin_amdgcn_s_sleep(4); }
    }
}

extern "C" void kernel_launch(void* const* d_in, const int* in_sizes, int n_in, void* d_out, int out_size, void* d_ws, size_t ws_size, hipStream_t stream) {
    static int grid = 0;
    if (grid == 0) {
        if (n_in != 18 || in_sizes[0] != T * DM || out_size != T * DM || ws_size < WS_END) { fprintf(stderr, "kernel_launch: unexpected shapes (n_in %d, in0 %d, out %d, ws %zu < %zu)\n", n_in, n_in > 0 ? in_sizes[0] : -1, out_size, ws_size, (size_t)WS_END); grid = -1; return; }
        int dev = 0, cus = 0, per_cu = 0;
        if (hipGetDevice(&dev) != hipSuccess || hipDeviceGetAttribute(&cus, hipDeviceAttributeMultiprocessorCount, dev) != hipSuccess) { grid = -1; return; }
        if (hipFuncSetAttribute((const void*)hawk_moba_fwd, hipFuncAttributeMaxDynamicSharedMemorySize, LDS_BYTES) != hipSuccess) { fprintf(stderr, "kernel_launch: hipFuncSetAttribute failed\n"); grid = -1; return; }
        if (hipOccupancyMaxActiveBlocksPerMultiprocessor(&per_cu, (const void*)hawk_moba_fwd, 512, LDS_BYTES) != hipSuccess || per_cu < 1) { fprintf(stderr, "kernel_launch: occupancy query says %d blocks per CU\n", per_cu); (void)hipGetLastError(); grid = -1; return; }
        grid = cus;
    }
    if (grid < 0) return;
    (void)hipMemsetAsync((char*)d_ws + WS_CTL, 0, CTL_ZERO_BYTES, stream);
    Args a{};
    for (int i = 0; i < 18; ++i) a.in[i] = (const float*)d_in[i];
    a.out = (float*)d_out; a.ws = (unsigned char*)d_ws;
#if MK_N_LAUNCHES == 1
    a.ph_lo = 0; a.ph_hi = N_PHASES;
    hipLaunchKernelGGL(hawk_moba_fwd, dim3(grid), dim3(512), LDS_BYTES, stream, a);
#else
    for (int p = 0; p <= MK_LAST_PHASE; ++p) { a.ph_lo = p; a.ph_hi = p + 1; hipLaunchKernelGGL(hawk_moba_fwd, dim3(grid), dim3(512), LDS_BYTES, stream, a); }
#endif
}
```

```cpp
#include <hip/hip_runtime.h>
#include <cstdio>
#include <cstdint>

#ifndef MK_N_LAUNCHES
#define MK_N_LAUNCHES 1
#endif
#ifndef MK_PHMASK
#define MK_PHMASK 0x7ff
#endif
#ifndef MK_REPEAT
#define MK_REPEAT (-1)
#endif
#ifndef MK_STAMP
#define MK_STAMP 0
#endif
#ifndef MK_STAGGER
#define MK_STAGGER 0
#endif
#ifndef MK_LAST_PHASE
#define MK_LAST_PHASE 10
#endif

namespace pg8 {
#define PG8_LAS __attribute__((address_space(3)))
typedef unsigned short bf16_t;
typedef short bf16x8 __attribute__((ext_vector_type(8)));
typedef float f32x4 __attribute__((ext_vector_type(4)));
typedef unsigned u32x4 __attribute__((ext_vector_type(4)));
typedef unsigned u32x2 __attribute__((ext_vector_type(2)));
constexpr int BM = 256, BK = 64, HALF = 128, HTB = HALF * BK * 2, STAGE_BYTES = 8 * HTB, NXCD = 8, WGM = 8;

__host__ __device__ __forceinline__ int lds_byte(int r, int c) { const int st = (r >> 4) * 2 + (c >> 5), rr = r & 15, cc = c & 31, ob = rr * 64 + cc * 2; return st * 1024 + (ob ^ (((ob >> 9) & 1) << 5)); }
__host__ __device__ __forceinline__ void stage_rc(int b, int& R, int& C) { const int st = b / 1024, sb = b % 1024, swz = sb ^ (((sb >> 9) & 1) << 5); R = (st >> 1) * 16 + swz / 64; C = (st & 1) * 32 + (swz % 64) / 2; }
__host__ __device__ __forceinline__ int perm32(int rho) { const int n = rho >> 4, i = rho & 15; return 8 * (i >> 2) + 4 * n + (i & 3); }

struct Unit { int pm, pn; };
struct Gemm { const bf16_t* A; const bf16_t* Bt; int M, N, K; };

struct StaticOrder {
    int nM, nN, nwg, G, c;
    __host__ __device__ void init(int M, int N, int G_, int c_) { nM = M / BM; nN = N / BM; nwg = nM * nN; G = G_; c = c_; }
    __host__ __device__ __forceinline__ bool next(int i, Unit& u) const {
        const long L = (long)i * G + c; if (L >= nwg) return false;
        int wgid = (int)L; { const int q = nwg / NXCD, r = nwg % NXCD, xcd = wgid % NXCD, off = wgid / NXCD; wgid = (xcd < r ? xcd * (q + 1) : r * (q + 1) + (xcd - r) * q) + off; }
        const int nig = WGM * nN, gid = wgid / nig, fm = gid * WGM, gsz = (nM - fm) < WGM ? (nM - fm) : WGM;
        u.pm = fm + ((wgid % nig) % gsz); u.pn = (wgid % nig) / gsz; return true;
    }
    __device__ __forceinline__ void a_ready(const Unit&) const {}
    __device__ __forceinline__ void done(const Unit&) const {}
};

template <int CTRL> __device__ __forceinline__ float dpp_mov(float v) { return __builtin_bit_cast(float, __builtin_amdgcn_update_dpp(0, __builtin_bit_cast(int, v), CTRL, 0xf, 0xf, true)); }
#define dpp_f(v, ctrl) dpp_mov<(ctrl)>(v)
__device__ __forceinline__ unsigned cvt_pk_bf16(float lo, float hi) { unsigned r; asm volatile("v_cvt_pk_bf16_f32 %0, %1, %2" : "=v"(r) : "v"(lo), "v"(hi)); return r; }

template <class Epi, class Sched, bool ALIGN_EPI = false, bool SP2 = false>
__device__ __forceinline__ void gemm_phase(PG8_LAS unsigned char* lds, const Gemm g, const Sched& S, const Epi& E, unsigned long long& tacc) {
    const int tid = threadIdx.x, wid = __builtin_amdgcn_readfirstlane(tid >> 6), lane = tid & 63, wr = wid >> 2, wc = wid & 3, fr = lane & 15, fq = lane >> 4;
    const int K = g.K, nt = K / BK;
    unsigned voffA[2], voffB[2];
#pragma unroll
    for (int i = 0; i < 2; ++i) { int R, C; stage_rc(tid * 16 + i * 8192, R, C); const int Rb = Epi::PERM ? ((R & ~31) + perm32(R & 31)) : R;
        voffA[i] = (unsigned)(R * K + C) * 2u; voffB[i] = (unsigned)(Rb * K + C) * 2u; }
    const size_t kstep = (size_t)(BK * 2);
    const size_t hstep = (size_t)HALF * K * 2;
    const size_t tstep = 2 * hstep;
    const unsigned ldsw = (unsigned)wid * 1024u;
    const int aoff = lds_byte(wr * 64 + fr, fq * 8), boff = lds_byte(wc * 32 + fr, fq * 8);
#define PG8_SA(b, h) (((b) * 2 + (h)) * HTB)
#define PG8_SB(b, h) ((4 + (b) * 2 + (h)) * HTB)
#define PG8_STAGE(bufoff, gbase, voff) do { _Pragma("unroll") for (int _i = 0; _i < 2; ++_i) \
        __builtin_amdgcn_global_load_lds((const unsigned*)((const char*)(gbase) + (voff)[_i]), (PG8_LAS unsigned*)(lds + (bufoff) + ldsw + _i * 8192), 16, 0, 0); } while (0)
#define PG8_LDA(dst, b, h) do { _Pragma("unroll") for (int m = 0; m < 4; ++m) _Pragma("unroll") for (int k = 0; k < 2; ++k) dst[m][k] = *(const PG8_LAS bf16x8*)(lds + PG8_SA(b, h) + aoff + m * 2048 + k * 1024); } while (0)
#define PG8_LDB(dst, b, h) do { _Pragma("unroll") for (int n = 0; n < 2; ++n) _Pragma("unroll") for (int k = 0; k < 2; ++k) dst[n][k] = *(const PG8_LAS bf16x8*)(lds + PG8_SB(b, h) + boff + n * 2048 + k * 1024); } while (0)
#define PG8_MMA(ai, bj, At, Bt) do { __builtin_amdgcn_s_setprio(1); _Pragma("unroll") for (int m = 0; m < 4; ++m) _Pragma("unroll") for (int n = 0; n < 2; ++n) _Pragma("unroll") for (int k = 0; k < 2; ++k) \
        acc[ai][bj][m][n] = __builtin_amdgcn_mfma_f32_16x16x32_bf16(Bt[n][k], At[m][k], acc[ai][bj][m][n], 0, 0, 0); __builtin_amdgcn_s_setprio(0); } while (0)
#define PG8_WAIT_V(n) asm volatile("s_waitcnt vmcnt(" #n ")" ::: "memory")
#define PG8_WAIT_L(n) asm volatile("s_waitcnt lgkmcnt(" #n ")" ::: "memory")
#define PG8_BAR __builtin_amdgcn_s_barrier()
#define PG8_SCHED __builtin_amdgcn_sched_barrier(0)
    Unit cur, nxt; int ui = 0;
    if (!S.next(0, cur)) return;
    f32x4 acc[2][2][4][2];
#pragma unroll
    for (int a = 0; a < 2; ++a)
#pragma unroll
        for (int b = 0; b < 2; ++b)
#pragma unroll
            for (int m = 0; m < 4; ++m)
#pragma unroll
                for (int n = 0; n < 2; ++n) acc[a][b][m][n] = (f32x4){0.f, 0.f, 0.f, 0.f};
    bf16x8 At[4][2], B0[2][2], B1[2][2];
    const char* cA = (const char*)g.A + (size_t)cur.pm * tstep; const char* cB = (const char*)g.Bt + (size_t)cur.pn * tstep;
    S.a_ready(cur);
    if constexpr (SP2) {
        PG8_STAGE(PG8_SB(0, 0), cB, voffB); PG8_STAGE(PG8_SB(0, 1), cB + hstep, voffB); PG8_STAGE(PG8_SA(0, 0), cA, voffA); PG8_STAGE(PG8_SA(0, 1), cA + hstep, voffA);
        if (wr == 1) PG8_BAR;
        PG8_WAIT_V(2); PG8_BAR;
        PG8_STAGE(PG8_SB(1, 0), cB + kstep, voffB); PG8_STAGE(PG8_SA(1, 0), cA + kstep, voffA); PG8_STAGE(PG8_SB(1, 1), cB + hstep + kstep, voffB);
        PG8_WAIT_V(6); PG8_BAR;
    } else {
        PG8_STAGE(PG8_SB(0, 0), cB, voffB); PG8_STAGE(PG8_SA(0, 0), cA, voffA); PG8_STAGE(PG8_SB(0, 1), cB + hstep, voffB); PG8_STAGE(PG8_SA(0, 1), cA + hstep, voffA);
        if (wr == 1) PG8_BAR;
        PG8_WAIT_V(4); PG8_BAR;
        PG8_STAGE(PG8_SB(1, 0), cB + kstep, voffB); PG8_STAGE(PG8_SA(1, 0), cA + kstep, voffA); PG8_STAGE(PG8_SB(1, 1), cB + hstep + kstep, voffB);
        PG8_WAIT_V(6); PG8_BAR;
    }
    for (;;) {
        const bool has_next = S.next(ui + 1, nxt);
        const char* nA = has_next ? (const char*)g.A + (size_t)nxt.pm * tstep : cA; const char* nB = has_next ? (const char*)g.Bt + (size_t)nxt.pn * tstep : cB;
        for (int t = 0; t < nt; t += 2) {
            const bool last = (t == nt - 2);
            const char* a1 = cA + (size_t)(t + 1) * kstep;
            const char* a2 = last ? nA : cA + (size_t)(t + 2) * kstep; const char* b2 = last ? nB : cB + (size_t)(t + 2) * kstep;
            const char* a3 = a2 + kstep; const char* b3 = b2 + kstep;
            if (last && has_next) S.a_ready(nxt);
            if constexpr (SP2) {
            PG8_LDB(B0, 0, 0); PG8_LDB(B1, 0, 1); PG8_SCHED; PG8_LDA(At, 0, 0); PG8_STAGE(PG8_SA(1, 1), a1 + hstep, voffA);
            PG8_WAIT_V(8); PG8_WAIT_L(0); PG8_BAR; PG8_MMA(0, 0, At, B0); PG8_MMA(0, 1, At, B1); PG8_BAR; PG8_SCHED;
            PG8_LDA(At, 0, 1); PG8_STAGE(PG8_SB(0, 0), b2, voffB); PG8_STAGE(PG8_SB(0, 1), b2 + hstep, voffB); PG8_STAGE(PG8_SA(0, 0), a2, voffA);
            PG8_WAIT_V(8); PG8_WAIT_L(0); PG8_BAR; PG8_MMA(1, 0, At, B0); PG8_MMA(1, 1, At, B1); PG8_BAR; PG8_SCHED;
            PG8_LDB(B0, 1, 0); PG8_LDB(B1, 1, 1); PG8_SCHED; PG8_LDA(At, 1, 0); PG8_STAGE(PG8_SA(0, 1), a2 + hstep, voffA);
            PG8_WAIT_V(8); PG8_WAIT_L(0); PG8_BAR; PG8_MMA(0, 0, At, B0); PG8_MMA(0, 1, At, B1); PG8_BAR; PG8_SCHED;
            PG8_LDA(At, 1, 1); PG8_STAGE(PG8_SB(1, 0), b3, voffB); PG8_STAGE(PG8_SB(1, 1), b3 + hstep, voffB); PG8_STAGE(PG8_SA(1, 0), a3, voffA);
            PG8_WAIT_V(8); PG8_WAIT_L(0); PG8_BAR; PG8_MMA(1, 0, At, B0); PG8_MMA(1, 1, At, B1); PG8_BAR; PG8_SCHED;
            } else {
            PG8_LDB(B0, 0, 0); PG8_SCHED; PG8_LDA(At, 0, 0); PG8_STAGE(PG8_SA(1, 1), a1 + hstep, voffA);
            PG8_WAIT_L(8); PG8_BAR; PG8_WAIT_L(0); PG8_MMA(0, 0, At, B0); PG8_BAR; PG8_SCHED;
            PG8_LDB(B1, 0, 1); PG8_STAGE(PG8_SB(0, 0), b2, voffB);
            PG8_BAR; PG8_WAIT_L(0); PG8_MMA(0, 1, At, B1); PG8_BAR;
            PG8_LDA(At, 0, 1); PG8_STAGE(PG8_SA(0, 0), a2, voffA);
            PG8_BAR; PG8_WAIT_L(0); PG8_MMA(1, 0, At, B0); PG8_BAR; PG8_SCHED;
            PG8_STAGE(PG8_SB(0, 1), b2 + hstep, voffB);
            PG8_WAIT_V(6); PG8_BAR; PG8_MMA(1, 1, At, B1); PG8_BAR;
            PG8_LDB(B0, 1, 0); PG8_SCHED; PG8_LDA(At, 1, 0); PG8_STAGE(PG8_SA(0, 1), a2 + hstep, voffA);
            PG8_WAIT_L(8); PG8_BAR; PG8_WAIT_L(0); PG8_MMA(0, 0, At, B0); PG8_BAR; PG8_SCHED;
            PG8_LDB(B1, 1, 1); PG8_STAGE(PG8_SB(1, 0), b3, voffB);
            PG8_BAR; PG8_WAIT_L(0); PG8_MMA(0, 1, At, B1); PG8_BAR;
            PG8_LDA(At, 1, 1); PG8_STAGE(PG8_SA(1, 0), a3, voffA);
            PG8_BAR; PG8_WAIT_L(0); PG8_MMA(1, 0, At, B0); PG8_BAR; PG8_SCHED;
            PG8_STAGE(PG8_SB(1, 1), b3 + hstep, voffB);
            PG8_WAIT_V(6); PG8_BAR; PG8_MMA(1, 1, At, B1); PG8_BAR;
            }
        }
        unsigned long long _t0 = 0; if (MK_STAMP == 31) _t0 = __builtin_amdgcn_s_memrealtime();
        if constexpr (ALIGN_EPI) { if (wr == 0) PG8_BAR; }
        if (MK_STAMP == 31) tacc += __builtin_amdgcn_s_memrealtime() - _t0;
        if (MK_STAMP == 30 || MK_STAMP == 32) _t0 = __builtin_amdgcn_s_memrealtime();
        E(acc, cur, wr, wc, fr, fq, ui); S.done(cur);
        if (MK_STAMP == 30) { asm volatile("s_waitcnt vmcnt(0)" ::: "memory"); tacc += __builtin_amdgcn_s_memrealtime() - _t0; }
        if (MK_STAMP == 32) tacc += __builtin_amdgcn_s_memrealtime() - _t0;
        if (!has_next) break;
#pragma unroll
        for (int a = 0; a < 2; ++a)
#pragma unroll
            for (int b = 0; b < 2; ++b)
#pragma unroll
                for (int m = 0; m < 4; ++m)
#pragma unroll
                    for (int n = 0; n < 2; ++n) acc[a][b][m][n] = (f32x4){0.f, 0.f, 0.f, 0.f};
        cur = nxt; cA = nA; cB = nB; ++ui;
        if constexpr (ALIGN_EPI) { if (wr == 1) PG8_BAR; }
    }
    PG8_WAIT_V(0);
    if constexpr (!ALIGN_EPI) { if (wr == 0) PG8_BAR; }
    PG8_BAR;
#undef PG8_SA
#undef PG8_SB
#undef PG8_STAGE
#undef PG8_LDA
#undef PG8_LDB
#undef PG8_MMA
#undef PG8_WAIT_V
#undef PG8_WAIT_L
#undef PG8_BAR
#undef PG8_SCHED
}
}

constexpr int NBATCH = 2, SEQ = 16384, T = NBATCH * SEQ, DM = 1024, NH = 8, HD = 128, NBLK = 64, BLK = 256;
constexpr float EPS = 1e-6f;
constexpr float QSCALE = 0.088388347648318440f * 1.4426950408889634f;

constexpr size_t MiB = 1u << 20;
constexpr size_t WS_CTL = 0, CTL_ZERO_BYTES = 160 * 1024;
constexpr size_t WS_WAIN = 2 * MiB, WS_WAOUT = 6 * MiB, WS_WB1 = 8 * MiB, WS_WBOUT = 16 * MiB, WS_WRG = 18 * MiB;
constexpr size_t WS_RS0 = 19 * MiB;
constexpr size_t WS_SSQ1 = 20 * MiB;
constexpr size_t WS_ROPE = 22 * MiB;
constexpr size_t WS_SUMA = 30 * MiB, WS_SUMB = 30 * MiB + 512 * 1024;
constexpr size_t WS_KMEAN = 31 * MiB;
constexpr size_t WS_ENT = 32 * MiB;
constexpr size_t WS_OFFS = 34 * MiB;
constexpr size_t WS_LSE = 36 * MiB;
constexpr size_t WS_SEGA = 44 * MiB, WS_SEGB = 46 * MiB;
constexpr size_t SLOT = 64 * MiB;
constexpr size_t WS_S0 = 1 * SLOT;
constexpr size_t WS_S1 = 2 * SLOT;
constexpr size_t WS_S2 = 3 * SLOT;
constexpr size_t WS_S3 = 4 * SLOT;
constexpr size_t WS_S6 = 7 * SLOT;
constexpr size_t WS_END = 8 * SLOT;
constexpr int OFFS_PITCH = 72;
constexpr int CW_BAR = 4096;
constexpr int CW_NTOT = 16384;

constexpr int LDS_BYTES = 163840;
constexpr int MISC_OFF = LDS_BYTES - 256;

#define GAS __attribute__((address_space(1)))
#define LAS __attribute__((address_space(3)))
typedef unsigned short bf16;
typedef unsigned v4u __attribute__((ext_vector_type(4)));
typedef unsigned v2u __attribute__((ext_vector_type(2)));
typedef float f32x4 __attribute__((ext_vector_type(4)));
typedef float f32x16 __attribute__((ext_vector_type(16)));
typedef short bf16x8 __attribute__((ext_vector_type(8)));
typedef short s16x4 __attribute__((ext_vector_type(4)));
#define LDS_WAIT() asm volatile("s_waitcnt lgkmcnt(0)" ::: "memory")
#define VM_WAIT() asm volatile("s_waitcnt vmcnt(0)" ::: "memory")
#define SBAR() __builtin_amdgcn_sched_barrier(0)

__device__ __forceinline__ unsigned f2bf(float f) { unsigned u = __builtin_bit_cast(unsigned, f); return (u + 0x7fffu + ((u >> 16) & 1u)) >> 16; }
__device__ __forceinline__ unsigned pk2(float lo, float hi) { return pg8::cvt_pk_bf16(lo, hi); }
__device__ __forceinline__ float bflo(unsigned w) { return __builtin_bit_cast(float, w << 16); }
__device__ __forceinline__ float bfhi(unsigned w) { return __builtin_bit_cast(float, w & 0xffff0000u); }
__device__ __forceinline__ float bf1(unsigned short h) { return __builtin_bit_cast(float, ((unsigned)h) << 16); }
__device__ __forceinline__ float fast_exp2(float x) { return __builtin_amdgcn_exp2f(x); }
__device__ __forceinline__ float sigmoidf_(float v) { return __builtin_amdgcn_rcpf(1.f + fast_exp2(-v * 1.4426950408889634f)); }
__device__ __forceinline__ float siluf_(float v) { return v * sigmoidf_(v); }

#define XB_TMO      128
#define XB_XCNT(j)  (256  + 64 * (j))
#define XB_XSUB(j)  (1280 + 64 * (j))
#define XB_XGEN(j)  (2304 + 64 * (j))
#define XB_TOP      3328
#define XB_TOPGEN   3392
#define XCD_BAR_WORDS 3456
#define XB_SPIN_CAP (1u << 20)
__device__ __forceinline__ unsigned xb_ld(unsigned* p)              { return __hip_atomic_load(p, __ATOMIC_RELAXED, __HIP_MEMORY_SCOPE_AGENT); }
__device__ __forceinline__ unsigned xb_add(unsigned* p, unsigned v) { return __hip_atomic_fetch_add(p, v, __ATOMIC_RELAXED, __HIP_MEMORY_SCOPE_AGENT); }
__device__ __forceinline__ unsigned xb_xcc_id() { return (unsigned)__builtin_amdgcn_s_getreg((3 << 11) | 20) & 0xFu; }
#define XB_SPIN(cond, bar) do { unsigned _sp = 0; while (cond) { __builtin_amdgcn_s_sleep(1); \
    if ((++_sp & 255u) == 0u) { if (xb_ld(&(bar)[XB_TMO])) break; if (_sp > XB_SPIN_CAP) { atomicAdd(&(bar)[XB_TMO], 1u); break; } } } } while (0)
struct XcdBarrier { unsigned* bar; unsigned x; volatile LAS unsigned* st; };
__device__ __forceinline__ XcdBarrier xcd_barrier_post(unsigned* bar, volatile LAS unsigned* st) {
    XcdBarrier b; b.bar = bar; b.x = xb_xcc_id(); b.st = st;
    if (threadIdx.x == 0) (void)xb_add(&bar[XB_XCNT(b.x)], 1u);
    return b;
}
__device__ __forceinline__ void xcd_barrier_complete(unsigned* bar, unsigned x, unsigned& nloc, unsigned& nx) {
    const unsigned G = gridDim.x * gridDim.y * gridDim.z;
    unsigned sum, cnt, mine, sp = 0u;
    for (;;) {
        sum = 0u; cnt = 0u; mine = 0u;
#pragma unroll
        for (unsigned j = 0; j < 16; ++j) { const unsigned c = xb_ld(&bar[XB_XCNT(j)]); sum += c; cnt += (c > 0u) ? 1u : 0u; mine = (j == x) ? c : mine; }
        if (sum == G) break;
        __builtin_amdgcn_s_sleep(1);
        if ((++sp & 255u) == 0u) { if (xb_ld(&bar[XB_TMO])) break; if (sp > XB_SPIN_CAP) { atomicAdd(&bar[XB_TMO], 1u); break; } }
    }
    nloc = mine > 0u ? mine : 1u; nx = cnt > 0u ? cnt : 1u;
}
__device__ __forceinline__ void xcd_barrier(const XcdBarrier& b) {
    asm volatile("s_waitcnt vmcnt(0)" ::: "memory");
    __syncthreads();
    if (threadIdx.x == 0) {
        unsigned* bar = b.bar;
        __builtin_amdgcn_s_waitcnt(0);
        unsigned nloc = b.st[0], nx = b.st[1];
        if (nloc == 0u) { xcd_barrier_complete(bar, b.x, nloc, nx); b.st[0] = nloc; b.st[1] = nx; }
        const unsigned old = xb_add(&bar[XB_XSUB(b.x)], 1u);
        const unsigned gen = old / nloc;
        if (old + 1u == (gen + 1u) * nloc) {
            __builtin_amdgcn_fence(__ATOMIC_RELEASE, "agent");
            asm volatile("s_waitcnt vmcnt(0)" ::: "memory");
            const unsigned og = xb_add(&bar[XB_TOP], 1u);
            const unsigned tg = og / nx;
            if (og + 1u != (tg + 1u) * nx) XB_SPIN(xb_ld(&bar[XB_TOP]) < (tg + 1u) * nx, bar);
            xb_add(&bar[XB_XGEN(b.x)], 1u);
            __builtin_amdgcn_fence(__ATOMIC_ACQUIRE, "agent");
            asm volatile("s_waitcnt vmcnt(0)" ::: "memory");
        } else {
            XB_SPIN(xb_ld(&bar[XB_XGEN(b.x)]) == gen, bar);
            __builtin_amdgcn_fence(__ATOMIC_ACQUIRE, "agent");
            asm volatile("s_waitcnt vmcnt(0)" ::: "memory");
        }
    }
    __syncthreads();
}

struct Args { const float* in[18]; float* out; unsigned char* ws; int ph_lo, ph_hi; };
__device__ __forceinline__ const float* inp(int k) {
    const __attribute__((address_space(4))) Args* ap = (const __attribute__((address_space(4))) Args*)__builtin_amdgcn_kernarg_segment_ptr();
    asm volatile("" : "+s"(ap));
    return ap->in[k];
}
struct Frame {
    LAS unsigned char* lds;
    int tid, lane, wave, vcu, G;
    unsigned long long tacc, t0;
    bool probe;
    float* out;
    unsigned char* ws;
};
#define TS_BEGIN(ID) do { if (MK_STAMP == (ID)) F.t0 = __builtin_amdgcn_s_memrealtime(); } while (0)
#define TS_END(ID) do { if (MK_STAMP == (ID)) F.tacc += __builtin_amdgcn_s_memrealtime() - F.t0; } while (0)
__device__ __forceinline__ float wave_sum(float v) {
#pragma unroll
    for (int o = 1; o < 64; o <<= 1) v += __shfl_xor(v, o);
    return v;
}

namespace pg8 {
struct EpiAll {
    static constexpr bool PERM = true, AFTER_DRAIN = false;
    int mode;
    unsigned char* ws;
    float* xout;
    bool probe;
    PG8_LAS float* ex;
    __device__ __forceinline__ void operator()(const f32x4 (&acc)[2][2][4][2], const Unit& u, int wr, int wc, int fr, int fq, int ui) const {
        const PG8_LAS float* const rst = ex + 2560 + ui * 256 + wr * 64 + fr;
        const int row0 = u.pm * BM + wr * 64 + fr;
        bf16_t* const o0 = (bf16_t*)(ws + (mode == 1 ? WS_S6 : WS_S1)); bf16_t* const o1 = (bf16_t*)(ws + WS_S2); bf16_t* const o2 = (bf16_t*)(ws + WS_S0); bf16_t* const o3 = (bf16_t*)xout;
        const float* const rs = (const float*)(ws + (mode == 0 ? WS_RS0 : WS_SSQ1)); float* const ssq = (float*)(ws + WS_SSQ1);
        if (mode == 2 && ((u.pn >> 2) == 0 || (u.pn >> 2) == 2)) {
            const bool isK = (u.pn >> 2) == 0;
            const float* G = isK ? inp(13) : inp(16); const float osc = isK ? 1.0f : QSCALE;
            const int i0 = 16 * wc + 4 * fq;
            const f32x4 glo = *(const f32x4*)(G + i0), ghi = *(const f32x4*)(G + 64 + i0);
            const float* RC = (const float*)(ws + WS_ROPE); const float* RSn = RC + (size_t)SEQ * 64;
            bf16_t* base = isK ? o0 : o2; const int col0 = (u.pn & 3) * BM + wc * 32 + 8 * fq;
            PG8_LAS float* SS = ex; PG8_LAS float* KM = ex + 2048;
            f32x4 csv[2][4], snv[2][4];
#pragma unroll
            for (int i = 0; i < 4; ++i) { const int pos = (row0 + i * 16) & (SEQ - 1); csv[0][i] = *(const f32x4*)(RC + (size_t)pos * 64 + i0); snv[0][i] = *(const f32x4*)(RSn + (size_t)pos * 64 + i0); }
            float rsv[8];
#pragma unroll
            for (int i = 0; i < 8; ++i) rsv[i] = rst[(i >> 2) * 128 + (i & 3) * 16];
            const f32x4 g1 = glo * osc, g2 = ghi * osc;
#pragma unroll
            for (int ai = 0; ai < 2; ++ai)
#pragma unroll
                for (int m = 0; m < 4; ++m) {
#pragma unroll
                    for (int bj = 0; bj < 2; ++bj) { const f32x4 a0 = acc[ai][bj][m][0], a1 = acc[ai][bj][m][1]; const f32x4 q = a0 * a0 + a1 * a1;
                        float ss = (q[0] + q[1]) + (q[2] + q[3]);
                        { auto r = __builtin_amdgcn_permlane16_swap(__float_as_uint(ss), __float_as_uint(ss), false, false); ss = __uint_as_float(r[0]) + __uint_as_float(r[1]); }
                        { auto r = __builtin_amdgcn_permlane32_swap(__float_as_uint(ss), __float_as_uint(ss), false, false); ss = __uint_as_float(r[0]) + __uint_as_float(r[1]); }
                        if (fq == 0) SS[((wr * 128 + ai * 64 + m * 16 + fr) * 2 + bj) * 4 + wc] = ss; } }
            asm volatile("s_waitcnt lgkmcnt(0)" ::: "memory"); __builtin_amdgcn_s_barrier(); asm volatile("" ::: "memory");
            f32x4 cs[2][2];
#pragma unroll
            for (int bj = 0; bj < 2; ++bj) { cs[bj][0] = (f32x4){0.f, 0.f, 0.f, 0.f}; cs[bj][1] = (f32x4){0.f, 0.f, 0.f, 0.f}; }
#pragma unroll
            for (int i = 0; i < 4; ++i) { const int pos = (row0 + HALF + i * 16) & (SEQ - 1); csv[1][i] = *(const f32x4*)(RC + (size_t)pos * 64 + i0); snv[1][i] = *(const f32x4*)(RSn + (size_t)pos * 64 + i0); }
#pragma unroll
            for (int ai = 0; ai < 2; ++ai) {
#pragma unroll
                for (int m = 0; m < 4; ++m) { const int row = row0 + ai * HALF + m * 16;
                    const f32x4 cs4 = csv[ai][m], sn4 = snv[ai][m]; const float sc = rsv[ai * 4 + m];
                    bf16_t* rowp = base + (size_t)row * DM + col0;
#pragma unroll
                    for (int bj = 0; bj < 2; ++bj) { const f32x4 pt = *(const PG8_LAS f32x4*)&SS[((wr * 128 + ai * 64 + m * 16 + fr) * 2 + bj) * 4];
                        const float tot = (pt[0] + pt[1]) + (pt[2] + pt[3]);
                        const float rinv = __builtin_amdgcn_rsqf(tot * (sc * sc) * (1.0f / HD) + EPS) * sc;
                        const f32x4 y1 = acc[ai][bj][m][0] * g1, y2 = acc[ai][bj][m][1] * g2;
                        const f32x4 o1 = (y1 * cs4 - y2 * sn4) * rinv, o2 = (y2 * cs4 + y1 * sn4) * rinv;
                        cs[bj][0] += o1; cs[bj][1] += o2;
                        u32x4 w; w.x = cvt_pk_bf16(o1[0], o1[1]); w.y = cvt_pk_bf16(o1[2], o1[3]); w.z = cvt_pk_bf16(o2[0], o2[1]); w.w = cvt_pk_bf16(o2[2], o2[3]);
                        *(u32x4*)(rowp + bj * HALF) = w; } }
            }
            if (isK) {
#pragma unroll
                for (int bj = 0; bj < 2; ++bj)
#pragma unroll
                    for (int e = 0; e < 8; ++e) { float v = cs[bj][e >> 2][e & 3]; v += dpp_f(v, 0xB1); v += dpp_f(v, 0x4E); v += dpp_f(v, 0x141); v += dpp_f(v, 0x140); cs[bj][e >> 2][e & 3] = v; }
                if (fr == 0) {
#pragma unroll
                    for (int bj = 0; bj < 2; ++bj)
#pragma unroll
                        for (int e = 0; e < 8; ++e) KM[wr * 256 + bj * 128 + 32 * wc + 8 * fq + e] = cs[bj][e >> 2][e & 3]; }
                asm volatile("s_waitcnt lgkmcnt(0)" ::: "memory"); __builtin_amdgcn_s_barrier(); asm volatile("" ::: "memory");
                if (wr == 0 && fr == 0) { float* KMEAN = (float*)(ws + WS_KMEAN);
#pragma unroll
                    for (int bj = 0; bj < 2; ++bj) { const int hh = (u.pn & 3) * 2 + bj; float* kp = KMEAN + ((size_t)((u.pm >> 6) * NH + hh) * NBLK + (u.pm & 63)) * HD + 32 * wc + 8 * fq;
                        const int c = bj * 128 + 32 * wc + 8 * fq;
#pragma unroll
                        for (int e = 0; e < 8; ++e) kp[e] = (KM[c + e] + KM[256 + c + e]) * (1.0f / BLK); } }
            }
        } else if (mode == 0 || mode == 2) {
            const int tt = u.pn >> 2; const bool act = (mode == 0) ? (tt == 1) : (tt == 3);
            bf16_t* base = tt == 0 ? o0 : (tt == 1 ? o1 : (tt == 2 ? o2 : o3)); const int col0 = (u.pn & 3) * BM + wc * 32 + 8 * fq;
            float sv[8];
#pragma unroll
            for (int i = 0; i < 8; ++i) sv[i] = rst[(i >> 2) * 128 + (i & 3) * 16];
#pragma unroll
            for (int ai = 0; ai < 2; ++ai)
#pragma unroll
                for (int m = 0; m < 4; ++m) { const int row = row0 + ai * HALF + m * 16; const float s = sv[ai * 4 + m];
                    bf16_t* rowp = base + (size_t)row * DM + col0;
#pragma unroll
                    for (int bj = 0; bj < 2; ++bj) { f32x4 v0 = acc[ai][bj][m][0] * s, v1 = acc[ai][bj][m][1] * s;
                        if (act) {
#pragma unroll
                            for (int j = 0; j < 4; ++j) { v0[j] = siluf_(v0[j]); v1[j] = siluf_(v1[j]); } }
                        u32x4 w; w.x = cvt_pk_bf16(v0[0], v0[1]); w.y = cvt_pk_bf16(v0[2], v0[3]); w.z = cvt_pk_bf16(v1[0], v1[1]); w.w = cvt_pk_bf16(v1[2], v1[3]);
                        *(u32x4*)(rowp + bj * HALF) = w; } }
        } else if (mode == 1) {
            const bf16_t* const xin = (const bf16_t*)(ws + WS_S0);
            const int col0 = u.pn * BM + wc * 32 + 8 * fq;
#pragma unroll
            for (int ai = 0; ai < 2; ++ai) {
                f32x4 xv[4][2][2];
#pragma unroll
                for (int m = 0; m < 4; ++m) { const size_t off = (size_t)(row0 + ai * HALF + m * 16) * DM + col0;
#pragma unroll
                    for (int bj = 0; bj < 2; ++bj) { const u32x4 x4 = __builtin_nontemporal_load((const u32x4*)(xin + off + bj * HALF));
                        xv[m][bj][0] = (f32x4){__builtin_bit_cast(float, x4.x << 16), __builtin_bit_cast(float, x4.x & 0xffff0000u), __builtin_bit_cast(float, x4.y << 16), __builtin_bit_cast(float, x4.y & 0xffff0000u)};
                        xv[m][bj][1] = (f32x4){__builtin_bit_cast(float, x4.z << 16), __builtin_bit_cast(float, x4.z & 0xffff0000u), __builtin_bit_cast(float, x4.w << 16), __builtin_bit_cast(float, x4.w & 0xffff0000u)}; } }
#pragma unroll
                for (int m = 0; m < 4; ++m) { const int row = row0 + ai * HALF + m * 16; const size_t off = (size_t)row * DM + col0; float ss = 0.f;
#pragma unroll
                    for (int bj = 0; bj < 2; ++bj) { const f32x4 v0 = acc[ai][bj][m][0] + xv[m][bj][0], v1 = acc[ai][bj][m][1] + xv[m][bj][1];
                        ss += ((v0[0] * v0[0] + v0[1] * v0[1]) + (v0[2] * v0[2] + v0[3] * v0[3])) + ((v1[0] * v1[0] + v1[1] * v1[1]) + (v1[2] * v1[2] + v1[3] * v1[3]));
                        u32x4 w; w.x = cvt_pk_bf16(v0[0], v0[1]); w.y = cvt_pk_bf16(v0[2], v0[3]); w.z = cvt_pk_bf16(v1[0], v1[1]); w.w = cvt_pk_bf16(v1[2], v1[3]);
                        *(u32x4*)(o0 + off + bj * HALF) = w; }
                    { auto r = __builtin_amdgcn_permlane16_swap(__float_as_uint(ss), __float_as_uint(ss), false, false); ss = __uint_as_float(r[0]) + __uint_as_float(r[1]); }
                    { auto r = __builtin_amdgcn_permlane32_swap(__float_as_uint(ss), __float_as_uint(ss), false, false); ss = __uint_as_float(r[0]) + __uint_as_float(r[1]); }
                    if (fq == 0) ssq[(size_t)row * 16 + u.pn * 4 + wc] = ss; }
            }
        } else {
            const int col0 = u.pn * BM + wc * 32 + 8 * fq;
            u32x4 xr[8][2];
#pragma unroll
            for (int i = 0; i < 8; ++i) { const size_t off = (size_t)(row0 + (i >> 2) * HALF + (i & 3) * 16) * DM + col0;
                xr[i][0] = __builtin_nontemporal_load((const u32x4*)((const bf16_t*)(ws + WS_S6) + off)); xr[i][1] = __builtin_nontemporal_load((const u32x4*)((const bf16_t*)(ws + WS_S6) + off + HALF)); }
#pragma unroll
            for (int ai = 0; ai < 2; ++ai)
#pragma unroll
                for (int m = 0; m < 4; ++m) { const size_t off = (size_t)(row0 + ai * HALF + m * 16) * DM + col0;
#pragma unroll
                    for (int bj = 0; bj < 2; ++bj) { float* p = xout + off + bj * HALF; const u32x4 x4 = xr[ai * 4 + m][bj];
                        const f32x4 xa = {__builtin_bit_cast(float, x4.x << 16), __builtin_bit_cast(float, x4.x & 0xffff0000u), __builtin_bit_cast(float, x4.y << 16), __builtin_bit_cast(float, x4.y & 0xffff0000u)};
                        const f32x4 xb = {__builtin_bit_cast(float, x4.z << 16), __builtin_bit_cast(float, x4.z & 0xffff0000u), __builtin_bit_cast(float, x4.w << 16), __builtin_bit_cast(float, x4.w & 0xffff0000u)};
                        const f32x4 v0 = acc[ai][bj][m][0] + xa, v1 = acc[ai][bj][m][1] + xb; const bool lower = (fr & 8) == 0;
                        const f32x4 snd = lower ? v1 : v0; f32x4 rcv;
#pragma unroll
                        for (int e = 0; e < 4; ++e) rcv[e] = dpp_f(snd[e], 0x128);
                        const f32x4 s1 = lower ? v0 : rcv, s2 = lower ? rcv : v1;
                        float* pr = xout + (size_t)(u.pm * BM + wr * 64 + ai * HALF + m * 16 + (fr & 7)) * DM + u.pn * BM + bj * HALF + wc * 32 + 8 * fq + (lower ? 0 : 4);
                        __builtin_nontemporal_store(s1, (f32x4*)pr); __builtin_nontemporal_store(s2, (f32x4*)(pr + 8 * DM)); (void)p; } }
        }
    }
};
}

__device__ __forceinline__ int fperm(int p) { return ((p >> 2) & 1) * 64 + (p >> 5) * 16 + ((p >> 3) & 3) * 4 + (p & 3); }
template <int MODE  >
__device__ __forceinline__ void p0_transpose_item(const float* W, int ldw, int Kd, bf16* WT, int drow0, const float* gain, LAS float* scr, int k0, int n0, int lane) {
    const int g = lane & 7, kr = lane >> 3;
    const int nn = n0 + 4 * g;
    const int sc = (MODE == 1 && nn < 1024) ? ((nn & ~127) + fperm(nn & 127)) : nn;
    f32x4 v[8];
#pragma unroll
    for (int i = 0; i < 8; ++i) v[i] = *(const f32x4*)(W + (size_t)(k0 + kr + 8 * i) * ldw + sc);
#pragma unroll
    for (int i = 0; i < 8; ++i) { const int kk = kr + 8 * i; const float gm = gain ? gain[k0 + kk] : 1.0f;
        scr[kk * 33 + 4 * g + 0] = v[i][0] * gm; scr[kk * 33 + 4 * g + 1] = v[i][1] * gm; scr[kk * 33 + 4 * g + 2] = v[i][2] * gm; scr[kk * 33 + 4 * g + 3] = v[i][3] * gm; }
    LDS_WAIT(); asm volatile("" ::: "memory");
    const int c = lane & 7;
#pragma unroll
    for (int j = 0; j < 4; ++j) { const int n = (lane >> 3) + 8 * j; const LAS float* sp = scr + (8 * c) * 33 + n;
        v4u o; o.x = pk2(sp[0 * 33], sp[1 * 33]); o.y = pk2(sp[2 * 33], sp[3 * 33]); o.z = pk2(sp[4 * 33], sp[5 * 33]); o.w = pk2(sp[6 * 33], sp[7 * 33]);
        *(v4u*)(WT + (size_t)(drow0 + n0 + n) * Kd + k0 + 8 * c) = o; }
    LDS_WAIT(); asm volatile("" ::: "memory");
}
__device__ __forceinline__ void sincos_acc(float angf, float& s, float& c) {
    const double a = (double)angf;
    const double k = __builtin_rint(a * 0.63661977236758134308);
    const double y = __builtin_fma(-k, 1.57079632679489661923, a) - k * 6.123233995736766e-17;
    const double y2 = y * y;
    double sp = -1.0 / 1307674368000.0; sp = sp * y2 + 1.0 / 6227020800.0; sp = sp * y2 - 1.0 / 39916800.0; sp = sp * y2 + 1.0 / 362880.0; sp = sp * y2 - 1.0 / 5040.0; sp = sp * y2 + 1.0 / 120.0; sp = sp * y2 - 1.0 / 6.0; sp = sp * y2 + 1.0;
    const double sy = sp * y;
    double cp = 1.0 / 20922789888000.0; cp = cp * y2 - 1.0 / 87178291200.0; cp = cp * y2 + 1.0 / 479001600.0; cp = cp * y2 - 1.0 / 3628800.0; cp = cp * y2 + 1.0 / 40320.0; cp = cp * y2 - 1.0 / 720.0; cp = cp * y2 + 1.0 / 24.0; cp = cp * y2 - 0.5; cp = cp * y2 + 1.0;
    const int q = ((int)k) & 3;
    const double ss = (q == 0) ? sy : (q == 1) ? cp : (q == 2) ? -sy : -cp;
    const double cc = (q == 0) ? cp : (q == 1) ? -sy : (q == 2) ? -cp : sy;
    s = (float)ss; c = (float)cc;
}
__device__ __forceinline__ void p0_prologue(Frame& F) {
    static constexpr float ROPE_INV[64] = {
        1.000000000e+00f, 8.659643531e-01f, 7.498942018e-01f, 6.493816376e-01f, 5.623413324e-01f, 4.869675338e-01f, 4.216965139e-01f, 3.651741147e-01f, 3.162277639e-01f, 2.738419771e-01f, 2.371373773e-01f, 2.053525001e-01f, 1.778279394e-01f, 1.539926529e-01f, 1.333521456e-01f, 1.154781953e-01f,
        1.000000015e-01f, 8.659642935e-02f, 7.498942316e-02f, 6.493816525e-02f, 5.623413250e-02f, 4.869675264e-02f, 4.216964915e-02f, 3.651741147e-02f, 3.162277490e-02f, 2.738419548e-02f, 2.371373773e-02f, 2.053525113e-02f, 1.778279431e-02f, 1.539926510e-02f, 1.333521400e-02f, 1.154781971e-02f,
        9.999999776e-03f, 8.659643121e-03f, 7.498942316e-03f, 6.493816152e-03f, 5.623413250e-03f, 4.869675264e-03f, 4.216964822e-03f, 3.651741194e-03f, 3.162277630e-03f, 2.738419687e-03f, 2.371373819e-03f, 2.053525066e-03f, 1.778279431e-03f, 1.539926510e-03f, 1.333521446e-03f, 1.154782018e-03f,
        1.000000047e-03f, 8.659643354e-04f, 7.498941850e-04f, 6.493816036e-04f, 5.623413017e-04f, 4.869675322e-04f, 4.216965172e-04f, 3.651741135e-04f, 3.162277571e-04f, 2.738419571e-04f, 2.371373703e-04f, 2.053525095e-04f, 1.778279402e-04f, 1.539926598e-04f, 1.333521504e-04f, 1.154782003e-04f};
    LAS float* scr = (LAS float*)(F.lds + F.wave * 16384);
    const int gw = F.vcu * 8 + F.wave, NGW = F.G * 8;
    bf16* WAIN = (bf16*)(F.ws + WS_WAIN); bf16* WAOUT = (bf16*)(F.ws + WS_WAOUT); bf16* WB1 = (bf16*)(F.ws + WS_WB1); bf16* WBOUT = (bf16*)(F.ws + WS_WBOUT); bf16* WRG = (bf16*)(F.ws + WS_WRG);
    constexpr int I0 = 16 * 64, I1 = 16 * 32, I2 = 16 * 64, I3 = 16 * 64, I4 = 16 * 32, I5 = 16 * 8;
    constexpr int NITEMS = I0 + I1 + I2 + I3 + I4 + I5;
#define P0_ITEM(IT) do { int r = (IT);\
        if (r < I0) { p0_transpose_item<0>(inp(2), 2048, DM, WAIN, 0, inp(1), scr, (r / 64) * 64, (r % 64) * 32, F.lane); break; } r -= I0;\
        if (r < I1) { p0_transpose_item<0>(inp(10), 1024, DM, WAOUT, 0, nullptr, scr, (r / 32) * 64, (r % 32) * 32, F.lane); break; } r -= I1;\
        if (r < I2) { p0_transpose_item<1>(inp(12), 2048, DM, WB1, 0, inp(11), scr, (r / 64) * 64, (r % 64) * 32, F.lane); break; } r -= I2;\
        if (r < I3) { p0_transpose_item<1>(inp(15), 2048, DM, WB1, 2048, inp(14), scr, (r / 64) * 64, (r % 64) * 32, F.lane); break; } r -= I3;\
        if (r < I4) { p0_transpose_item<0>(inp(17), 1024, DM, WBOUT, 0, nullptr, scr, (r / 32) * 64, (r % 32) * 32, F.lane); break; } r -= I4;\
        { const int mat = r >> 3, sub = r & 7, n = mat >> 1, which = mat & 1;   \
          const float* W = (which ? inp(7) : inp(5)) + (size_t)n * 128 * 128;\
          p0_transpose_item<0>(W, 128, 128, WRG, n * 256 + which * 128, nullptr, scr, (sub >> 2) * 64, (sub & 3) * 32, F.lane); } } while (0)
    bf16* XB = (bf16*)(F.ws + WS_S0); float* RS0 = (float*)(F.ws + WS_RS0);
    int item = gw;
    for (int m0 = gw * 8; m0 < T; m0 += NGW * 8) {
        const float* xin = inp(0);
        f32x4 v[8][4];
#pragma unroll
        for (int r = 0; r < 8; ++r) { const f32x4* xr = (const f32x4*)(xin + (size_t)(m0 + r) * DM) + F.lane;
#pragma unroll
            for (int j = 0; j < 4; ++j) v[r][j] = __builtin_nontemporal_load(xr + 64 * j); }
        if (item < NITEMS) { P0_ITEM(item); item += NGW; }
#pragma unroll
        for (int r = 0; r < 8; ++r) { float s = 0.f;
#pragma unroll
            for (int j = 0; j < 4; ++j) s += (v[r][j][0] * v[r][j][0] + v[r][j][1] * v[r][j][1]) + (v[r][j][2] * v[r][j][2] + v[r][j][3] * v[r][j][3]);
            s = wave_sum(s);
            if (F.lane == 0) RS0[m0 + r] = 1.0f / sqrtf(s * (1.0f / DM) + EPS);
            v2u* o8 = (v2u*)(XB + (size_t)(m0 + r) * DM) + F.lane;
#pragma unroll
            for (int j = 0; j < 4; ++j) { v2u w; w.x = pk2(v[r][j][0], v[r][j][1]); w.y = pk2(v[r][j][2], v[r][j][3]); o8[64 * j] = w; } }
    }
    for (; item < NITEMS; item += NGW) P0_ITEM(item);
#undef P0_ITEM
    float* RC = (float*)(F.ws + WS_ROPE); float* RSn = RC + (size_t)SEQ * 64;
    for (int idx = gw * 64 + F.lane; idx < SEQ * 64; idx += NGW * 64) {
        const int pos = idx >> 6, i = idx & 63;
        const float inv = ROPE_INV[i];
        const float ang = (float)pos * inv; float s, c; sincos_acc(ang, s, c);
        RC[idx] = c; RSn[idx] = s;
    }
}

constexpr int XB_PITCH = 272;
constexpr int XB_TILE = 256 * XB_PITCH;
__device__ __forceinline__ int xb_addr(int tok, int byteoff) { return tok * XB_PITCH + ((((byteoff >> 4) ^ (((tok >> 6) & 3) << 2)) << 4) | (byteoff & 15)); }
__device__ __forceinline__ unsigned pk_half2(float lo, float hi) { const _Float16 a = (_Float16)lo, b = (_Float16)hi; return (unsigned)__builtin_bit_cast(unsigned short, a) | ((unsigned)__builtin_bit_cast(unsigned short, b) << 16); }
__device__ __forceinline__ float half_lo(unsigned w) { return (float)__builtin_bit_cast(_Float16, (unsigned short)(w & 0xffffu)); }
__device__ __forceinline__ float half_hi(unsigned w) { return (float)__builtin_bit_cast(_Float16, (unsigned short)(w >> 16)); }
constexpr float LA_SCALE = 256.0f;
__device__ __forceinline__ void scan_load_raw(Frame& F, int b, int c, int n, v4u (&raw)[11]) {
    const bf16* UX = (const bf16*)(F.ws + WS_S1); const int cg = F.tid & 15, tr = F.tid >> 4, chb = n * 128 + cg * 8; const size_t rowbase = (size_t)b * SEQ + c * BLK;
#pragma unroll
    for (int i = 0; i < 11; ++i) { const int t = 8 * tr + i - 3; const bool ok = (c > 0) || (t >= 0);
        raw[i] = ok ? __builtin_nontemporal_load((const v4u*)(UX + (size_t)((long)rowbase + t) * DM + chb)) : (v4u){0u, 0u, 0u, 0u}; }
}
constexpr int SCAN_WTAB = 96 * 1024;
struct ScanW { bf16x8 Br[4], Bi[4]; int n; };
__device__ __forceinline__ void scan_load_w(Frame& F, int n, ScanW& W) {
    const int w = F.wave, cl = F.lane & 15, q = F.lane >> 4;
    const bf16* WRG = (const bf16*)(F.ws + WS_WRG);
#pragma unroll
    for (int ks = 0; ks < 4; ++ks) { W.Br[ks] = *(const bf16x8*)(WRG + (size_t)(n * 256 + 16 * w + cl) * 128 + 32 * ks + 8 * q);
                                     W.Bi[ks] = *(const bf16x8*)(WRG + (size_t)(n * 256 + 128 + 16 * w + cl) * 128 + 32 * ks + 8 * q); }
    __syncthreads();
    if (F.tid < 160) { const int cgt = F.tid / 10, j = F.tid % 10; const int chb = n * 128 + cgt * 8;
        const float* src = (j < 8) ? (inp(3) + (j >> 1) * DM + chb + 4 * (j & 1)) : (inp(4) + chb + 4 * (j & 1));
        *(LAS f32x4*)(F.lds + SCAN_WTAB + F.tid * 16) = *(const f32x4*)src; }
    if (F.tid >= 256 && F.tid < 384) { const int cc = F.tid - 256, ch = n * 128 + cc;
        const float lam = inp(9)[ch]; const float z = -lam; const float sp = fmaxf(z, 0.f) + log1pf(expf(-fabsf(z)));
        const float c8 = -8.0f * sp;
        *(LAS f32x4*)(F.lds + SCAN_WTAB + 4096 + cc * 16) = (f32x4){inp(6)[ch] * -1.4426950408889634f, inp(8)[ch] * -1.4426950408889634f, c8, c8 * 1.4426950408889634f}; }
    __syncthreads();
    W.n = n;
}
__device__ __forceinline__ void scan_unit(Frame& F, int b, int c, int n, v4u (&raw)[11], int nb, int nc, int nn, const ScanW& W) {
    LAS unsigned char* XBt = F.lds;
    unsigned* LB = (unsigned*)(F.ws + WS_S3);
    float* SUMA = (float*)(F.ws + WS_SUMA); float* SUMB = (float*)(F.ws + WS_SUMB); float* SEGA = (float*)(F.ws + WS_SEGA); float* SEGB = (float*)(F.ws + WS_SEGB);
    const int t0 = c * BLK; const size_t rowbase = (size_t)b * SEQ + t0;
    TS_BEGIN(1);
    {
        const int cg = F.tid & 15, tr = F.tid >> 4, chb = n * 128 + cg * 8;
        typedef float f32x2 __attribute__((ext_vector_type(2)));
        (void)chb;
        const LAS f32x4* wt = (const LAS f32x4*)(F.lds + SCAN_WTAB) + cg * 10;
        f32x2 w2[4][4], b2[4];
#pragma unroll
        for (int k = 0; k < 4; ++k) { const f32x4 a = wt[2 * k], bb = wt[2 * k + 1];
            w2[k][0] = (f32x2){a[0], a[1]}; w2[k][1] = (f32x2){a[2], a[3]}; w2[k][2] = (f32x2){bb[0], bb[1]}; w2[k][3] = (f32x2){bb[2], bb[3]}; }
        { const f32x4 a = wt[8], bb = wt[9]; b2[0] = (f32x2){a[0], a[1]}; b2[1] = (f32x2){a[2], a[3]}; b2[2] = (f32x2){bb[0], bb[1]}; b2[3] = (f32x2){bb[2], bb[3]}; }
#pragma unroll
        for (int i = 0; i < 8; ++i) { f32x2 o[4] = {b2[0], b2[1], b2[2], b2[3]};
#pragma unroll
            for (int k = 0; k < 4; ++k) { const v4u r = raw[i + k];
                o[0] = __builtin_elementwise_fma(w2[k][0], (f32x2){bflo(r.x), bfhi(r.x)}, o[0]); o[1] = __builtin_elementwise_fma(w2[k][1], (f32x2){bflo(r.y), bfhi(r.y)}, o[1]);
                o[2] = __builtin_elementwise_fma(w2[k][2], (f32x2){bflo(r.z), bfhi(r.z)}, o[2]); o[3] = __builtin_elementwise_fma(w2[k][3], (f32x2){bflo(r.w), bfhi(r.w)}, o[3]); }
            v4u pk; pk.x = pk2(o[0][0], o[0][1]); pk.y = pk2(o[1][0], o[1][1]); pk.z = pk2(o[2][0], o[2][1]); pk.w = pk2(o[3][0], o[3][1]);
            *(LAS v4u*)(XBt + xb_addr(8 * tr + i, cg * 16)) = pk; }
    }
    __syncthreads();
    if (nc >= 0) scan_load_raw(F, nb, nc, nn, raw);
    TS_END(1); TS_BEGIN(2);
    {
        const int w = F.wave, cl = F.lane & 15, q = F.lane >> 4;
        const int ch = n * 128 + 16 * w + cl;
        const f32x4 gc = *(const LAS f32x4*)(F.lds + SCAN_WTAB + 4096 + (16 * w + cl) * 16);
        const float rb = gc[0], ib = gc[1], c8 = gc[2], c8l = gc[3];
        float Arun = 1.f, h = 0.f;
        const int arow = 64 * (cl >> 2) + (cl & 3);
        int aoffs[4];
#pragma unroll
        for (int ks = 0; ks < 4; ++ks) aoffs[ks] = xb_addr(arow, (32 * ks + 8 * q) * 2);
        const int eoff = xb_addr(64 * q, (16 * w + cl) * 2);
        unsigned* lbp = LB + (rowbase + 64 * q) * DM + ch;
#pragma unroll 2
        for (int mt = 0; mt < 16; ++mt) {
            pg8::f32x4 accR = {0.f, 0.f, 0.f, 0.f}, accI = {0.f, 0.f, 0.f, 0.f};
#pragma unroll
            for (int ks = 0; ks < 4; ++ks) { const bf16x8 a = *(const LAS bf16x8*)(XBt + aoffs[ks] + 4 * mt * XB_PITCH);
                accR = __builtin_amdgcn_mfma_f32_16x16x32_bf16(a, W.Br[ks], accR, 0, 0, 0);
                accI = __builtin_amdgcn_mfma_f32_16x16x32_bf16(a, W.Bi[ks], accI, 0, 0, 0); }
            typedef float f32x2 __attribute__((ext_vector_type(2)));
#pragma unroll
            for (int rp = 0; rp < 4; rp += 2) {
                const int eo = eoff + (4 * mt + rp) * XB_PITCH;
                const f32x2 xv = {bf1(*(const LAS unsigned short*)(XBt + eo)), bf1(*(const LAS unsigned short*)(XBt + eo + XB_PITCH))};
                const f32x2 zr = (f32x2){accR[rp], accR[rp + 1]} * -1.4426950408889634f + rb, zi = (f32x2){accI[rp], accI[rp + 1]} * -1.4426950408889634f + ib;
                const f32x2 er = {fast_exp2(zr[0]), fast_exp2(zr[1])}, ei = {fast_exp2(zi[0]), fast_exp2(zi[1])};
                const f32x2 dr = er + 1.0f, di = ei + 1.0f;
                const f32x2 rg = {__builtin_amdgcn_rcpf(dr[0]), __builtin_amdgcn_rcpf(dr[1])}, ig = {__builtin_amdgcn_rcpf(di[0]), __builtin_amdgcn_rcpf(di[1])};
                const f32x2 la2 = rg * c8l;
                const f32x2 av = {fast_exp2(la2[0]), fast_exp2(la2[1])};
                const f32x2 x2 = rg * (2.f * c8);
                f32x2 pz = x2 * (1.0f / 120.0f) + (1.0f / 24.0f); pz = pz * x2 + (1.0f / 6.0f); pz = pz * x2 + 0.5f; pz = pz * x2 + 1.0f;
                const f32x2 ser = -x2 * pz, dir = 1.0f - av * av;
                const f32x2 em1 = {fminf(ser[0], dir[0]), fminf(ser[1], dir[1])};
                const f32x2 sq = {__builtin_amdgcn_sqrtf(em1[0]), __builtin_amdgcn_sqrtf(em1[1])};
                const f32x2 bt = sq * ig * xv; const f32x2 las = la2 * LA_SCALE;
                h = av[0] * h + bt[0]; lbp[(size_t)(4 * mt + rp) * DM] = pk_half2(las[0], bt[0]);
                h = av[1] * h + bt[1]; lbp[(size_t)(4 * mt + rp + 1) * DM] = pk_half2(las[1], bt[1]);
                Arun *= av[0] * av[1]; }
        }
        SEGA[(size_t)(b * 256 + 4 * c + q) * DM + ch] = Arun; SEGB[(size_t)(b * 256 + 4 * c + q) * DM + ch] = h;
        float Ac = 1.f, Bc = 0.f;
#pragma unroll
        for (int k = 0; k < 4; ++k) { const float Ak = __shfl(Arun, cl + 16 * k), Bk = __shfl(h, cl + 16 * k); Bc = Ak * Bc + Bk; Ac *= Ak; }
        if (q == 0) { SUMA[(size_t)(b * 64 + c) * DM + ch] = Ac; SUMB[(size_t)(b * 64 + c) * DM + ch] = Bc; }
    }
    __syncthreads();
    TS_END(2);
}
__device__ __forceinline__ void scan_apply_unit(Frame& F, int b, int seg) {
    const unsigned* LB = (const unsigned*)(F.ws + WS_S3); const bf16* SG = (const bf16*)(F.ws + WS_S2); bf16* Y = (bf16*)(F.ws + WS_S1);
    const float* SUMA = (const float*)(F.ws + WS_SUMA); const float* SUMB = (const float*)(F.ws + WS_SUMB); const float* SEGA = (const float*)(F.ws + WS_SEGA); const float* SEGB = (const float*)(F.ws + WS_SEGB);
    typedef float f32x2 __attribute__((ext_vector_type(2)));
    const int ch = 2 * F.tid, c = seg >> 2, qq = seg & 3;
    float h0 = 0.f, h1 = 0.f;
    TS_BEGIN(11);
    for (int cc0 = 0; cc0 < c; cc0 += 8) {
        f32x2 A[8], Bv[8];
#pragma unroll
        for (int i = 0; i < 8; ++i) { const bool ok = cc0 + i < c; const size_t o = (size_t)(b * 64 + cc0 + i) * DM + ch;
            A[i] = ok ? *(const f32x2*)(SUMA + o) : (f32x2){1.f, 1.f}; Bv[i] = ok ? *(const f32x2*)(SUMB + o) : (f32x2){0.f, 0.f}; }
#pragma unroll
        for (int i = 0; i < 8; ++i) { h0 = A[i][0] * h0 + Bv[i][0]; h1 = A[i][1] * h1 + Bv[i][1]; }
    }
    {   f32x2 A[3], Bv[3];
#pragma unroll
        for (int i = 0; i < 3; ++i) { const bool ok = i < qq; const size_t o = (size_t)(b * 256 + 4 * c + i) * DM + ch;
            A[i] = ok ? *(const f32x2*)(SEGA + o) : (f32x2){1.f, 1.f}; Bv[i] = ok ? *(const f32x2*)(SEGB + o) : (f32x2){0.f, 0.f}; }
#pragma unroll
        for (int i = 0; i < 3; ++i) { h0 = A[i][0] * h0 + Bv[i][0]; h1 = A[i][1] * h1 + Bv[i][1]; } }
    TS_END(11); TS_BEGIN(12);
    const size_t row0 = (size_t)b * SEQ + (size_t)seg * 64;
#pragma unroll 1
    for (int t0 = 0; t0 < 64; t0 += 16) {
        v2u lb[16]; unsigned sg[16];
#pragma unroll
        for (int i = 0; i < 16; ++i) { const size_t o = (row0 + t0 + i) * DM + ch; lb[i] = __builtin_nontemporal_load((const v2u*)(LB + o)); sg[i] = __builtin_nontemporal_load((const unsigned*)(SG + o)); }
#pragma unroll
        for (int i = 0; i < 16; ++i) {
            h0 = fast_exp2(half_lo(lb[i].x) * (1.0f / LA_SCALE)) * h0 + half_hi(lb[i].x);
            h1 = fast_exp2(half_lo(lb[i].y) * (1.0f / LA_SCALE)) * h1 + half_hi(lb[i].y);
            *(unsigned*)(Y + (row0 + t0 + i) * DM + ch) = pk2(h0 * bflo(sg[i]), h1 * bfhi(sg[i])); }
    }
    TS_END(12);
}

__device__ __forceinline__ void scan_apply_pair(Frame& F, int b, int sp) {
    const unsigned* LB = (const unsigned*)(F.ws + WS_S3); const bf16* SG = (const bf16*)(F.ws + WS_S2); bf16* Y = (bf16*)(F.ws + WS_S1);
    const float* SUMA = (const float*)(F.ws + WS_SUMA); const float* SUMB = (const float*)(F.ws + WS_SUMB); const float* SEGA = (const float*)(F.ws + WS_SEGA); const float* SEGB = (const float*)(F.ws + WS_SEGB);
    const int seg = (F.tid >> 8) ? 255 - sp : sp, ch = 4 * (F.tid & 255), c = seg >> 2, qq = seg & 3;
    f32x4 h = {0.f, 0.f, 0.f, 0.f};
    for (int cc0 = 0; cc0 < c; cc0 += 8) {
        f32x4 A[8], Bv[8];
#pragma unroll
        for (int i = 0; i < 8; ++i) { const bool ok = cc0 + i < c; const size_t o = (size_t)(b * 64 + cc0 + i) * DM + ch;
            A[i] = ok ? *(const f32x4*)(SUMA + o) : (f32x4){1.f, 1.f, 1.f, 1.f}; Bv[i] = ok ? *(const f32x4*)(SUMB + o) : (f32x4){0.f, 0.f, 0.f, 0.f}; }
#pragma unroll
        for (int i = 0; i < 8; ++i) h = A[i] * h + Bv[i];
    }
    {   f32x4 A[3], Bv[3];
#pragma unroll
        for (int i = 0; i < 3; ++i) { const bool ok = i < qq; const size_t o = (size_t)(b * 256 + 4 * c + i) * DM + ch;
            A[i] = ok ? *(const f32x4*)(SEGA + o) : (f32x4){1.f, 1.f, 1.f, 1.f}; Bv[i] = ok ? *(const f32x4*)(SEGB + o) : (f32x4){0.f, 0.f, 0.f, 0.f}; }
#pragma unroll
        for (int i = 0; i < 3; ++i) h = A[i] * h + Bv[i]; }
    const size_t row0 = (size_t)b * SEQ + (size_t)seg * 64;
#pragma unroll 1
    for (int t0 = 0; t0 < 64; t0 += 16) {
        v4u lb[16]; v2u sg[16];
#pragma unroll
        for (int i = 0; i < 16; ++i) { const size_t o = (row0 + t0 + i) * DM + ch; lb[i] = __builtin_nontemporal_load((const v4u*)(LB + o)); sg[i] = __builtin_nontemporal_load((const v2u*)(SG + o)); }
#pragma unroll
        for (int i = 0; i < 16; ++i) {
            h[0] = fast_exp2(half_lo(lb[i].x) * (1.0f / LA_SCALE)) * h[0] + half_hi(lb[i].x);
            h[1] = fast_exp2(half_lo(lb[i].y) * (1.0f / LA_SCALE)) * h[1] + half_hi(lb[i].y);
            h[2] = fast_exp2(half_lo(lb[i].z) * (1.0f / LA_SCALE)) * h[2] + half_hi(lb[i].z);
            h[3] = fast_exp2(half_lo(lb[i].w) * (1.0f / LA_SCALE)) * h[3] + half_hi(lb[i].w);
            v2u yo; yo.x = pk2(h[0] * bflo(sg[i].x), h[1] * bfhi(sg[i].x)); yo.y = pk2(h[2] * bflo(sg[i].y), h[3] * bfhi(sg[i].y));
            *(v2u*)(Y + (row0 + t0 + i) * DM + ch) = yo; }
    }
}

__device__ __forceinline__ void fix_unit(Frame& F, int b, int blk, int h, int which  ) {
    bf16* BUF = (bf16*)(F.ws + (which ? WS_S0 : WS_S1));
    const float* G = which ? inp(16) : inp(13);
    const float* RC = (const float*)(F.ws + WS_ROPE); const float* RSn = RC + (size_t)SEQ * 64;
    LAS float* red = (LAS float*)F.lds;
    const int k16 = F.tid & 15, ts = F.tid >> 4;
    float g[8];
    { const f32x4 a = *(const f32x4*)(G + 4 * k16), bb = *(const f32x4*)(G + 64 + 4 * k16); g[0] = a[0]; g[1] = a[1]; g[2] = a[2]; g[3] = a[3]; g[4] = bb[0]; g[5] = bb[1]; g[6] = bb[2]; g[7] = bb[3]; }
    const float osc = which ? QSCALE : 1.0f;
    float km[8] = {0.f, 0.f, 0.f, 0.f, 0.f, 0.f, 0.f, 0.f};
#pragma unroll 2
    for (int it = 0; it < 8; ++it) {
        const int tl = ts + 32 * it, pos = blk * BLK + tl; const size_t row = (size_t)b * SEQ + pos;
        bf16* p = BUF + row * DM + h * 128 + 8 * k16;
        const v4u raw = *(const v4u*)p;
        float v[8] = {bflo(raw.x), bfhi(raw.x), bflo(raw.y), bfhi(raw.y), bflo(raw.z), bfhi(raw.z), bflo(raw.w), bfhi(raw.w)};
        float ss = 0.f;
#pragma unroll
        for (int e = 0; e < 8; ++e) ss += v[e] * v[e];
        ss += __shfl_xor(ss, 1); ss += __shfl_xor(ss, 2); ss += __shfl_xor(ss, 4); ss += __shfl_xor(ss, 8);
        const float rinv = 1.0f / sqrtf(ss * (1.0f / HD) + EPS);
        const f32x4 cs = *(const f32x4*)(RC + (size_t)pos * 64 + 4 * k16), sn = *(const f32x4*)(RSn + (size_t)pos * 64 + 4 * k16);
        float o[8];
#pragma unroll
        for (int e = 0; e < 4; ++e) { const float x1 = v[e] * rinv * g[e], x2 = v[4 + e] * rinv * g[4 + e];
            o[e] = (x1 * cs[e] - x2 * sn[e]) * osc; o[4 + e] = (x2 * cs[e] + x1 * sn[e]) * osc; }
#pragma unroll
        for (int e = 0; e < 8; ++e) km[e] += o[e];
        v4u w; w.x = pk2(o[0], o[1]); w.y = pk2(o[2], o[3]); w.z = pk2(o[4], o[5]); w.w = pk2(o[6], o[7]);
        if (F.probe) *(v4u*)(F.ws + 48 * MiB + (((size_t)(p - BUF) * 2) & (8 * MiB - 1))) = w; else *(v4u*)p = w;
    }
    if (which == 0) {
#pragma unroll
        for (int e = 0; e < 8; ++e) red[ts * 128 + 8 * k16 + e] = km[e];
        __syncthreads();
        if (F.tid < 128) { float s = 0.f;
#pragma unroll 8
            for (int j = 0; j < 32; ++j) s += red[j * 128 + F.tid];
            ((float*)(F.ws + WS_KMEAN))[((size_t)(b * NH + h) * NBLK + blk) * HD + F.tid] = s * (1.0f / BLK); }
        __syncthreads();
    }
}

#define KSWZ(row, colB) ((row) * 256 + ((colB) ^ (((row) & 7) << 4)))
__device__ __forceinline__ int crow(int r, int hi) { return (r & 3) + 8 * (r >> 2) + 4 * hi; }
__device__ __forceinline__ int v_st(int k, int c) { const int kk = (k & ~0xC) | ((k & 4) << 1) | ((k & 8) >> 1); return ((kk >> 3) * 4 + (c >> 5)) * 512 + ((kk & 7) * 32 + (c & 31)) * 2; }
__device__ __forceinline__ int v_rd_base(int lane) { return ((lane & 3) << 3) | (((lane >> 2) & 3) << 6) | (((lane >> 4) & 1) << 5) | (((lane >> 5) & 1) << 8); }
constexpr int v_rd_off(int d0, int ks, int half) { return d0 * 512 + ks * 4096 + half * 2048; }
template <int OFF> __device__ __forceinline__ s16x4 tr_read(int vb) {
    s16x4 r; asm volatile("ds_read_b64_tr_b16 %0, %1 offset:%2" : "=&v"(r) : "v"(vb), "i"(OFF) : "memory"); return r;
}
__device__ __forceinline__ void qkt_acc(f32x16& p0, f32x16& p1, const LAS unsigned char* Ks, const bf16x8 (&qr)[8], int r32, int hi) {
    bf16x8 b0[8], b1[8];
#pragma unroll
    for (int d0 = 0; d0 < 8; ++d0) { const int cb = (d0 * 16 + hi * 8) * 2;
        b0[d0] = *(const LAS bf16x8*)(Ks + KSWZ(r32, cb)); b1[d0] = *(const LAS bf16x8*)(Ks + KSWZ(32 + r32, cb)); }
#pragma unroll
    for (int d0 = 0; d0 < 8; ++d0) {
        p0 = __builtin_amdgcn_mfma_f32_32x32x16_bf16(b0[d0], qr[d0], p0, 0, 0, 0);
        p1 = __builtin_amdgcn_mfma_f32_32x32x16_bf16(b1[d0], qr[d0], p1, 0, 0, 0); }
}
template <int D0> __device__ __forceinline__ void pv_one(f32x16& od, int vb, bf16x8 pa0, bf16x8 pa1, bf16x8 pa2, bf16x8 pa3) {
    const s16x4 l0 = tr_read<v_rd_off(D0, 0, 0)>(vb), h0 = tr_read<v_rd_off(D0, 0, 1)>(vb), l1 = tr_read<v_rd_off(D0, 1, 0)>(vb), h1 = tr_read<v_rd_off(D0, 1, 1)>(vb);
    const s16x4 l2 = tr_read<v_rd_off(D0, 2, 0)>(vb), h2 = tr_read<v_rd_off(D0, 2, 1)>(vb), l3 = tr_read<v_rd_off(D0, 3, 0)>(vb), h3 = tr_read<v_rd_off(D0, 3, 1)>(vb);
    asm volatile("s_waitcnt lgkmcnt(0)" ::: "memory"); SBAR();
#define PKV(L, H) (bf16x8){L[0], L[1], L[2], L[3], H[0], H[1], H[2], H[3]}
    od = __builtin_amdgcn_mfma_f32_32x32x16_bf16(PKV(l0, h0), pa0, od, 0, 0, 0);
    od = __builtin_amdgcn_mfma_f32_32x32x16_bf16(PKV(l1, h1), pa1, od, 0, 0, 0);
    od = __builtin_amdgcn_mfma_f32_32x32x16_bf16(PKV(l2, h2), pa2, od, 0, 0, 0);
    od = __builtin_amdgcn_mfma_f32_32x32x16_bf16(PKV(l3, h3), pa3, od, 0, 0, 0);
#undef PKV
}
constexpr float THR2 = 8.0f;
template <bool DIAG>
__device__ __forceinline__ void attn_subtile(f32x16 (&o)[4], float& m, float& l, const LAS unsigned char* Ks, int vb, const bf16x8 (&qr)[8], int r32, int hi, int kb0, int qidx) {
    const bool fresh = m <= -1e29f;
    const float mref = fresh ? 0.f : m, nm = -mref;
    f32x16 p0, p1;
#pragma unroll
    for (int r = 0; r < 16; ++r) { p0[r] = nm; p1[r] = nm; }
    qkt_acc(p0, p1, Ks, qr, r32, hi);
    if (DIAG) {
#pragma unroll
        for (int r = 0; r < 16; ++r) { const int kk = kb0 + crow(r, hi); if (kk > qidx) p0[r] = -1e30f; if (kk + 32 > qidx) p1[r] = -1e30f; }
    }
    float pmax = p0[0];
#pragma unroll
    for (int r = 1; r < 16; ++r) pmax = fmaxf(pmax, p0[r]);
#pragma unroll
    for (int r = 0; r < 16; ++r) pmax = fmaxf(pmax, p1[r]);
    { auto rr = __builtin_amdgcn_permlane32_swap(__float_as_uint(pmax), __float_as_uint(pmax), false, false);
      pmax = fmaxf(__uint_as_float(rr[0]), __uint_as_float(rr[1])); }
    const bool need = fresh || (pmax > THR2);
    if (__any(need)) {
        const float d = need ? pmax : 0.f;
        const float alpha = fresh ? 0.f : fast_exp2(-d);
        m = mref + d; l *= alpha;
#pragma unroll
        for (int r = 0; r < 16; ++r) { p0[r] -= d; p1[r] -= d; }
#pragma unroll
        for (int dd = 0; dd < 4; ++dd)
#pragma unroll
            for (int r = 0; r < 16; ++r) o[dd][r] *= alpha;
    }
#pragma unroll
    for (int r = 0; r < 16; ++r) { p0[r] = fast_exp2(p0[r]); p1[r] = fast_exp2(p1[r]); }
    typedef float f32x8v __attribute__((ext_vector_type(8)));
    const f32x16 t16 = p0 + p1; const f32x8v t8 = t16.lo + t16.hi; const f32x4 t4 = t8.lo + t8.hi;
    float ps = (t4[0] + t4[1]) + (t4[2] + t4[3]);
    { auto rr = __builtin_amdgcn_permlane32_swap(__float_as_uint(ps), __float_as_uint(ps), false, false);
      ps = __uint_as_float(rr[0]) + __uint_as_float(rr[1]); }
    l += ps;
    bf16x8 pa0, pa1, pa2, pa3;
#define PK4(P, BASE, OUT) do { unsigned a0 = pk2(P[BASE + 0], P[BASE + 1]), a1 = pk2(P[BASE + 2], P[BASE + 3]);   \
    unsigned b0 = pk2(P[BASE + 4], P[BASE + 5]), b1 = pk2(P[BASE + 6], P[BASE + 7]);                              \
    auto r0 = __builtin_amdgcn_permlane32_swap(a0, b0, false, false); auto r1 = __builtin_amdgcn_permlane32_swap(a1, b1, false, false); \
    v4u w = {r0[0], r1[0], r0[1], r1[1]}; OUT = __builtin_bit_cast(bf16x8, w); } while (0)
    PK4(p0, 0, pa0); PK4(p0, 8, pa1); PK4(p1, 0, pa2); PK4(p1, 8, pa3);
#undef PK4
    pv_one<0>(o[0], vb, pa0, pa1, pa2, pa3); pv_one<1>(o[1], vb, pa0, pa1, pa2, pa3); pv_one<2>(o[2], vb, pa0, pa1, pa2, pa3); pv_one<3>(o[3], vb, pa0, pa1, pa2, pa3);
}
__device__ __forceinline__ void sm_scores(f32x16& p0, f32x16& p1, const LAS unsigned char* Ks, const bf16x8 (&qr)[8], int r32, int hi, float m) {
    const float nm = (m <= -1e29f) ? 0.f : -m;
#pragma unroll
    for (int r = 0; r < 16; ++r) { p0[r] = nm; p1[r] = nm; }
#pragma unroll
    for (int d0 = 0; d0 < 8; ++d0) { const int cb = (d0 * 16 + hi * 8) * 2;
        const bf16x8 b0 = *(const LAS bf16x8*)(Ks + KSWZ(r32, cb)), b1 = *(const LAS bf16x8*)(Ks + KSWZ(32 + r32, cb));
        p0 = __builtin_amdgcn_mfma_f32_32x32x16_bf16(b0, qr[d0], p0, 0, 0, 0);
        p1 = __builtin_amdgcn_mfma_f32_32x32x16_bf16(b1, qr[d0], p1, 0, 0, 0); }
}
__device__ __forceinline__ float sm_decide(const f32x16& p0, const f32x16& p1, f32x16 (&o)[4], float& m, float& l) {
    const bool fresh = m <= -1e29f; const float mref = fresh ? 0.f : m;
    float pmax = p0[0];
#pragma unroll
    for (int r = 1; r < 16; ++r) pmax = fmaxf(pmax, p0[r]);
#pragma unroll
    for (int r = 0; r < 16; ++r) pmax = fmaxf(pmax, p1[r]);
    { auto rr = __builtin_amdgcn_permlane32_swap(__float_as_uint(pmax), __float_as_uint(pmax), false, false);
      pmax = fmaxf(__uint_as_float(rr[0]), __uint_as_float(rr[1])); }
    const bool need = fresh || (pmax > THR2);
    float d = 0.f;
    if (__any(need)) {
        d = need ? pmax : 0.f;
        const float alpha = fresh ? 0.f : fast_exp2(-d);
        m = mref + d; l *= alpha;
#pragma unroll
        for (int dd = 0; dd < 4; ++dd)
#pragma unroll
            for (int r = 0; r < 16; ++r) o[dd][r] *= alpha;
    }
    return d;
}
__device__ __forceinline__ void sm_finish(f32x16& p0, f32x16& p1, float d, float& l, bf16x8& pa0, bf16x8& pa1, bf16x8& pa2, bf16x8& pa3) {
#pragma unroll
    for (int r = 0; r < 16; ++r) { p0[r] = fast_exp2(p0[r] - d); p1[r] = fast_exp2(p1[r] - d); }
    typedef float f32x8v __attribute__((ext_vector_type(8)));
    const f32x16 t16 = p0 + p1;
    const f32x8v t8 = t16.lo + t16.hi; const f32x4 t4 = t8.lo + t8.hi;
    float ps = (t4[0] + t4[1]) + (t4[2] + t4[3]);
    { auto rr = __builtin_amdgcn_permlane32_swap(__float_as_uint(ps), __float_as_uint(ps), false, false);
      ps = __uint_as_float(rr[0]) + __uint_as_float(rr[1]); }
    l += ps;
#define PK4(P, BASE, OUT) do { unsigned a0 = pk2(P[BASE + 0], P[BASE + 1]), a1 = pk2(P[BASE + 2], P[BASE + 3]);   \
    unsigned b0 = pk2(P[BASE + 4], P[BASE + 5]), b1 = pk2(P[BASE + 6], P[BASE + 7]);                              \
    auto r0 = __builtin_amdgcn_permlane32_swap(a0, b0, false, false); auto r1 = __builtin_amdgcn_permlane32_swap(a1, b1, false, false); \
    v4u w = {r0[0], r1[0], r0[1], r1[1]}; OUT = __builtin_bit_cast(bf16x8, w); } while (0)
    PK4(p0, 0, pa0); PK4(p0, 8, pa1); PK4(p1, 0, pa2); PK4(p1, 8, pa3);
#undef PK4
}
__device__ __forceinline__ void pv_all(f32x16 (&o)[4], int vb, bf16x8 pa0, bf16x8 pa1, bf16x8 pa2, bf16x8 pa3) {
    pv_one<0>(o[0], vb, pa0, pa1, pa2, pa3); pv_one<1>(o[1], vb, pa0, pa1, pa2, pa3); pv_one<2>(o[2], vb, pa0, pa1, pa2, pa3); pv_one<3>(o[3], vb, pa0, pa1, pa2, pa3);
}
__device__ __forceinline__ void attn_tile4(f32x16 (&o)[4], float& m, float& l, const LAS unsigned char* K0, int vb, const bf16x8 (&qr)[8], int r32, int hi) {
    f32x16 pA0, pA1, pB0, pB1; bf16x8 pa0, pa1, pa2, pa3; float dA, dB;
    sm_scores(pA0, pA1, K0, qr, r32, hi, m); dA = sm_decide(pA0, pA1, o, m, l);
    sm_scores(pB0, pB1, K0 + 16384, qr, r32, hi, m); sm_finish(pA0, pA1, dA, l, pa0, pa1, pa2, pa3);
    pv_all(o, vb, pa0, pa1, pa2, pa3); dB = sm_decide(pB0, pB1, o, m, l);
    sm_scores(pA0, pA1, K0 + 32768, qr, r32, hi, m); sm_finish(pB0, pB1, dB, l, pa0, pa1, pa2, pa3);
    pv_all(o, vb + 16384, pa0, pa1, pa2, pa3); dA = sm_decide(pA0, pA1, o, m, l);
    sm_scores(pB0, pB1, K0 + 49152, qr, r32, hi, m); sm_finish(pA0, pA1, dA, l, pa0, pa1, pa2, pa3);
    pv_all(o, vb + 32768, pa0, pa1, pa2, pa3); dB = sm_decide(pB0, pB1, o, m, l);
    sm_finish(pB0, pB1, dB, l, pa0, pa1, pa2, pa3);
    pv_all(o, vb + 49152, pa0, pa1, pa2, pa3);
}
__device__ __forceinline__ void row_store_T(unsigned char* rowp, const f32x16 (&o)[4], float sc, int hi, bool pred) {
#pragma unroll
    for (int j = 0; j < 8; ++j) { const int d0 = j >> 1, g0 = (j & 1) * 2;
        unsigned ax = pk2(o[d0][4 * g0 + 0] * sc, o[d0][4 * g0 + 1] * sc), ay = pk2(o[d0][4 * g0 + 2] * sc, o[d0][4 * g0 + 3] * sc);
        unsigned bx = pk2(o[d0][4 * g0 + 4] * sc, o[d0][4 * g0 + 5] * sc), by = pk2(o[d0][4 * g0 + 6] * sc, o[d0][4 * g0 + 7] * sc);
        auto r0 = __builtin_amdgcn_permlane32_swap(ax, bx, false, false); auto r1 = __builtin_amdgcn_permlane32_swap(ay, by, false, false);
        const v4u w = {r0[0], r1[0], r0[1], r1[1]};
        if (pred) *(v4u*)(rowp + 32 * j + 16 * hi) = w; }
}
__device__ __forceinline__ void row_load_T(const unsigned char* rowp, f32x16 (&v)[4], int hi) {
    v4u w[8];
#pragma unroll
    for (int j = 0; j < 8; ++j) w[j] = *(const v4u*)(rowp + 32 * j + 16 * hi);
#pragma unroll
    for (int j = 0; j < 8; ++j) { const int d0 = j >> 1, g0 = (j & 1) * 2;
        auto r0 = __builtin_amdgcn_permlane32_swap(w[j].x, w[j].z, false, false); auto r1 = __builtin_amdgcn_permlane32_swap(w[j].y, w[j].w, false, false);
        const unsigned ax = r0[0], bx = r0[1], ay = r1[0], by = r1[1];
        v[d0][4 * g0 + 0] = bflo(ax); v[d0][4 * g0 + 1] = bfhi(ax); v[d0][4 * g0 + 2] = bflo(ay); v[d0][4 * g0 + 3] = bfhi(ay);
        v[d0][4 * g0 + 4] = bflo(bx); v[d0][4 * g0 + 5] = bfhi(bx); v[d0][4 * g0 + 6] = bflo(by); v[d0][4 * g0 + 7] = bfhi(by); }
}
constexpr int KIMG = 0, VIMG = 65536, ATT_AUX = 131072;
__device__ __forceinline__ void load_kv_block(Frame& F, int b, int h, int j) {
    const bf16* KB = (const bf16*)(F.ws + WS_S1); const bf16* VB = (const bf16*)(F.ws + WS_S2);
    const size_t base = ((size_t)b * SEQ + (size_t)j * BLK) * DM + h * 128;
    v4u kr[8], vr[8];
#pragma unroll
    for (int it = 0; it < 8; ++it) { const int id = F.tid + 512 * it, row = id >> 4, c = id & 15;
        kr[it] = *(const v4u*)(KB + base + (size_t)row * DM + c * 8); vr[it] = *(const v4u*)(VB + base + (size_t)row * DM + c * 8); }
#pragma unroll
    for (int it = 0; it < 8; ++it) { const int id = F.tid + 512 * it, row = id >> 4, c = id & 15;
        *(LAS v4u*)(F.lds + KIMG + (row >> 6) * 16384 + KSWZ(row & 63, c * 16)) = kr[it];
        *(LAS v4u*)(F.lds + VIMG + (row >> 6) * 16384 + v_st(row & 63, c * 8)) = vr[it]; }
}

__device__ __forceinline__ void select_loads(Frame& F, int b, int h, int qb, f32x4 (&km)[4], bf16x8 (&qr)[8]) {
    const float* KM = (const float*)(F.ws + WS_KMEAN) + (size_t)(b * NH + h) * NBLK * HD;
    const bf16* QB = (const bf16*)(F.ws + WS_S0);
    const int r32 = F.lane & 31, hi = F.lane >> 5, ql = 32 * F.wave + r32;
    const size_t tok = (size_t)b * SEQ + qb * BLK + ql;
#pragma unroll
    for (int d0 = 0; d0 < 8; ++d0) qr[d0] = *(const bf16x8*)(QB + tok * DM + h * 128 + d0 * 16 + hi * 8);
#pragma unroll
    for (int it = 0; it < 2; ++it) { const int id = F.tid + 512 * it, row = id >> 4, c = id & 15;
        km[2 * it] = *(const f32x4*)(KM + row * HD + c * 8); km[2 * it + 1] = *(const f32x4*)(KM + row * HD + c * 8 + 4); }
}
__device__ __forceinline__ void select_unit(Frame& F, int b, int h, int qb, f32x4 (&km)[4], bf16x8 (&qr)[8], int nb, int nh, int nqb) {
    LAS unsigned char* KH = F.lds; LAS unsigned char* KL = F.lds + 16384;
    LAS int* cnt = (LAS int*)(F.lds + 32768); LAS int* cursor = cnt + 64; LAS int* offs = cnt + 128; LAS unsigned short* ent = (LAS unsigned short*)(F.lds + 32768 + 1024);
    unsigned short* ENT = (unsigned short*)(F.ws + WS_ENT) + (size_t)((b * NH + h) * NBLK + qb) * 768;
    unsigned short* OFFS = (unsigned short*)(F.ws + WS_OFFS) + (size_t)((b * NH + h) * NBLK + qb) * OFFS_PITCH;
    unsigned* NTOT = (unsigned*)(F.ws + WS_CTL) + CW_NTOT + (b * NH + h) * NBLK;
    TS_BEGIN(70);
#pragma unroll
    for (int it = 0; it < 2; ++it) { const int id = F.tid + 512 * it, row = id >> 4, c = id & 15;
        const f32x4 a = km[2 * it], bb = km[2 * it + 1];
        float v[8] = {a[0], a[1], a[2], a[3], bb[0], bb[1], bb[2], bb[3]}; unsigned hw[8]; float lo[8];
#pragma unroll
        for (int e = 0; e < 8; ++e) { if (row >= qb) v[e] = 0.f; hw[e] = f2bf(v[e]); lo[e] = v[e] - __builtin_bit_cast(float, hw[e] << 16); }
        v4u wh = {hw[0] | (hw[1] << 16), hw[2] | (hw[3] << 16), hw[4] | (hw[5] << 16), hw[6] | (hw[7] << 16)};
        v4u wl = {pk2(lo[0], lo[1]), pk2(lo[2], lo[3]), pk2(lo[4], lo[5]), pk2(lo[6], lo[7])};
        *(LAS v4u*)(KH + KSWZ(row, c * 16)) = wh; *(LAS v4u*)(KL + KSWZ(row, c * 16)) = wl; }
    if (F.tid < 64) cnt[F.tid] = 0;
    __syncthreads();
    TS_END(70); TS_BEGIN(71);
    const int r32 = F.lane & 31, hi = F.lane >> 5, ql = 32 * F.wave + r32;
    f32x16 p0 = {}, p1 = {};
    qkt_acc(p0, p1, KH, qr, r32, hi); qkt_acc(p0, p1, KL, qr, r32, hi);
    if (nqb >= 0) select_loads(F, nb, nh, nqb, km, qr);
    unsigned key[32];
#pragma unroll
    for (int r = 0; r < 16; ++r) { const int j0 = crow(r, hi), j1 = 32 + crow(r, hi);
        const unsigned b0 = __float_as_uint(p0[r]), b1 = __float_as_uint(p1[r]);
        const unsigned u0 = b0 ^ (((int)b0 >> 31) | 0x80000000u), u1 = b1 ^ (((int)b1 >> 31) | 0x80000000u);
        key[r] = j0 < qb ? ((u0 & ~63u) | (unsigned)(63 - j0)) : 0u; key[16 + r] = j1 < qb ? ((u1 & ~63u) | (unsigned)(63 - j1)) : 0u; }
    unsigned tk[3];
#pragma unroll
    for (int pass = 0; pass < 3; ++pass) { unsigned bk = key[0];
#pragma unroll
        for (int r = 1; r < 32; ++r) bk = bk > key[r] ? bk : key[r];
        tk[pass] = bk;
#pragma unroll
        for (int r = 0; r < 32; ++r) key[r] = (key[r] == bk) ? 0u : key[r]; }
    unsigned mk[6];
#pragma unroll
    for (int k = 0; k < 3; ++k) { mk[k] = tk[k]; mk[3 + k] = (unsigned)__shfl_xor((int)tk[k], 32); }
    unsigned fk[3];
#pragma unroll
    for (int pass = 0; pass < 3; ++pass) { unsigned bk = mk[0];
#pragma unroll
        for (int r = 1; r < 6; ++r) bk = bk > mk[r] ? bk : mk[r];
        fk[pass] = bk;
#pragma unroll
        for (int r = 0; r < 6; ++r) mk[r] = (mk[r] == bk) ? 0u : mk[r]; }
    const int i1 = 63 - (int)(fk[0] & 63u), i2 = 63 - (int)(fk[1] & 63u), i3 = 63 - (int)(fk[2] & 63u);
    TS_END(71); TS_BEGIN(72);
    const int nv = qb < 3 ? qb : 3;
    const int js[3] = {i1, i2, i3};
    int rk[3] = {0, 0, 0};
    if (hi == 0) {
#pragma unroll
        for (int s = 0; s < 3; ++s) if (s < nv) rk[s] = __hip_atomic_fetch_add(&cnt[js[s]], 1, __ATOMIC_RELAXED, __HIP_MEMORY_SCOPE_WORKGROUP);
    }
    __syncthreads();
    if (F.wave == 0) {
        const int c = cnt[F.lane]; int incl = c;
#pragma unroll
        for (int o = 1; o < 64; o <<= 1) { const int t = __shfl_up(incl, o); if (F.lane >= o) incl += t; }
        offs[F.lane + 1] = incl; if (F.lane == 0) offs[0] = 0;
        OFFS[F.lane + 1] = (unsigned short)incl; if (F.lane == 0) OFFS[0] = 0;
        if (F.lane < qb && c > 0 && !F.probe) atomicAdd(&NTOT[F.lane], (unsigned)c);
    }
    __syncthreads();
    if (hi == 0) {
#pragma unroll
        for (int s = 0; s < 3; ++s) if (s < nv) ENT[offs[js[s]] + rk[s]] = (unsigned short)(ql | (s << 8));
    }
    (void)cursor; (void)ent;
    TS_END(72);
}

constexpr int P8_SQ = 32;
constexpr int P8_MAXSTEPS = 144;
constexpr int P8_GC = 1, P8_OWNC = 8;
constexpr int P8_OVH = 6;
constexpr size_t OWNP_OFF = 64 * MiB;
__device__ __forceinline__ void gathered_attention(Frame& F) {
    LAS int* PFX = (LAS int*)(F.lds + ATT_AUX); LAS int* NT = PFX + 1024; LAS int* wtot = NT + 1024;
    LAS int* ctr = wtot + 16; LAS int* qinfo = (LAS int*)(F.lds + ATT_AUX + 9216);
    LAS int* NXTQ = (LAS int*)(F.lds + ATT_AUX + 9216 + 19456);
    LAS int* NXT = (LAS int*)(F.lds + ATT_AUX + 8448); LAS int* NXTU = NXT + 64;
    const unsigned* NTOT = (const unsigned*)(F.ws + WS_CTL) + CW_NTOT;
    const bf16* QB = (const bf16*)(F.ws + WS_S0);
    unsigned char* PART = F.ws + WS_S3; unsigned char* OWNP = (unsigned char*)F.out + OWNP_OFF; float* LSE = (float*)(F.ws + WS_LSE);
    {
        const int n0 = (int)NTOT[2 * F.tid], n1 = (int)NTOT[2 * F.tid + 1]; const int g0 = (n0 + P8_SQ - 1) / P8_SQ, g1 = (n1 + P8_SQ - 1) / P8_SQ;
        const int e0 = P8_GC * g0 + P8_OWNC + P8_OVH, e1 = P8_GC * g1 + P8_OWNC + P8_OVH;
        NT[2 * F.tid] = n0; NT[2 * F.tid + 1] = n1; if (F.tid == 0) NXTU[0] = 0x40000000;
        int incl = e0 + e1;
#pragma unroll
        for (int o = 1; o < 64; o <<= 1) { const int t = __shfl_up(incl, o); if (F.lane >= o) incl += t; }
        if (F.lane == 63) wtot[F.wave] = incl;
        __syncthreads();
        int off = 0;
#pragma unroll
        for (int w = 0; w < 8; ++w) off += (w < F.wave) ? wtot[w] : 0;
        PFX[2 * F.tid + 1] = off + incl; PFX[2 * F.tid] = off + incl - e1;
        __syncthreads();
    }
    const int V_tot = PFX[1023];
    const int v_lo = (int)(((long)F.vcu * V_tot) / F.G), v_hi = (int)(((long)(F.vcu + 1) * V_tot) / F.G);
    const int r32 = F.lane & 31, hi = F.lane >> 5;
    const int vbase = (int)(uintptr_t)(F.lds + VIMG) + v_rd_base(F.lane);
    int u; { int lo = 0, hi_ = 1023; while (lo < hi_) { const int mid = (lo + hi_) >> 1; if (PFX[mid] > v_lo) hi_ = mid; else lo = mid + 1; } u = lo; }
    int done = 0;
    while (u < 1024) {
        const int base = u ? PFX[u - 1] : 0; if (base >= v_hi) break;
        const int n = NT[u]; const int ns_g = (n + P8_SQ - 1) / P8_SQ, ns_u = ns_g + 1;
        int k_lo = (v_lo - base - P8_OVH + P8_GC - 1) / P8_GC; if (v_lo - base - P8_OVH + P8_GC - 1 < 0) k_lo = 0;
        int k_hi = (v_hi - base - P8_OVH + P8_GC - 1) / P8_GC; if (v_hi - base - P8_OVH + P8_GC - 1 < 0) k_hi = 0; if (k_hi > ns_u) k_hi = ns_u;
        k_lo += done;
        if (k_lo >= k_hi) { ++u; done = 0; continue; }
        int nsteps = k_hi - k_lo; bool more = false; if (nsteps > P8_MAXSTEPS) { nsteps = P8_MAXSTEPS; more = true; }
        const int ub = u >> 9, uh = (u >> 6) & 7, uj = u & 63;
        const bool own = (k_lo + nsteps == ns_u);
        const int ngs = nsteps - (own ? 1 : 0);
        TS_BEGIN(5);
        int tidp = F.tid; asm volatile("" : "+v"(tidp));
        __syncthreads();
        {
            const bf16* KB = (const bf16*)(F.ws + WS_S1); const bf16* VB = (const bf16*)(F.ws + WS_S2);
            const size_t kvbase = ((size_t)ub * SEQ + (size_t)uj * BLK) * DM + uh * 128;
            v4u kr[8], vr[8];
#pragma unroll
            for (int it = 0; it < 8; ++it) { const int id = tidp + 512 * it, row = id >> 4, c = id & 15;
                kr[it] = __builtin_nontemporal_load((const v4u*)(KB + kvbase + (size_t)row * DM + c * 8)); vr[it] = __builtin_nontemporal_load((const v4u*)(VB + kvbase + (size_t)row * DM + c * 8)); }
            int o0 = 0, o1 = 0;
            const int nxu = NXTU[0]; const bool pfq = (nxu == u) && (k_lo == 0);
            if (nxu == u || nxu == -1 - u) { const int pk = NXT[F.lane]; o0 = pk & 0xffff; o1 = (int)((unsigned)pk >> 16); }
            else { const int qb = F.lane; if (qb > uj) { const unsigned short* OF = (const unsigned short*)(F.ws + WS_OFFS) + (size_t)((ub * NH + uh) * NBLK + qb) * OFFS_PITCH; o0 = OF[uj]; o1 = OF[uj + 1]; } }
            int cum = o1 - o0;
#pragma unroll
            for (int o = 1; o < 64; o <<= 1) { const int t = __shfl_up(cum, o); if (F.lane >= o) cum += t; }
            int e_end = P8_SQ * (k_lo + ngs); if (e_end > n) e_end = n;
            const int nent = ngs > 0 ? e_end - P8_SQ * k_lo : 0;
            if (pfq && ngs > 0) { const int i = tidp; if (i < ngs * P8_SQ) qinfo[i] = (i < nent) ? NXTQ[i] : -1; }
            for (int i0 = (pfq ? 512 : 0); i0 < ngs * P8_SQ; i0 += 512) { const int i = i0 + tidp;
                int info = -1; const int e = P8_SQ * k_lo + i; const bool ok = i < nent;
                int a = 0, c = 63;
#pragma unroll
                for (int it = 0; it < 6; ++it) { const int mid = (a + c) >> 1; const int cm = __shfl(cum, mid); if (cm > e) c = mid; else a = mid + 1; }
                const int qb = a; const int cprev = __shfl(cum, qb > 0 ? qb - 1 : 0); const int so = __shfl(o0, qb);
                if (ok) { const int idx = e - (qb ? cprev : 0);
                    const unsigned short en = ((const unsigned short*)(F.ws + WS_ENT))[(size_t)((ub * NH + uh) * NBLK + qb) * 768 + so + idx];
                    info = (qb * BLK + (en & 255)) | ((en >> 8) << 16); }
                if (i < ngs * P8_SQ) qinfo[i] = info; }
            if (own && tidp < 256) qinfo[ngs * P8_SQ + tidp] = (uj * BLK + tidp) | (3 << 16);
            if (tidp == 0) ctr[0] = 0;
#pragma unroll
            for (int it = 0; it < 8; ++it) { const int id = tidp + 512 * it, row = id >> 4, c = id & 15;
                *(LAS v4u*)(F.lds + KIMG + (row >> 6) * 16384 + KSWZ(row & 63, c * 16)) = kr[it];
                *(LAS v4u*)(F.lds + VIMG + (row >> 6) * 16384 + v_st(row & 63, c * 8)) = vr[it]; }
            __syncthreads();
            TS_END(5); TS_BEGIN(6);
            const int ntg = (nent + 31) >> 5;
            const int ntiles = ntg + (own ? 8 : 0);
            bf16x8 qa[8]; int ta;
#define P8_GRAB(T) do { int _t = 0; if (F.lane == 0) _t = __hip_atomic_fetch_add(ctr, 1, __ATOMIC_RELAXED, __HIP_MEMORY_SCOPE_WORKGROUP); T = __builtin_amdgcn_readfirstlane(_t); } while (0)
            if (F.wave == 7) { const int un = more ? u : u + 1;
                if (un < 1024) { const int ubn = un >> 9, uhn = (un >> 6) & 7, ujn = un & 63, qb = F.lane; int a0 = 0, a1 = 0;
                    if (qb > ujn) { const unsigned short* OF = (const unsigned short*)(F.ws + WS_OFFS) + (size_t)((ubn * NH + uhn) * NBLK + qb) * OFFS_PITCH; a0 = OF[ujn]; a1 = OF[ujn + 1]; }
                    NXT[F.lane] = a0 | (a1 << 16);
                    if (!more) {
                        int cumn = a1 - a0;
#pragma unroll
                        for (int o = 1; o < 64; o <<= 1) { const int t = __shfl_up(cumn, o); if (F.lane >= o) cumn += t; }
                        const int nn = NT[un]; unsigned enx[8]; int qbx[8];
#pragma unroll
                        for (int k = 0; k < 8; ++k) { const int e = 64 * k + F.lane; int a = 0, c = 63;
#pragma unroll
                            for (int it = 0; it < 6; ++it) { const int mid = (a + c) >> 1; const int cm = __shfl(cumn, mid); if (cm > e) c = mid; else a = mid + 1; }
                            const int qb2 = a; const int cprev = __shfl(cumn, qb2 > 0 ? qb2 - 1 : 0); const int so = __shfl(a0, qb2);
                            qbx[k] = qb2; enx[k] = 0u;
                            if (e < nn) enx[k] = ((const unsigned short*)(F.ws + WS_ENT))[(size_t)((ubn * NH + uhn) * NBLK + qb2) * 768 + so + (e - (qb2 ? cprev : 0))]; }
#pragma unroll
                        for (int k = 0; k < 8; ++k) { const int e = 64 * k + F.lane; NXTQ[e] = (e < nn) ? ((qbx[k] * BLK + (int)(enx[k] & 255u)) | ((int)(enx[k] >> 8) << 16)) : -1; } }
                    if (F.lane == 0) NXTU[0] = more ? -1 - un : un; } }
            P8_GRAB(ta);
            while (ta < ntiles) {
                const bool ownt = ta >= ntg; const int ot = ownt ? 7 - (ta - ntg) : 0;
                const int info = qinfo[ownt ? (ngs * P8_SQ + 32 * ot + r32) : (32 * ta + r32)];
                const bool valid = info >= 0; const int pos = valid ? (info & 0xffff) : 0, slot = valid ? ((info >> 16) & 3) : 0; const size_t tok = (size_t)ub * SEQ + pos;
                { int hiq = hi; asm volatile("" : "+v"(hiq)); const bf16* qp = QB + tok * DM + uh * 128 + hiq * 8;
#pragma unroll
                  for (int d0 = 0; d0 < 8; ++d0) qa[d0] = *(const bf16x8*)(qp + d0 * 16); }
                f32x16 o[4] = {}; float m = -1e30f, l = 0.f;
                const int tlast = ownt ? (ot >> 1) : 3;
                const int tfull = ownt ? tlast : 4;
                if (!ownt) attn_tile4(o, m, l, F.lds + KIMG, vbase, qa, r32, hi);
                else {
#pragma unroll 1
                    for (int t = 0; t < tfull; ++t) attn_subtile<false>(o, m, l, F.lds + KIMG + t * 16384, vbase + t * 16384, qa, r32, hi, 0, 0);
                    attn_subtile<true>(o, m, l, F.lds + KIMG + tlast * 16384, vbase + tlast * 16384, qa, r32, hi, 64 * tlast, 32 * ot + r32); }
                const float il = __builtin_amdgcn_rcpf(l);
                unsigned char* orow = ownt ? (OWNP + (tok * NH + uh) * 256) : (PART + ((tok * NH + uh) * 3 + slot) * 256);
                row_store_T(orow, o, il, hi, valid);
                if (valid && hi == 0) LSE[(tok * NH + uh) * 4 + slot] = m + __builtin_amdgcn_logf(l);
                P8_GRAB(ta);
            }
#undef P8_GRAB
            TS_END(6);
        }
        if (more) done += nsteps; else { ++u; done = 0; }
    }
    __syncthreads();
}

__device__ __forceinline__ void combine_phase(Frame& F) {
    const unsigned char* PART = F.ws + WS_S3; const unsigned char* OWNP = (const unsigned char*)F.out + OWNP_OFF; const float* LSE = (const float*)(F.ws + WS_LSE);
    const bf16* SG2 = (const bf16*)F.out; bf16* O = (bf16*)(F.ws + WS_S0);
    const long NIT = (long)T * NH * 16;
    for (long it = (long)F.vcu * 512 + F.tid; it < NIT; it += (long)F.G * 512) {
        const int c16 = (int)(it & 15); const long th = it >> 4;
        const int h = (int)(th & 7); const long tok = th >> 3; const int qb = (int)((tok & (SEQ - 1)) >> 8); const int nv = qb < 3 ? qb : 3;
        const f32x4 L4 = *(const f32x4*)(LSE + th * 4);
        const v4u po = __builtin_nontemporal_load((const v4u*)(OWNP + th * 256 + c16 * 16));
        v4u p0 = {0u, 0u, 0u, 0u}, p1 = p0, p2 = p0;
        if (nv > 0) p0 = __builtin_nontemporal_load((const v4u*)(PART + (th * 3 + 0) * 256 + c16 * 16));
        if (nv > 1) p1 = __builtin_nontemporal_load((const v4u*)(PART + (th * 3 + 1) * 256 + c16 * 16));
        if (nv > 2) p2 = __builtin_nontemporal_load((const v4u*)(PART + (th * 3 + 2) * 256 + c16 * 16));
        const v4u g = __builtin_nontemporal_load((const v4u*)(SG2 + tok * DM + h * 128 + c16 * 8));
        const float l0 = nv > 0 ? L4[0] : -1e30f, l1 = nv > 1 ? L4[1] : -1e30f, l2 = nv > 2 ? L4[2] : -1e30f, l3 = L4[3];
        const float M = fmaxf(fmaxf(l0, l1), fmaxf(l2, l3));
        const float w0 = fast_exp2(l0 - M), w1 = fast_exp2(l1 - M), w2 = fast_exp2(l2 - M), w3 = fast_exp2(l3 - M);
        const float inv = __builtin_amdgcn_rcpf((w0 + w1) + (w2 + w3));
        unsigned ow[4];
#pragma unroll
        for (int k = 0; k < 4; ++k) {
            const float a = (w0 * bflo(p0[k]) + w1 * bflo(p1[k])) + (w2 * bflo(p2[k]) + w3 * bflo(po[k]));
            const float bq = (w0 * bfhi(p0[k]) + w1 * bfhi(p1[k])) + (w2 * bfhi(p2[k]) + w3 * bfhi(po[k]));
            ow[k] = pk2(a * inv * bflo(g[k]), bq * inv * bfhi(g[k])); }
        const v4u ov = {ow[0], ow[1], ow[2], ow[3]};
        *(v4u*)(O + tok * DM + h * 128 + c16 * 8) = ov;
    }
}

constexpr int N_PHASES = 11;
__global__ void __launch_bounds__(512, 2) hawk_moba_fwd(Args args) {
    extern __shared__ __attribute__((aligned(16))) unsigned char lds_raw[];
    Frame F;
    F.lds = (LAS unsigned char*)lds_raw;
    F.tid = threadIdx.x; F.lane = F.tid & 63; F.wave = __builtin_amdgcn_readfirstlane(F.tid >> 6);
    F.G = gridDim.x; { const int bx = blockIdx.x; F.vcu = (F.G % 8 == 0) ? (bx % 8) * (F.G / 8) + bx / 8 : bx; }
    F.out = args.out; F.ws = args.ws; F.probe = false; F.tacc = 0ull; F.t0 = 0ull;
    volatile LAS unsigned* MISC = (volatile LAS unsigned*)(F.lds + MISC_OFF);
    if (F.tid < 64) MISC[F.tid] = 0u;
    __syncthreads();
    unsigned* ctl = (unsigned*)(F.ws + WS_CTL);
    XcdBarrier bar; bar.bar = ctl + CW_BAR; bar.x = 0; bar.st = nullptr;
    const int lo = args.ph_lo, hi = args.ph_hi;
    if (hi - lo > 1) bar = xcd_barrier_post(ctl + CW_BAR, MISC + 8);
#define IN(k) (lo <= (k) && (k) < hi)
#define SEAM(k) do { if (IN(k) && IN((k) + 1)) { TS_BEGIN(100 + (k)); xcd_barrier(bar); TS_END(100 + (k)); } } while (0)

#define RUN_GEMM(MODE, AOFF, BOFF, NN) do { \
        if ((MODE) == 0 || (MODE) == 2) {     \
            LAS float* rst = (LAS float*)(F.lds + pg8::STAGE_BYTES) + 2560; pg8::Unit uu; pg8::StaticOrder S0; S0.init(T, (NN), F.G, (int)blockIdx.x); \
            _Pragma("unroll") for (int i = 0; i < 8; ++i) { const bool okk = S0.next(i, uu); if (okk && F.tid < 256) { const int row = uu.pm * 256 + F.tid; float sc; \
                if ((MODE) == 0) sc = ((const float*)(F.ws + WS_RS0))[row]; \
                else { const f32x4* sp = (const f32x4*)((const float*)(F.ws + WS_SSQ1) + (size_t)row * 16); const f32x4 t4 = (sp[0] + sp[1]) + (sp[2] + sp[3]); sc = 1.0f / sqrtf(((t4[0] + t4[1]) + (t4[2] + t4[3])) * (1.0f / DM) + EPS); } \
                rst[i * 256 + F.tid] = sc; } } \
            __syncthreads(); } \
        { pg8::Gemm g{(const pg8::bf16_t*)(F.ws + (AOFF)), (const pg8::bf16_t*)(F.ws + (BOFF)), T, (NN), DM}; \
          pg8::EpiAll E{(MODE), F.ws, F.out, F.probe, (LAS float*)(F.lds + pg8::STAGE_BYTES)}; pg8::StaticOrder S; S.init(T, (NN), F.G, (int)blockIdx.x); \
          pg8::gemm_phase<pg8::EpiAll, pg8::StaticOrder, true, true>(F.lds, g, S, E, F.tacc); } } while (0)
    TS_BEGIN(200 + 0); if (IN(0)) { for (int rep = 0; rep < (MK_REPEAT == 0 ? 2 : 1); ++rep) { if (rep) xcd_barrier(bar); p0_prologue(F); } } TS_END(200 + 0); SEAM(0);
    TS_BEGIN(200 + 1); if (IN(1)) { RUN_GEMM(0, WS_S0, WS_WAIN, 2048); } TS_END(200 + 1); SEAM(1);
#if MK_REPEAT == 1
    TS_BEGIN(200 + 1); if (IN(1)) { RUN_GEMM(0, WS_S0, WS_WAIN, 2048); } TS_END(200 + 1); SEAM(1);
#endif
    TS_BEGIN(200 + 2); if (IN(2)) { for (int rep = 0; rep < (MK_REPEAT == 2 ? 2 : 1); ++rep) { if (rep) xcd_barrier(bar); { v4u raw[11]; ScanW W; W.n = -1; int u = F.vcu; if (u < 1024) scan_load_raw(F, u >> 9, (u >> 3) & 63, u & 7, raw); for (; u < 1024; u += F.G) { const int un = u + F.G; const bool hn = un < 1024; if ((u & 7) != W.n) scan_load_w(F, u & 7, W); scan_unit(F, u >> 9, (u >> 3) & 63, u & 7, raw, hn ? (un >> 9) : 0, hn ? ((un >> 3) & 63) : -1, hn ? (un & 7) : 0, W); } } } } TS_END(200 + 2); SEAM(2);
    TS_BEGIN(200 + 3); if (IN(3)) { for (int rep = 0; rep < (MK_REPEAT == 3 ? 2 : 1); ++rep) { if (rep) xcd_barrier(bar); for (int u = F.vcu; u < 256; u += F.G) scan_apply_pair(F, u >> 7, u & 127); } } TS_END(200 + 3); SEAM(3);
    TS_BEGIN(200 + 4); if (IN(4)) { RUN_GEMM(1, WS_S1, WS_WAOUT, DM); } TS_END(200 + 4); SEAM(4);
#if MK_REPEAT == 4
    TS_BEGIN(200 + 4); if (IN(4)) { RUN_GEMM(1, WS_S1, WS_WAOUT, DM); } TS_END(200 + 4); SEAM(4);
#endif
    TS_BEGIN(200 + 5); if (IN(5)) { RUN_GEMM(2, WS_S6, WS_WB1, 4096); } TS_END(200 + 5); SEAM(5);
#if MK_REPEAT == 5
    TS_BEGIN(200 + 5); if (IN(5)) { RUN_GEMM(2, WS_S6, WS_WB1, 4096); } TS_END(200 + 5); SEAM(5);
#endif
    TS_BEGIN(200 + 7); if (IN(7)) { for (int rep = 0; rep < (MK_REPEAT == 7 ? 2 : 1); ++rep) { if (rep) xcd_barrier(bar); F.probe = (MK_REPEAT == 7 && rep == 0); { f32x4 km[4]; bf16x8 qr[8]; int u = F.vcu; while (u < 1024 && (u & 63) == 0) u += F.G;     if (u < 1024) select_loads(F, u >> 9, (u >> 6) & 7, u & 63, km, qr); while (u < 1024) { int un = u + F.G; while (un < 1024 && (un & 63) == 0) un += F.G; const bool hn = un < 1024; select_unit(F, u >> 9, (u >> 6) & 7, u & 63, km, qr, hn ? (un >> 9) : 0, hn ? ((un >> 6) & 7) : 0, hn ? (un & 63) : -1); u = un; } } } } TS_END(200 + 7); SEAM(7);
    TS_BEGIN(200 + 8); if (IN(8)) { for (int rep = 0; rep < (MK_REPEAT == 8 ? 2 : 1); ++rep) { if (rep) xcd_barrier(bar); gathered_attention(F); } } TS_END(200 + 8); SEAM(8);
    TS_BEGIN(200 + 9); if (IN(9)) { for (int rep = 0; rep < (MK_REPEAT == 9 ? 2 : 1); ++rep) { if (rep) xcd_barrier(bar); F.probe = (MK_REPEAT == 9 && rep == 0); combine_phase(F); } } TS_END(200 + 9); SEAM(9);
#if MK_REPEAT == 20
    if (hi - lo > 1) { for (int i = 0; i < 10; ++i) xcd_barrier(bar); }
#endif
#if MK_REPEAT == 10
    if (IN(10)) { F.probe = true; RUN_GEMM(3, WS_S0, WS_WBOUT, DM); F.probe = false; xcd_barrier(bar); }
#endif
    TS_BEGIN(210); if (IN(10)) { RUN_GEMM(3, WS_S0, WS_WBOUT, DM); }
#undef RUN_GEMM
#undef IN
#undef SEAM
    if (MK_STAMP != 0) {
        unsigned long long* mx = (unsigned long long*)(ctl + 32768);
        if (F.tid == 0) atomicMax(mx, F.tacc);
        xcd_barrier(bar);
        if (blockIdx.x == 0 && F.tid == 0) { const unsigned long long tw = __hip_atomic_load(mx, __ATOMIC_RELAXED, __HIP_MEMORY_SCOPE_AGENT);
            const unsigned long long t0 = __builtin_amdgcn_s_memrealtime(); while (__builtin_amdgcn_s_memrealtime() - t0 < tw) __builtin_amdgcn_s_sleep(4); }
    }
}

extern "C" void kernel_launch(void* const* d_in, const int* in_sizes, int n_in, void* d_out, int out_size, void* d_ws, size_t ws_size, hipStream_t stream) {
    static int grid = 0;
    if (grid == 0) {
        if (n_in != 18 || in_sizes[0] != T * DM || out_size != T * DM || ws_size < WS_END) { fprintf(stderr, "kernel_launch: unexpected shapes (n_in %d, in0 %d, out %d, ws %zu < %zu)\n", n_in, n_in > 0 ? in_sizes[0] : -1, out_size, ws_size, (size_t)WS_END); grid = -1; return; }
        int dev = 0, cus = 0, per_cu = 0;
        if (hipGetDevice(&dev) != hipSuccess || hipDeviceGetAttribute(&cus, hipDeviceAttributeMultiprocessorCount, dev) != hipSuccess) { grid = -1; return; }
        if (hipFuncSetAttribute((const void*)hawk_moba_fwd, hipFuncAttributeMaxDynamicSharedMemorySize, LDS_BYTES) != hipSuccess) { fprintf(stderr, "kernel_launch: hipFuncSetAttribute failed\n"); grid = -1; return; }
        if (hipOccupancyMaxActiveBlocksPerMultiprocessor(&per_cu, (const void*)hawk_moba_fwd, 512, LDS_BYTES) != hipSuccess || per_cu < 1) { fprintf(stderr, "kernel_launch: occupancy query says %d blocks per CU\n", per_cu); (void)hipGetLastError(); grid = -1; return; }
        grid = cus;
    }
    if (grid < 0) return;
    (void)hipMemsetAsync((char*)d_ws + WS_CTL, 0, CTL_ZERO_BYTES, stream);
    Args a{};
    for (int i = 0; i < 18; ++i) a.in[i] = (const float*)d_in[i];
    a.out = (float*)d_out; a.ws = (unsigned char*)d_ws;
#if MK_N_LAUNCHES == 1
    a.ph_lo = 0; a.ph_hi = N_PHASES;
    hipLaunchKernelGGL(hawk_moba_fwd, dim3(grid), dim3(512), LDS_BYTES, stream, a);
#else
    for (int p = 0; p <= MK_LAST_PHASE; ++p) { a.ph_lo = p; a.ph_hi = p + 1; hipLaunchKernelGGL(hawk_moba_fwd, dim3(grid), dim3(512), LDS_BYTES, stream, a); }
#endif
}
```
